# Optimizing an MI355X kernel written in HIP

```python
import math, functools
import jax, jax.numpy as jnp
from jax import lax
import numpy as np

D_MODEL = 1024
BATCH = 8
SEQ = 2048
DEPTH = 1
DEC_BATCH = 32
DEC_SEQ = 4
PAST_LEN = 16384
PAGE_SIZE = 128

SSD_D_INNER = 2 * D_MODEL
SSD_HEAD_DIM = 64
SSD_N_HEADS = SSD_D_INNER // SSD_HEAD_DIM
SSD_N_GROUPS = 8
SSD_D_STATE = 128
SSD_CONV_W = 4
SSD_CONV_DIM = SSD_D_INNER + 2 * SSD_N_GROUPS * SSD_D_STATE
SSD_CHUNK = 128
ATT_N_HEADS = 16
ATT_N_KV_HEADS = 4
ATT_HEAD_DIM = 64
IDX_N_HEADS = 8
IDX_HEAD_DIM = 64
TOPK_MAX = 256
Q_BLOCK = 128
MEM_LEN = 256
MEM_N_HEADS = 4
MEM_HEAD_DIM = D_MODEL // MEM_N_HEADS
FFN_HIDDEN = 2816
EPS = 1e-6

IN_SPLITS = (SSD_D_INNER, SSD_CONV_DIM, SSD_N_HEADS,
             ATT_N_HEADS * ATT_HEAD_DIM, ATT_N_KV_HEADS * ATT_HEAD_DIM, ATT_N_KV_HEADS * ATT_HEAD_DIM,
             IDX_N_HEADS * IDX_HEAD_DIM, IDX_HEAD_DIM, IDX_N_HEADS,
             D_MODEL, D_MODEL)
IN_DIM = sum(IN_SPLITS)
IN_OFFSETS = tuple(int(o) for o in np.cumsum(IN_SPLITS)[:-1])

kernel_name = 'hybrid_ssd_dsa_macaron_step'


def rmsnorm(x, g):
    xf = x.astype(jnp.float32)
    y = xf * lax.rsqrt(jnp.mean(xf * xf, axis=-1, keepdims=True) + EPS)
    return (y * g.astype(jnp.float32)).astype(x.dtype)


def swiglu(x, wg, wu, wd):
    return (jax.nn.silu(x @ wg) * (x @ wu)) @ wd


def gather_rows(a, idx):
    return jax.vmap(lambda ar, ix: ar[ix])(a, idx)


def causal_dwconv(xbc, buf, w, b):
    l = xbc.shape[1]
    xp = jnp.concatenate([buf.astype(xbc.dtype), xbc], axis=1)
    y = b
    for j in range(SSD_CONV_W):
        y = y + w[j] * xp[:, j:j + l]
    return jax.nn.silu(y), xp[:, l:]


def ssd_scan(x, dt, a, bm, cm, h0):
    b, l, h, p = x.shape
    g, n = bm.shape[2], bm.shape[3]
    r = h // g
    q = math.gcd(l, SSD_CHUNK)
    c = l // q
    xdt = (x * dt[..., None]).reshape(b, c, q, g, r, p)
    a_cs = jnp.cumsum((dt * a).reshape(b, c, q, g, r), axis=2)
    bc = bm.reshape(b, c, q, g, n)
    cc = cm.reshape(b, c, q, g, n)
    causal = jnp.tril(jnp.ones((q, q), dtype=bool))[:, :, None, None]
    seg = a_cs[:, :, :, None] - a_cs[:, :, None, :]
    decay = jnp.exp(jnp.where(causal, seg, -jnp.inf))
    cb = jnp.einsum('bctgn,bcsgn->bctsg', cc, bc)
    y_diag = jnp.einsum('bctsgr,bcsgrp->bctgrp', cb[..., None] * decay, xdt)
    to_end = jnp.exp(a_cs[:, :, -1:] - a_cs)
    chunk_states = jnp.einsum('bcsgn,bcsgrp->bcgrpn', bc, xdt * to_end[..., None])
    chunk_decay = jnp.exp(a_cs[:, :, -1])

    def step(state, inp):
        s_c, d_c = inp
        return state * d_c[..., None, None] + s_c, state

    h_fin, h_in = lax.scan(step, h0.reshape(b, g, r, p, n),
                           (jnp.moveaxis(chunk_states, 1, 0), jnp.moveaxis(chunk_decay, 1, 0)))
    h_in = jnp.moveaxis(h_in, 0, 1)
    y_off = jnp.einsum('bctgn,bcgrpn->bctgrp', cc, h_in) * jnp.exp(a_cs)[..., None]
    y = (y_diag + y_off).reshape(b, l, h, p)
    return y, h_fin.reshape(b, h, p, n)


def ssd_branch(z, xbc, dt_raw, conv_buf, h0, conv_w, conv_b, dt_bias, a_log, d_skip, norm_g):
    f32 = jnp.float32
    b, l, _ = z.shape
    xbc_act, new_buf = causal_dwconv(xbc, conv_buf, conv_w, conv_b)
    xs, bm, cm = jnp.split(xbc_act, [SSD_D_INNER, SSD_D_INNER + SSD_N_GROUPS * SSD_D_STATE], axis=-1)
    xs = xs.reshape(b, l, SSD_N_HEADS, SSD_HEAD_DIM).astype(f32)
    bm = bm.reshape(b, l, SSD_N_GROUPS, SSD_D_STATE).astype(f32)
    cm = cm.reshape(b, l, SSD_N_GROUPS, SSD_D_STATE).astype(f32)
    dt = jax.nn.softplus((dt_raw + dt_bias).astype(f32))
    a = -jnp.exp(a_log.astype(f32))
    y, h_new = ssd_scan(xs, dt, a, bm, cm, h0.astype(f32))
    y = y + d_skip.astype(f32)[:, None] * xs
    y = y.reshape(b, l, SSD_D_INNER) * jax.nn.silu(z.astype(f32))
    yg = y.reshape(b, l, SSD_N_GROUPS, -1)
    yg = yg * lax.rsqrt(jnp.mean(yg * yg, axis=-1, keepdims=True) + EPS)
    y = yg.reshape(b, l, SSD_D_INNER) * norm_g.astype(f32)
    return y.astype(z.dtype), new_buf, h_new.astype(h0.dtype)


def indexer_select(qi, wi, ki, q_pos, n_keys, topk):
    dots = jnp.einsum('bthd,bsd->bths', qi, ki).astype(jnp.float32) * (IDX_HEAD_DIM ** -0.5)
    score = jnp.einsum('bth,bths->bts', wi.astype(jnp.float32) * (IDX_N_HEADS ** -0.5), jax.nn.relu(dots))
    allowed = jnp.arange(n_keys)[None, :] <= q_pos[:, None]
    score = jnp.where(allowed[None], score, -jnp.inf)
    _, sel = lax.top_k(score, topk)
    valid = sel <= q_pos[None, :, None]
    return sel, valid


def sparse_attend(q, k_sel, v_sel, valid):
    b, t = q.shape[:2]
    qg = q.reshape(b, t, ATT_N_KV_HEADS, ATT_N_HEADS // ATT_N_KV_HEADS, ATT_HEAD_DIM)
    s = jnp.einsum('btgrd,btkgd->btgrk', qg, k_sel).astype(jnp.float32) * (ATT_HEAD_DIM ** -0.5)
    s = jnp.where(valid[:, :, None, None, :], s, -jnp.inf)
    pr = jax.nn.softmax(s, axis=-1).astype(v_sel.dtype)
    o = jnp.einsum('btgrk,btkgd->btgrd', pr, v_sel)
    return o.reshape(b, t, ATT_N_HEADS * ATT_HEAD_DIM)


def dsa_prompt(q, k, v, qi, ki, wi):
    b, T = q.shape[:2]
    topk = min(TOPK_MAX, T // 4)

    def block(t0):
        sl = lambda arr: lax.dynamic_slice_in_dim(arr, t0, Q_BLOCK, axis=1)
        q_pos = t0 + jnp.arange(Q_BLOCK)
        sel, valid = indexer_select(sl(qi), sl(wi), ki, q_pos, T, topk)
        return sparse_attend(sl(q), gather_rows(k, sel), gather_rows(v, sel), valid)

    out = lax.map(block, jnp.arange(T // Q_BLOCK) * Q_BLOCK)
    return jnp.moveaxis(out, 0, 1).reshape(b, T, ATT_N_HEADS * ATT_HEAD_DIM)


def dsa_sample(q, k, v, qi, ki, wi, pool_k, pool_v, pool_kidx, page_table):
    b, l = q.shape[:2]
    n_pages = page_table.shape[1]
    past = n_pages * PAGE_SIZE
    n_keys = past + l
    topk = min(TOPK_MAX, n_keys // 4)
    ki_past = pool_kidx[page_table].reshape(b, past, IDX_HEAD_DIM)
    ki_all = jnp.concatenate([ki_past.astype(ki.dtype), ki], axis=1)
    q_pos = past + jnp.arange(l)
    sel, valid = indexer_select(qi, wi, ki_all, q_pos, n_keys, topk)
    is_past = sel < past
    ps = jnp.where(is_past, sel, 0)
    phys = jax.vmap(lambda pt, s: pt[s])(page_table, ps // PAGE_SIZE)
    off = ps % PAGE_SIZE
    ns = jnp.clip(sel - past, 0, l - 1)
    m = is_past[..., None, None]
    k_sel = jnp.where(m, pool_k[phys, off].astype(k.dtype), gather_rows(k, ns))
    v_sel = jnp.where(m, pool_v[phys, off].astype(v.dtype), gather_rows(v, ns))
    return sparse_attend(q, k_sel, v_sel, valid)


def memory_kv(mem, g, wk, wv):
    b, n, _ = mem.shape
    m = rmsnorm(mem, g)
    return ((m @ wk).reshape(b, n, MEM_N_HEADS, MEM_HEAD_DIM),
            (m @ wv).reshape(b, n, MEM_N_HEADS, MEM_HEAD_DIM))


def mem_attend(u, wq, mk, mv):
    b, l, _ = u.shape
    q = (u @ wq).reshape(b, l, MEM_N_HEADS, MEM_HEAD_DIM)
    s = jnp.einsum('blhd,bmhd->bhlm', q, mk.astype(q.dtype)).astype(jnp.float32) * (MEM_HEAD_DIM ** -0.5)
    pr = jax.nn.softmax(s, axis=-1).astype(q.dtype)
    return jnp.einsum('bhlm,bmhd->blhd', pr, mv.astype(q.dtype)).reshape(b, l, MEM_N_HEADS * MEM_HEAD_DIM)


def layer_forward(h, lp, conv_buf, ssm_h0, attn_fn, mem_k, mem_v):
    u = rmsnorm(h, lp['ffn1_pre_g'])
    h = h + 0.5 * rmsnorm(swiglu(u, lp['ffn1_wg'], lp['ffn1_wu'], lp['ffn1_wd']), lp['ffn1_post_g'])
    u = rmsnorm(h, lp['mix_pre_g'])
    b, l, _ = u.shape
    z, xbc, dt_raw, q, k, v, qi, ki, wi, g_ssd, g_att = jnp.split(u @ lp['w_in'], IN_OFFSETS, axis=-1)
    y_ssd, new_conv, new_ssm = ssd_branch(z, xbc, dt_raw, conv_buf, ssm_h0, lp['conv_w'], lp['conv_b'],
                                          lp['dt_bias'], lp['a_log'], lp['d_skip'], lp['ssd_norm_g'])
    q = q.reshape(b, l, ATT_N_HEADS, ATT_HEAD_DIM)
    k = k.reshape(b, l, ATT_N_KV_HEADS, ATT_HEAD_DIM)
    v = v.reshape(b, l, ATT_N_KV_HEADS, ATT_HEAD_DIM)
    qi = qi.reshape(b, l, IDX_N_HEADS, IDX_HEAD_DIM)
    y_att = attn_fn(q, k, v, qi, ki, wi)
    merged = (jax.nn.sigmoid(g_ssd) * (y_ssd @ lp['w_br_ssd'])
              + jax.nn.sigmoid(g_att) * (y_att @ lp['w_br_att']))
    h = h + rmsnorm(merged @ lp['w_out'], lp['mix_post_g'])
    u = rmsnorm(h, lp['mem_pre_g'])
    h = h + rmsnorm(mem_attend(u, lp['w_mq'], mem_k, mem_v) @ lp['w_mo'], lp['mem_post_g'])
    u = rmsnorm(h, lp['ffn2_pre_g'])
    h = h + 0.5 * rmsnorm(swiglu(u, lp['ffn2_wg'], lp['ffn2_wu'], lp['ffn2_wd']), lp['ffn2_post_g'])
    return h, (k, v, ki, new_ssm, new_conv)


def setup_inputs(seed: int = 0) -> dict:
    key = jax.random.key(seed)
    ks = iter(jax.random.split(key, 64))

    def nrm(shape, scale=1.0):
        return jax.random.normal(next(ks), shape, jnp.float32) * scale

    def gain(n):
        return 1.0 + nrm((DEPTH, n), 0.02)

    n_pages = PAST_LEN // PAGE_SIZE
    n_pool = (DEC_BATCH * n_pages * 5) // 4
    D = D_MODEL
    inp = {}
    inp['x_prompt'] = nrm((BATCH, SEQ, D))
    inp['x_sample'] = nrm((DEC_BATCH, DEC_SEQ, D))
    inp['mem_prompt'] = nrm((BATCH, MEM_LEN, D))
    inp['cache_k'] = nrm((DEPTH, n_pool, PAGE_SIZE, ATT_N_KV_HEADS, ATT_HEAD_DIM))
    inp['cache_v'] = nrm((DEPTH, n_pool, PAGE_SIZE, ATT_N_KV_HEADS, ATT_HEAD_DIM))
    inp['cache_kidx'] = nrm((DEPTH, n_pool, PAGE_SIZE, IDX_HEAD_DIM))
    inp['state_ssm'] = nrm((DEPTH, DEC_BATCH, SSD_N_HEADS, SSD_HEAD_DIM, SSD_D_STATE), 0.3)
    inp['state_conv'] = nrm((DEPTH, DEC_BATCH, SSD_CONV_W - 1, SSD_CONV_DIM))
    inp['cache_mem_k'] = nrm((DEPTH, DEC_BATCH, MEM_LEN, MEM_N_HEADS, MEM_HEAD_DIM))
    inp['cache_mem_v'] = nrm((DEPTH, DEC_BATCH, MEM_LEN, MEM_N_HEADS, MEM_HEAD_DIM))
    perm = jax.random.permutation(next(ks), n_pool)[: DEC_BATCH * n_pages]
    inp['page_table'] = perm.reshape(DEC_BATCH, n_pages).astype(jnp.int32)
    inp['ffn1_pre_g'] = gain(D)
    inp['ffn1_wg'] = nrm((DEPTH, D, FFN_HIDDEN), D ** -0.5)
    inp['ffn1_wu'] = nrm((DEPTH, D, FFN_HIDDEN), D ** -0.5)
    inp['ffn1_wd'] = nrm((DEPTH, FFN_HIDDEN, D), FFN_HIDDEN ** -0.5)
    inp['ffn1_post_g'] = gain(D)
    inp['mix_pre_g'] = gain(D)
    inp['w_in'] = nrm((DEPTH, D, IN_DIM), D ** -0.5)
    inp['conv_w'] = nrm((DEPTH, SSD_CONV_W, SSD_CONV_DIM), 0.5)
    inp['conv_b'] = nrm((DEPTH, SSD_CONV_DIM), 0.01)
    u = jax.random.uniform(next(ks), (DEPTH, SSD_N_HEADS))
    dt0 = jnp.exp(u * (math.log(0.1) - math.log(0.001)) + math.log(0.001))
    inp['dt_bias'] = dt0 + jnp.log(-jnp.expm1(-dt0))
    inp['a_log'] = jnp.log(jax.random.uniform(next(ks), (DEPTH, SSD_N_HEADS), minval=1.0, maxval=16.0))
    inp['d_skip'] = 1.0 + nrm((DEPTH, SSD_N_HEADS), 0.1)
    inp['ssd_norm_g'] = gain(SSD_D_INNER)
    inp['w_br_ssd'] = nrm((DEPTH, SSD_D_INNER, D), SSD_D_INNER ** -0.5)
    inp['w_br_att'] = nrm((DEPTH, ATT_N_HEADS * ATT_HEAD_DIM, D), (ATT_N_HEADS * ATT_HEAD_DIM) ** -0.5)
    inp['w_out'] = nrm((DEPTH, D, D), D ** -0.5)
    inp['mix_post_g'] = gain(D)
    inp['mem_pre_g'] = gain(D)
    inp['mem_kv_g'] = gain(D)
    inp['w_mq'] = nrm((DEPTH, D, MEM_N_HEADS * MEM_HEAD_DIM), D ** -0.5)
    inp['w_mk'] = nrm((DEPTH, D, MEM_N_HEADS * MEM_HEAD_DIM), D ** -0.5)
    inp['w_mv'] = nrm((DEPTH, D, MEM_N_HEADS * MEM_HEAD_DIM), D ** -0.5)
    inp['w_mo'] = nrm((DEPTH, MEM_N_HEADS * MEM_HEAD_DIM, D), (MEM_N_HEADS * MEM_HEAD_DIM) ** -0.5)
    inp['mem_post_g'] = gain(D)
    inp['ffn2_pre_g'] = gain(D)
    inp['ffn2_wg'] = nrm((DEPTH, D, FFN_HIDDEN), D ** -0.5)
    inp['ffn2_wu'] = nrm((DEPTH, D, FFN_HIDDEN), D ** -0.5)
    inp['ffn2_wd'] = nrm((DEPTH, FFN_HIDDEN, D), FFN_HIDDEN ** -0.5)
    inp['ffn2_post_g'] = gain(D)
    return inp


def reference(x_prompt, x_sample, mem_prompt, cache_k, cache_v, cache_kidx, state_ssm, state_conv,
              cache_mem_k, cache_mem_v, page_table,
              ffn1_pre_g, ffn1_wg, ffn1_wu, ffn1_wd, ffn1_post_g,
              mix_pre_g, w_in, conv_w, conv_b, dt_bias, a_log, d_skip, ssd_norm_g,
              w_br_ssd, w_br_att, w_out, mix_post_g,
              mem_pre_g, mem_kv_g, w_mq, w_mk, w_mv, w_mo, mem_post_g,
              ffn2_pre_g, ffn2_wg, ffn2_wu, ffn2_wd, ffn2_post_g):
    y_p, y_s = x_prompt, x_sample
    b_p = x_prompt.shape[0]
    acc = [[] for _ in range(12)]
    for i in range(DEPTH):
        lp = dict(ffn1_pre_g=ffn1_pre_g[i], ffn1_wg=ffn1_wg[i], ffn1_wu=ffn1_wu[i], ffn1_wd=ffn1_wd[i],
                  ffn1_post_g=ffn1_post_g[i], mix_pre_g=mix_pre_g[i], w_in=w_in[i], conv_w=conv_w[i],
                  conv_b=conv_b[i], dt_bias=dt_bias[i], a_log=a_log[i], d_skip=d_skip[i],
                  ssd_norm_g=ssd_norm_g[i], w_br_ssd=w_br_ssd[i], w_br_att=w_br_att[i], w_out=w_out[i],
                  mix_post_g=mix_post_g[i], mem_pre_g=mem_pre_g[i], w_mq=w_mq[i], w_mo=w_mo[i],
                  mem_post_g=mem_post_g[i], ffn2_pre_g=ffn2_pre_g[i], ffn2_wg=ffn2_wg[i], ffn2_wu=ffn2_wu[i],
                  ffn2_wd=ffn2_wd[i], ffn2_post_g=ffn2_post_g[i])
        mk_p, mv_p = memory_kv(mem_prompt, mem_kv_g[i], w_mk[i], w_mv[i])
        conv0 = jnp.zeros((b_p, SSD_CONV_W - 1, SSD_CONV_DIM), x_prompt.dtype)
        h0 = jnp.zeros((b_p, SSD_N_HEADS, SSD_HEAD_DIM, SSD_D_STATE), jnp.float32)
        y_p, (k_p, v_p, ki_p, ssm_p, conv_p) = layer_forward(y_p, lp, conv0, h0, dsa_prompt, mk_p, mv_p)
        samp_attn = functools.partial(dsa_sample, pool_k=cache_k[i], pool_v=cache_v[i],
                                      pool_kidx=cache_kidx[i], page_table=page_table)
        y_s, (k_s, v_s, ki_s, ssm_s, conv_s) = layer_forward(y_s, lp, state_conv[i], state_ssm[i], samp_attn,
                                                             cache_mem_k[i], cache_mem_v[i])
        for lst, val in zip(acc, (k_p, v_p, ki_p, ssm_p, conv_p, mk_p, mv_p, k_s, v_s, ki_s, ssm_s, conv_s)):
            lst.append(val)
    (nk_p, nv_p, nki_p, nssm_p, nconv_p, nmk_p, nmv_p,
     nk_s, nv_s, nki_s, nssm_s, nconv_s) = [jnp.stack(lst) for lst in acc]
    return (y_p, y_s, nk_p, nv_p, nki_p, nssm_p, nconv_p, nmk_p, nmv_p, nk_s, nv_s, nki_s, nssm_s, nconv_s)
```

```cpp
#include <hip/hip_runtime.h>
#include <cstdio>
#include <cstdint>
namespace pg8 {
#define PG8_LAS __attribute__((address_space(3)))
typedef unsigned short bf16_t;
typedef short bf16x8 __attribute__((ext_vector_type(8)));
typedef float f32x4 __attribute__((ext_vector_type(4)));
typedef unsigned u32x4 __attribute__((ext_vector_type(4)));
constexpr int BM = 256, BK = 64, HALF = 128, HTB = HALF * BK * 2  , STAGE_BYTES = 8 * HTB, NXCD = 8, WGM = 8;

__host__ __device__ __forceinline__ int lds_byte(int r, int c) { const int st = (r >> 4) * 2 + (c >> 5), rr = r & 15, cc = c & 31, ob = rr * 64 + cc * 2; return st * 1024 + (ob ^ (((ob >> 9) & 1) << 5)); }
__host__ __device__ __forceinline__ void stage_rc(int b, int& R, int& C) { const int st = b / 1024, sb = b % 1024, swz = sb ^ (((sb >> 9) & 1) << 5); R = (st >> 1) * 16 + swz / 64; C = (st & 1) * 32 + (swz % 64) / 2; }
__host__ __device__ __forceinline__ int perm32(int rho) { const int n = rho >> 4, i = rho & 15; return 8 * (i >> 2) + 4 * n + (i & 3); }

struct Unit { int pm, pn; };
struct Gemm { const bf16_t* A; const bf16_t* Bt; int M, N, K; };

struct StaticOrder {
    int nM, nN, nwg, G, c;
    __host__ __device__ void init(int M, int N, int G_, int c_) { nM = M / BM; nN = N / BM; nwg = nM * nN; G = G_; c = c_; }
    __host__ __device__ bool next(int i, Unit& u) const {
        const long L = (long)i * G + c; if (L >= nwg) return false;
        int wgid = (int)L; { const int q = nwg / NXCD, r = nwg % NXCD, xcd = wgid % NXCD, off = wgid / NXCD; wgid = (xcd < r ? xcd * (q + 1) : r * (q + 1) + (xcd - r) * q) + off; }
        const int nig = WGM * nN, gid = wgid / nig, fm = gid * WGM, gsz = (nM - fm) < WGM ? (nM - fm) : WGM;
        u.pm = fm + ((wgid % nig) % gsz); u.pn = (wgid % nig) / gsz; return true;
    }
    __device__ __forceinline__ void a_ready(const Unit&) const {}
    __device__ __forceinline__ void done(const Unit&) const {}
};

__device__ __forceinline__ unsigned cvt_pk_bf16(float lo, float hi) { unsigned r; asm volatile("v_cvt_pk_bf16_f32 %0, %1, %2" : "=v"(r) : "v"(lo), "v"(hi)); return r; }
typedef float f32x2 __attribute__((ext_vector_type(2)));
template <class Epi, class Sched, bool ALIGN_EPI = false, bool SP2 = false>
__device__ __forceinline__ void gemm_phase(PG8_LAS unsigned char* lds, const Gemm g, const Sched& S, const Epi& E, const int tid_in  ) {
    const int tid = tid_in, wid = __builtin_amdgcn_readfirstlane(tid >> 6), lane = tid & 63, wr = wid >> 2, wc = wid & 3, fr = lane & 15, fq = lane >> 4;
    const int K = g.K, nt = K / BK;
    unsigned voffA[2], voffB[2];
#pragma unroll
    for (int i = 0; i < 2; ++i) { int R, C; stage_rc(tid * 16 + i * 8192, R, C); const int Rb = Epi::PERM ? ((R & ~31) + perm32(R & 31)) : R;
        voffA[i] = (unsigned)(R * K + C) * 2u; voffB[i] = (unsigned)(Rb * K + C) * 2u; }
    const size_t kstep = (size_t)(BK * 2);
    const size_t hstep = (size_t)HALF * K * 2;
    const size_t tstep = 2 * hstep;
    const unsigned ldsw = (unsigned)wid * 1024u;
    const int aoff = lds_byte(wr * 64 + fr, fq * 8), boff = lds_byte(wc * 32 + fr, fq * 8);
#define PG8_SA(b, h) (((b) * 2 + (h)) * HTB)
#define PG8_SB(b, h) ((4 + (b) * 2 + (h)) * HTB)
#define PG8_STAGE(bufoff, gbase, voff) do { _Pragma("unroll") for (int _i = 0; _i < 2; ++_i) \
        __builtin_amdgcn_global_load_lds((const unsigned*)((const char*)(gbase) + (voff)[_i]), (PG8_LAS unsigned*)(lds + (bufoff) + ldsw + _i * 8192), 16, 0, 0); } while (0)
#define PG8_LDA(dst, b, h) do { _Pragma("unroll") for (int m = 0; m < 4; ++m) _Pragma("unroll") for (int k = 0; k < 2; ++k) dst[m][k] = *(const PG8_LAS bf16x8*)(lds + PG8_SA(b, h) + aoff + m * 2048 + k * 1024); } while (0)
#define PG8_LDB(dst, b, h) do { _Pragma("unroll") for (int n = 0; n < 2; ++n) _Pragma("unroll") for (int k = 0; k < 2; ++k) dst[n][k] = *(const PG8_LAS bf16x8*)(lds + PG8_SB(b, h) + boff + n * 2048 + k * 1024); } while (0)
#define PG8_MMA(ai, bj, At, Bt) do { __builtin_amdgcn_s_setprio(1); _Pragma("unroll") for (int m = 0; m < 4; ++m) _Pragma("unroll") for (int n = 0; n < 2; ++n) _Pragma("unroll") for (int k = 0; k < 2; ++k) \
        acc[ai][bj][m][n] = __builtin_amdgcn_mfma_f32_16x16x32_bf16(Bt[n][k], At[m][k], acc[ai][bj][m][n], 0, 0, 0); __builtin_amdgcn_s_setprio(0); } while (0)
#define PG8_WAIT_V(n) asm volatile("s_waitcnt vmcnt(" #n ")" ::: "memory")
#define PG8_WAIT_L(n) asm volatile("s_waitcnt lgkmcnt(" #n ")" ::: "memory")
#define PG8_BAR __builtin_amdgcn_s_barrier()
#define PG8_SCHED __builtin_amdgcn_sched_barrier(0)
    Unit cur, nxt; int ui = 0;
    if (!S.next(0, cur)) return;
    f32x4 acc[2][2][4][2];
#pragma unroll
    for (int a = 0; a < 2; ++a)
#pragma unroll
        for (int b = 0; b < 2; ++b)
#pragma unroll
            for (int m = 0; m < 4; ++m)
#pragma unroll
                for (int n = 0; n < 2; ++n) acc[a][b][m][n] = (f32x4){0.f, 0.f, 0.f, 0.f};
    bf16x8 At[4][2], B0[2][2], B1[2][2];
    const char* cA = (const char*)g.A + (size_t)cur.pm * tstep; const char* cB = (const char*)g.Bt + (size_t)cur.pn * tstep;
    S.a_ready(cur);
    if constexpr (SP2) {
        PG8_STAGE(PG8_SB(0, 0), cB, voffB); PG8_STAGE(PG8_SB(0, 1), cB + hstep, voffB); PG8_STAGE(PG8_SA(0, 0), cA, voffA); PG8_STAGE(PG8_SA(0, 1), cA + hstep, voffA);
        if (wr == 1) PG8_BAR;
        PG8_WAIT_V(2); PG8_BAR;
        PG8_STAGE(PG8_SB(1, 0), cB + kstep, voffB); PG8_STAGE(PG8_SA(1, 0), cA + kstep, voffA); PG8_STAGE(PG8_SB(1, 1), cB + hstep + kstep, voffB);
        PG8_WAIT_V(6); PG8_BAR;
    } else {
        PG8_STAGE(PG8_SB(0, 0), cB, voffB); PG8_STAGE(PG8_SA(0, 0), cA, voffA); PG8_STAGE(PG8_SB(0, 1), cB + hstep, voffB); PG8_STAGE(PG8_SA(0, 1), cA + hstep, voffA);
        if (wr == 1) PG8_BAR;
        PG8_WAIT_V(4); PG8_BAR;
        PG8_STAGE(PG8_SB(1, 0), cB + kstep, voffB); PG8_STAGE(PG8_SA(1, 0), cA + kstep, voffA); PG8_STAGE(PG8_SB(1, 1), cB + hstep + kstep, voffB);
        PG8_WAIT_V(6); PG8_BAR;
    }
    for (;;) {
        const bool has_next = S.next(ui + 1, nxt);
        const char* nA = has_next ? (const char*)g.A + (size_t)nxt.pm * tstep : cA; const char* nB = has_next ? (const char*)g.Bt + (size_t)nxt.pn * tstep : cB;
        for (int t = 0; t < nt; t += 2) {
            const bool last = (t == nt - 2);
            const char* a1 = cA + (size_t)(t + 1) * kstep;
            const char* a2 = last ? nA : cA + (size_t)(t + 2) * kstep; const char* b2 = last ? nB : cB + (size_t)(t + 2) * kstep;
            const char* a3 = a2 + kstep; const char* b3 = b2 + kstep;
            if (last && has_next) S.a_ready(nxt);
            if constexpr (SP2) {
            PG8_LDB(B0, 0, 0); PG8_LDB(B1, 0, 1); PG8_SCHED; PG8_LDA(At, 0, 0); PG8_STAGE(PG8_SA(1, 1), a1 + hstep, voffA);
            PG8_WAIT_V(8); PG8_WAIT_L(0); PG8_BAR; PG8_MMA(0, 0, At, B0); PG8_MMA(0, 1, At, B1); PG8_BAR; PG8_SCHED;
            PG8_LDA(At, 0, 1); PG8_STAGE(PG8_SB(0, 0), b2, voffB); PG8_STAGE(PG8_SB(0, 1), b2 + hstep, voffB); PG8_STAGE(PG8_SA(0, 0), a2, voffA);
            PG8_WAIT_V(8); PG8_WAIT_L(0); PG8_BAR; PG8_MMA(1, 0, At, B0); PG8_MMA(1, 1, At, B1); PG8_BAR; PG8_SCHED;
            PG8_LDB(B0, 1, 0); PG8_LDB(B1, 1, 1); PG8_SCHED; PG8_LDA(At, 1, 0); PG8_STAGE(PG8_SA(0, 1), a2 + hstep, voffA);
            PG8_WAIT_V(8); PG8_WAIT_L(0); PG8_BAR; PG8_MMA(0, 0, At, B0); PG8_MMA(0, 1, At, B1); PG8_BAR; PG8_SCHED;
            PG8_LDA(At, 1, 1); PG8_STAGE(PG8_SB(1, 0), b3, voffB); PG8_STAGE(PG8_SB(1, 1), b3 + hstep, voffB); PG8_STAGE(PG8_SA(1, 0), a3, voffA);
            PG8_WAIT_V(8); PG8_WAIT_L(0); PG8_BAR; PG8_MMA(1, 0, At, B0); PG8_MMA(1, 1, At, B1); PG8_BAR; PG8_SCHED;
            } else {
            PG8_LDB(B0, 0, 0); PG8_SCHED; PG8_LDA(At, 0, 0); PG8_STAGE(PG8_SA(1, 1), a1 + hstep, voffA);
            PG8_WAIT_L(8); PG8_BAR; PG8_WAIT_L(0); PG8_MMA(0, 0, At, B0); PG8_BAR; PG8_SCHED;
            PG8_LDB(B1, 0, 1); PG8_STAGE(PG8_SB(0, 0), b2, voffB);
            PG8_BAR; PG8_WAIT_L(0); PG8_MMA(0, 1, At, B1); PG8_BAR;
            PG8_LDA(At, 0, 1); PG8_STAGE(PG8_SA(0, 0), a2, voffA);
            PG8_BAR; PG8_WAIT_L(0); PG8_MMA(1, 0, At, B0); PG8_BAR; PG8_SCHED;
            PG8_STAGE(PG8_SB(0, 1), b2 + hstep, voffB);
            PG8_WAIT_V(6); PG8_BAR; PG8_MMA(1, 1, At, B1); PG8_BAR;
            PG8_LDB(B0, 1, 0); PG8_SCHED; PG8_LDA(At, 1, 0); PG8_STAGE(PG8_SA(0, 1), a2 + hstep, voffA);
            PG8_WAIT_L(8); PG8_BAR; PG8_WAIT_L(0); PG8_MMA(0, 0, At, B0); PG8_BAR; PG8_SCHED;
            PG8_LDB(B1, 1, 1); PG8_STAGE(PG8_SB(1, 0), b3, voffB);
            PG8_BAR; PG8_WAIT_L(0); PG8_MMA(0, 1, At, B1); PG8_BAR;
            PG8_LDA(At, 1, 1); PG8_STAGE(PG8_SA(1, 0), a3, voffA);
            PG8_BAR; PG8_WAIT_L(0); PG8_MMA(1, 0, At, B0); PG8_BAR; PG8_SCHED;
            PG8_STAGE(PG8_SB(1, 1), b3 + hstep, voffB);
            PG8_WAIT_V(6); PG8_BAR; PG8_MMA(1, 1, At, B1); PG8_BAR;
            }
        }
        if constexpr (ALIGN_EPI) { if (wr == 0) PG8_BAR; }
        if constexpr (!Epi::AFTER_DRAIN) { E(acc, cur, wr, wc, fr, fq); S.done(cur); }
        if (!has_next) break;
#pragma unroll
        for (int a = 0; a < 2; ++a)
#pragma unroll
            for (int b = 0; b < 2; ++b)
#pragma unroll
                for (int m = 0; m < 4; ++m)
#pragma unroll
                    for (int n = 0; n < 2; ++n) acc[a][b][m][n] = (f32x4){0.f, 0.f, 0.f, 0.f};
        cur = nxt; cA = nA; cB = nB; ++ui;
        if constexpr (ALIGN_EPI) { if (wr == 1) PG8_BAR; }
    }
    PG8_WAIT_V(0);
    if constexpr (!ALIGN_EPI) { if (wr == 0) PG8_BAR; }
    PG8_BAR;
    if constexpr (Epi::AFTER_DRAIN) { E.fused(acc, cur, wr, wc, fr, fq, lds, wid, lane); S.done(cur); }
#undef PG8_SA
#undef PG8_SB
#undef PG8_STAGE
#undef PG8_LDA
#undef PG8_LDB
#undef PG8_MMA
#undef PG8_WAIT_V
#undef PG8_WAIT_L
#undef PG8_BAR
#undef PG8_SCHED
}
}
#define GAS __attribute__((address_space(1)))
#define LAS __attribute__((address_space(3)))
typedef unsigned short bf16;
typedef unsigned v4u __attribute__((ext_vector_type(4)));
typedef float f32x4 __attribute__((ext_vector_type(4)));
typedef short bf16x8 __attribute__((ext_vector_type(8)));
typedef GAS unsigned gu32;
typedef GAS unsigned long long gu64;
#define RLX_AGENT __ATOMIC_RELAXED, __HIP_MEMORY_SCOPE_AGENT
#define LDS_WAIT() asm volatile("s_waitcnt lgkmcnt(0)" ::: "memory")
#define VM_WAIT() asm volatile("s_waitcnt vmcnt(0)" ::: "memory")
__device__ __forceinline__ unsigned long long rt() { return __builtin_amdgcn_s_memrealtime(); }
__device__ __forceinline__ unsigned f2bf(float f) { unsigned u = __builtin_bit_cast(unsigned, f); return (u + 0x7fffu + ((u >> 16) & 1u)) >> 16; }
__device__ __forceinline__ unsigned pk2(float lo, float hi) { return f2bf(lo) | (f2bf(hi) << 16); }

#define XB_TMO      128
#define XB_XCNT(j)  (256  + 64 * (j))
#define XB_XSUB(j)  (1280 + 64 * (j))
#define XB_XGEN(j)  (2304 + 64 * (j))
#define XB_TOP      3328
#define XB_TOPGEN   3392
#define XCD_BAR_WORDS 3456
#define XB_SPIN_CAP (1u << 18)

__device__ __forceinline__ unsigned xb_ld(unsigned* p)              { return __hip_atomic_load(p, __ATOMIC_RELAXED, __HIP_MEMORY_SCOPE_AGENT); }
__device__ __forceinline__ unsigned xb_add(unsigned* p, unsigned v) { return __hip_atomic_fetch_add(p, v, __ATOMIC_RELAXED, __HIP_MEMORY_SCOPE_AGENT); }
__device__ __forceinline__ unsigned xb_xcc_id() { return (unsigned)__builtin_amdgcn_s_getreg((3 << 11) | 20) & 0xFu; }
#define XB_SPIN(cond, bar) do { unsigned _sp = 0; while (cond) { __builtin_amdgcn_s_sleep(1); \
    if ((++_sp & 255u) == 0u) { if (xb_ld(&(bar)[XB_TMO])) break; if (_sp > XB_SPIN_CAP) { atomicAdd(&(bar)[XB_TMO], 1u); break; } } } } while (0)

struct XcdBarrier {
    unsigned* bar; unsigned x;
    volatile LAS unsigned* st;
};

__device__ __forceinline__ XcdBarrier xcd_barrier_post(unsigned* bar, volatile LAS unsigned* st) {
    XcdBarrier b; b.bar = bar; b.x = xb_xcc_id(); b.st = st;
    if (threadIdx.x == 0) (void)xb_add(&bar[XB_XCNT(b.x)], 1u);
    return b;
}
__device__ __forceinline__ void xcd_barrier_complete(unsigned* bar, unsigned x, unsigned& nloc, unsigned& nx) {
    const unsigned G = gridDim.x * gridDim.y * gridDim.z;
    unsigned sum, cnt, mine, sp = 0u;
    for (;;) {
        sum = 0u; cnt = 0u; mine = 0u;
#pragma unroll
        for (unsigned j = 0; j < 16; ++j) { const unsigned c = xb_ld(&bar[XB_XCNT(j)]); sum += c; cnt += (c > 0u) ? 1u : 0u; mine = (j == x) ? c : mine; }
        if (sum == G) break;
        __builtin_amdgcn_s_sleep(1);
        if ((++sp & 255u) == 0u) { if (xb_ld(&bar[XB_TMO])) break; if (sp > XB_SPIN_CAP) { atomicAdd(&bar[XB_TMO], 1u); break; } }
    }
    nloc = mine > 0u ? mine : 1u; nx = cnt > 0u ? cnt : 1u;
}

__device__ __forceinline__ void xcd_barrier(const XcdBarrier& b, bool leader  ) {
    asm volatile("s_waitcnt vmcnt(0)" ::: "memory");
    __syncthreads();
    if (leader) {
        unsigned* bar = b.bar;
        __builtin_amdgcn_s_waitcnt(0);
        unsigned nloc = b.st[0], nx = b.st[1];
        if (nloc == 0u) { xcd_barrier_complete(bar, b.x, nloc, nx); b.st[0] = nloc; b.st[1] = nx; }
        const unsigned old = xb_add(&bar[XB_XSUB(b.x)], 1u);
        const unsigned gen = old / nloc;
        if (old + 1u == (gen + 1u) * nloc) {
            __builtin_amdgcn_fence(__ATOMIC_RELEASE, "agent");
            asm volatile("s_waitcnt vmcnt(0)" ::: "memory");
            const unsigned og = xb_add(&bar[XB_TOP], 1u);
            const unsigned tg = og / nx;
            if (og + 1u == (tg + 1u) * nx) xb_add(&bar[XB_TOPGEN], 1u);
            else XB_SPIN(xb_ld(&bar[XB_TOPGEN]) == tg, bar);
            __builtin_amdgcn_fence(__ATOMIC_ACQUIRE, "agent");
            xb_add(&bar[XB_XGEN(b.x)], 1u);
            asm volatile("s_waitcnt vmcnt(0)" ::: "memory");
        } else {
            XB_SPIN(xb_ld(&bar[XB_XGEN(b.x)]) == gen, bar);
            __builtin_amdgcn_fence(__ATOMIC_ACQUIRE, "agent");
            asm volatile("s_waitcnt vmcnt(0)" ::: "memory");
        }
    }
    __syncthreads();
}

constexpr int DM = 1024, NB = 8, SEQ = 2048, DECB = 32, DECS = 4, PAST = 16384, PAGE = 128, NPAGE = 128;
constexpr int MP = NB * SEQ;
constexpr int MS = DECB * DECS;
constexpr int MR = MP + MS;
constexpr int MT = 16640;
constexpr int FF = 2816, NGU = 2 * FF, NINP = 10496;
constexpr float EPS = 1e-6f;
constexpr int NWAVES = 8;

enum { I_XP = 0, I_XS, I_MEMP, I_CK, I_CV, I_CKI, I_SSM, I_CONV, I_CMK, I_CMV, I_PT,
       I_F1PRE, I_F1WG, I_F1WU, I_F1WD, I_F1POST, I_MIXPRE, I_WIN, I_CONVW, I_CONVB, I_DTB, I_ALOG, I_DSKIP, I_SSDG,
       I_WBRS, I_WBRA, I_WOUT, I_MIXPOST, I_MEMPRE, I_MEMKVG, I_WMQ, I_WMK, I_WMV, I_WMO, I_MEMPOST,
       I_F2PRE, I_F2WG, I_F2WU, I_F2WD, I_F2POST, N_IN };

constexpr size_t O_YP = 0;
constexpr size_t O_YS = O_YP + (size_t)MP * DM;
constexpr size_t O_KP = O_YS + (size_t)MS * DM;
constexpr size_t O_VP = O_KP + (size_t)MP * 256;
constexpr size_t O_KIP = O_VP + (size_t)MP * 256;
constexpr size_t O_SSMP = O_KIP + (size_t)MP * 64;
constexpr size_t O_CONVP = O_SSMP + (size_t)NB * 32 * 64 * 128;
constexpr size_t O_MKP = O_CONVP + (size_t)NB * 3 * 4096;
constexpr size_t O_MVP = O_MKP + (size_t)NB * 256 * 1024;
constexpr size_t O_KS = O_MVP + (size_t)NB * 256 * 1024;
constexpr size_t O_VS = O_KS + (size_t)MS * 256;
constexpr size_t O_KIS = O_VS + (size_t)MS * 256;
constexpr size_t O_SSMS = O_KIS + (size_t)MS * 64;
constexpr size_t O_CONVS = O_SSMS + (size_t)DECB * 32 * 64 * 128;
constexpr size_t O_END = O_CONVS + (size_t)DECB * 3 * 4096;
static_assert(O_END == 41590784, "output size");

constexpr size_t MiB = 1u << 20;
constexpr size_t al(size_t x) { return (x + MiB - 1) / MiB * MiB; }
constexpr size_t WS_CTL = 0, CTL_ZERO_BYTES = 1 * MiB;
constexpr size_t WS_WGU1 = 1 * MiB;
constexpr size_t WS_WD1 = WS_WGU1 + al((size_t)NGU * DM * 2);
constexpr size_t WS_WIN = WS_WD1 + al((size_t)DM * FF * 2);
constexpr size_t WS_WBRS = WS_WIN + al((size_t)NINP * DM * 2);
constexpr size_t WS_WBRA = WS_WBRS + al((size_t)DM * 2048 * 2);
constexpr size_t WS_WOUT = WS_WBRA + al((size_t)DM * DM * 2);
constexpr size_t WS_WMQ = WS_WOUT + al((size_t)DM * DM * 2);
constexpr size_t WS_WMKV = WS_WMQ + al((size_t)DM * DM * 2);
constexpr size_t WS_WMO = WS_WMKV + al((size_t)2048 * DM * 2);
constexpr size_t WS_WGU2 = WS_WMO + al((size_t)DM * DM * 2);
constexpr size_t WS_WD2 = WS_WGU2 + al((size_t)NGU * DM * 2);
constexpr size_t WS_U = WS_WD2 + al((size_t)DM * FF * 2);
constexpr size_t WS_ACT = WS_U + al((size_t)MT * DM * 2);
constexpr size_t WS_F = WS_ACT + al((size_t)MT * FF * 2);
constexpr size_t WS_Z = WS_F + al((size_t)MT * DM * 4);
constexpr size_t WS_XBC = WS_Z + al((size_t)MT * 2048 * 2);
constexpr size_t WS_Q = WS_XBC + al((size_t)MT * 4096 * 2);
constexpr size_t WS_KB = WS_Q + al((size_t)MT * DM * 2);
constexpr size_t WS_VT = WS_KB + al((size_t)MT * 256 * 2);
constexpr size_t WS_QI = WS_VT + al((size_t)NB * 256 * SEQ * 2);
constexpr size_t WS_GS = WS_QI + al((size_t)MT * 512 * 2);
constexpr size_t WS_GA = WS_GS + al((size_t)MT * DM * 2);
constexpr size_t WS_MISC = WS_GA + al((size_t)MT * DM * 2);
constexpr size_t WS_KIB = WS_MISC + al((size_t)MT * 256 * 4);
constexpr size_t WS_YS = WS_KIB + al((size_t)MT * 64 * 2);
constexpr size_t WS_YA = WS_YS + al((size_t)MT * 2048 * 2);
constexpr size_t WS_MRG = WS_YA + al((size_t)MT * DM * 2);
constexpr size_t WS_QM = WS_MRG + al((size_t)MT * DM * 2);
constexpr size_t WS_OM = WS_QM + al((size_t)MT * DM * 2);
constexpr size_t WS_MN = WS_OM + al((size_t)MT * DM * 2);
constexpr size_t WS_MKB = WS_MN + al((size_t)2048 * DM * 2);
constexpr size_t WS_MVT = WS_MKB + al((size_t)40 * 256 * DM * 2);
constexpr size_t WS_SC = WS_MVT + al((size_t)40 * 256 * DM * 2);
constexpr size_t WS_SCS = WS_SC + al((size_t)MP * 2048 * 4);
constexpr size_t WS_MASK = WS_SCS + al((size_t)MS * 16640 * 4);
constexpr size_t WS_END = WS_MASK + al((size_t)MP * 64 * 4);

constexpr int CW_BAR = 4096;
constexpr int CW_Q = 16384;

constexpr int RING_BYTES = 131072;
constexpr int LDSCTL_OFF = RING_BYTES, MISC_OFF = LDSCTL_OFF + 320;
constexpr int LDS_BYTES = 147456;

struct Args { const void* in[N_IN]; float* out; unsigned char* ws; };
typedef const __attribute__((address_space(4))) Args* KArgs;

__device__ __forceinline__ float wave_sum(float v) {
#pragma unroll
    for (int o = 1; o < 64; o <<= 1) v += __shfl_xor(v, o);
    return v;
}
__device__ __forceinline__ float silu_f(float x) { return x * __builtin_amdgcn_rcpf(1.0f + __expf(-x)); }
__device__ __forceinline__ float sigmoid_f(float x) { return __builtin_amdgcn_rcpf(1.0f + __expf(-x)); }

__device__ __forceinline__ void tr_item(const float* __restrict__ W, int ldw, int col0, int nvalid, int k0, bf16* WT, int ldt, int drow0, int dk0,
                                        const float* kscale, LAS float* scr, int lane) {
    const int c = lane & 31;
#pragma unroll 8
    for (int i = 0; i < 32; ++i) {
        const int kk = 2 * i + (lane >> 5);
        float v = (c < nvalid) ? W[(size_t)(k0 + kk) * ldw + col0 + c] : 0.f;
        if (kscale) v *= kscale[k0 + kk];
        scr[kk * 33 + c] = v;
    }
    LDS_WAIT(); asm volatile("" ::: "memory");
    const int c8 = lane & 7;
#pragma unroll
    for (int j = 0; j < 4; ++j) {
        const int n = (lane >> 3) + 8 * j; const LAS float* s = scr + (8 * c8) * 33 + n;
        v4u o; o.x = pk2(s[0 * 33], s[1 * 33]); o.y = pk2(s[2 * 33], s[3 * 33]); o.z = pk2(s[4 * 33], s[5 * 33]); o.w = pk2(s[6 * 33], s[7 * 33]);
        *(GAS v4u*)(WT + (size_t)(drow0 + n) * ldt + dk0 + k0 + 8 * c8) = o;
    }
    LDS_WAIT(); asm volatile("" ::: "memory");
}

__device__ __forceinline__ void rms_row_bf16(const float* xrow, const float* g, bf16* orow, int lane) {
    const GAS f32x4* xr = (const GAS f32x4*)xrow + lane; const GAS f32x4* gr = (const GAS f32x4*)g + lane;
    f32x4 v[4]; float s = 0.f;
#pragma unroll
    for (int j = 0; j < 4; ++j) { v[j] = xr[64 * j]; s += (v[j].x * v[j].x + v[j].y * v[j].y) + (v[j].z * v[j].z + v[j].w * v[j].w); }
    const float rs = 1.0f / sqrtf(wave_sum(s) * (1.0f / DM) + EPS);
    GAS unsigned long long* o8 = (GAS unsigned long long*)orow + lane;
#pragma unroll
    for (int j = 0; j < 4; ++j) { const f32x4 gg = gr[64 * j];
        o8[64 * j] = (unsigned long long)pk2(v[j].x * rs * gg.x, v[j].y * rs * gg.y) | ((unsigned long long)pk2(v[j].z * rs * gg.z, v[j].w * rs * gg.w) << 32); }
}
__device__ __forceinline__ void cvt_row_bf16(const float* xrow, bf16* orow, int lane) {
    const GAS f32x4* xr = (const GAS f32x4*)xrow + lane; GAS unsigned long long* o8 = (GAS unsigned long long*)orow + lane;
#pragma unroll
    for (int j = 0; j < 4; ++j) { const f32x4 v = xr[64 * j]; o8[64 * j] = (unsigned long long)pk2(v.x, v.y) | ((unsigned long long)pk2(v.z, v.w) << 32); }
}
__device__ __forceinline__ void post_norm_row(const float* hin, const float* frow, const float* post_g, float rscale, float* hout, const float* pre_g, bf16* urow, int lane) {
    const GAS f32x4* fr = (const GAS f32x4*)frow + lane; const GAS f32x4* hr = (const GAS f32x4*)hin + lane; const GAS f32x4* pg = (const GAS f32x4*)post_g + lane;
    f32x4 f[4], h[4]; float s = 0.f;
#pragma unroll
    for (int j = 0; j < 4; ++j) { f[j] = fr[64 * j]; h[j] = hr[64 * j]; s += (f[j].x * f[j].x + f[j].y * f[j].y) + (f[j].z * f[j].z + f[j].w * f[j].w); }
    const float rs = rscale / sqrtf(wave_sum(s) * (1.0f / DM) + EPS);
    float s2 = 0.f;
    GAS f32x4* ho = (GAS f32x4*)hout + lane;
#pragma unroll
    for (int j = 0; j < 4; ++j) { const f32x4 gg = pg[64 * j]; h[j] = h[j] + f[j] * rs * gg; ho[64 * j] = h[j];
        s2 += (h[j].x * h[j].x + h[j].y * h[j].y) + (h[j].z * h[j].z + h[j].w * h[j].w); }
    if (pre_g) {
        const float rs2 = 1.0f / sqrtf(wave_sum(s2) * (1.0f / DM) + EPS);
        const GAS f32x4* qg = (const GAS f32x4*)pre_g + lane; GAS unsigned long long* o8 = (GAS unsigned long long*)urow + lane;
#pragma unroll
        for (int j = 0; j < 4; ++j) { const f32x4 gg = qg[64 * j];
            o8[64 * j] = (unsigned long long)pk2(h[j].x * rs2 * gg.x, h[j].y * rs2 * gg.y) | ((unsigned long long)pk2(h[j].z * rs2 * gg.z, h[j].w * rs2 * gg.w) << 32); }
    }
}

constexpr int IT_GU = 176 * 16, IT_D = 32 * 44, IT_IN = 328 * 16, IT_BRS = 32 * 32, IT_SQ = 32 * 16, IT_MKV = 64 * 16, IT_CMV = DECB * 128;
constexpr int IT_W = 2 * IT_GU + 2 * IT_D + IT_IN + IT_BRS + 4 * IT_SQ + IT_MKV + IT_CMV;
constexpr int IT_ROWS = MT   + NB * 256   + DECB * 256  ;
__device__ __forceinline__ void prologue(KArgs a, LAS unsigned char* lds, int wave, int lane, int gw, int NGW) {
    unsigned char* ws = a->ws;
    LAS float* scr = (LAS float*)(lds + wave * 16384);
    for (int it = gw; it < IT_W + IT_ROWS; it += NGW) {
        int r = it;
        if (r < IT_GU) {
            const int db = r >> 4, kb = r & 15, tile = db >> 3, within = db & 7, half = within >> 2, sub = within & 3;
            tr_item((const float*)a->in[half ? I_F1WU : I_F1WG], FF, 128 * tile + 32 * sub, 32, 64 * kb, (bf16*)(ws + WS_WGU1), DM, 32 * db, 0, nullptr, scr, lane); continue; }
        r -= IT_GU;
        if (r < IT_GU) {
            const int db = r >> 4, kb = r & 15, tile = db >> 3, within = db & 7, half = within >> 2, sub = within & 3;
            tr_item((const float*)a->in[half ? I_F2WU : I_F2WG], FF, 128 * tile + 32 * sub, 32, 64 * kb, (bf16*)(ws + WS_WGU2), DM, 32 * db, 0, nullptr, scr, lane); continue; }
        r -= IT_GU;
        if (r < IT_D) { const int db = r / 44, kb = r % 44;
            tr_item((const float*)a->in[I_F1WD], DM, 32 * db, 32, 64 * kb, (bf16*)(ws + WS_WD1), FF, 32 * db, 0, nullptr, scr, lane); continue; }
        r -= IT_D;
        if (r < IT_D) { const int db = r / 44, kb = r % 44;
            tr_item((const float*)a->in[I_F2WD], DM, 32 * db, 32, 64 * kb, (bf16*)(ws + WS_WD2), FF, 32 * db, 0, nullptr, scr, lane); continue; }
        r -= IT_D;
        if (r < IT_IN) {
            const int db = r >> 4, kb = r & 15, d = 32 * db; int col, nv = 32;
            if (d < 6144) col = d;
            else if (d < 8192) col = d + 32;
            else if (d < 10240) col = d + 104;
            else if (d < 10272) col = d - 10240 + 6144;
            else if (d < 10336) col = d - 10272 + 8224;
            else if (d < 10368) { col = 8288; nv = 8; }
            else { col = 0; nv = 0; }
            tr_item((const float*)a->in[I_WIN], 10344, col, nv, 64 * kb, (bf16*)(ws + WS_WIN), DM, d, 0, nullptr, scr, lane); continue; }
        r -= IT_IN;
        if (r < IT_BRS) { const int db = r >> 5, kb = r & 31;
            tr_item((const float*)a->in[I_WBRS], DM, 32 * db, 32, 64 * kb, (bf16*)(ws + WS_WBRS), 2048, 32 * db, 0, (const float*)a->in[I_SSDG], scr, lane); continue; }
        r -= IT_BRS;
        if (r < 4 * IT_SQ) { const int w = r / IT_SQ, q = r % IT_SQ, db = q >> 4, kb = q & 15;
            const float* src = (const float*)a->in[w == 0 ? I_WBRA : w == 1 ? I_WOUT : w == 2 ? I_WMQ : I_WMO];
            bf16* dst = (bf16*)(ws + (w == 0 ? WS_WBRA : w == 1 ? WS_WOUT : w == 2 ? WS_WMQ : WS_WMO));
            tr_item(src, DM, 32 * db, 32, 64 * kb, dst, DM, 32 * db, 0, nullptr, scr, lane); continue; }
        r -= 4 * IT_SQ;
        if (r < IT_MKV) { const int db = r >> 4, kb = r & 15;
            tr_item((const float*)a->in[db < 32 ? I_WMK : I_WMV], DM, 32 * (db & 31), 32, 64 * kb, (bf16*)(ws + WS_WMKV), DM, 32 * db, 0, nullptr, scr, lane); continue; }
        r -= IT_MKV;
        if (r < IT_CMV) { const int b = r >> 7, q = r & 127, db = q >> 2, kb = q & 3;
            tr_item((const float*)a->in[I_CMV] + (size_t)b * 256 * DM, DM, 32 * db, 32, 64 * kb, (bf16*)(ws + WS_MVT) + (size_t)(NB + b) * DM * 256, 256, 32 * db, 0, nullptr, scr, lane); continue; }
        r -= IT_CMV;
        if (r < MT) {
            bf16* urow = (bf16*)(ws + WS_U) + (size_t)r * DM;
            if (r < MP) rms_row_bf16((const float*)a->in[I_XP] + (size_t)r * DM, (const float*)a->in[I_F1PRE], urow, lane);
            else if (r < MR) rms_row_bf16((const float*)a->in[I_XS] + (size_t)(r - MP) * DM, (const float*)a->in[I_F1PRE], urow, lane);
            else { GAS unsigned long long* o8 = (GAS unsigned long long*)urow + lane;
#pragma unroll
                for (int j = 0; j < 4; ++j) o8[64 * j] = 0ull; }
            continue; }
        r -= MT;
        if (r < NB * 256) { rms_row_bf16((const float*)a->in[I_MEMP] + (size_t)r * DM, (const float*)a->in[I_MEMKVG], (bf16*)(ws + WS_MN) + (size_t)r * DM, lane); continue; }
        r -= NB * 256;
        cvt_row_bf16((const float*)a->in[I_CMK] + (size_t)r * DM, (bf16*)(ws + WS_MKB) + (size_t)(NB * 256 + r) * DM, lane);
    }
}

namespace ssd {
typedef short s16x8 __attribute__((ext_vector_type(8)));
typedef float f4 __attribute__((ext_vector_type(4)));
typedef unsigned u2 __attribute__((ext_vector_type(2)));
typedef unsigned u4 __attribute__((ext_vector_type(4)));
constexpr int P_C = 272, P_S = 144;
constexpr int L_CS = 0, L_BS = 17408, L_BST = 34816, L_XT = 53248, L_XWT = 90112, L_HS = 99328, L_MS = 116736, L_DT = 125952, L_ACS = 126976, L_SSQ = 128000, L_END = 130048;
static_assert(L_END <= 131072, "ssd LDS");
__device__ __forceinline__ f4 mfma16(s16x8 a, s16x8 b, f4 c) { return __builtin_amdgcn_mfma_f32_16x16x32_bf16(a, b, c, 0, 0, 0); }
#define SSD_FRAG(off) (*(const LAS s16x8*)(lds + (off)))
#define SSD_LO(w) __uint_as_float((w) << 16)
#define SSD_HI(w) __uint_as_float((w) & 0xffff0000u)

__device__ __forceinline__ void ssd_unit(LAS unsigned char* lds, int tid_in, KArgs a_in, int seqrow0, int ntok, int g, int b, bool smp) {
    const int wave = __builtin_amdgcn_readfirstlane(tid_in >> 6);
    const int tb = wave & 3, ph = wave >> 2, nb = wave;
    const int nchunks = (ntok + 63) >> 6;
    f4 hacc[4][4];
    {
        const int lane = tid_in & 63, l15 = lane & 15, lq = lane >> 4;
        const float* h0 = smp ? (const float*)a_in->in[I_SSM] + (size_t)b * 32 * 64 * 128 : nullptr;
#pragma unroll
        for (int h = 0; h < 4; ++h)
#pragma unroll
            for (int pb = 0; pb < 4; ++pb) {
                if (h0) hacc[h][pb] = *(const f4*)(h0 + ((size_t)(4 * g + h) * 64 + 16 * pb + l15) * 128 + 16 * nb + 4 * lq);
                else hacc[h][pb] = (f4){0.f, 0.f, 0.f, 0.f};
            }
    }
    for (int c = 0; c < nchunks; ++c) {
        int tid = tid_in; asm volatile("" : "+v"(tid));
        KArgs a = a_in; asm volatile("" : "+s"(a));
        const bf16* XBC = (const bf16*)(a->ws + WS_XBC); const float* MISCB = (const float*)(a->ws + WS_MISC);
        const float* convw = (const float*)a->in[I_CONVW]; const float* convb = (const float*)a->in[I_CONVB]; const float* dtb = (const float*)a->in[I_DTB]; const float* alog = (const float*)a->in[I_ALOG];
        const float* conv_halo = smp ? (const float*)a->in[I_CONV] + (size_t)b * 3 * 4096 : nullptr;
        const int lane = tid & 63, l15 = lane & 15, lq = lane >> 4;
        const int nvalid = (ntok - 64 * c) < 64 ? (ntok - 64 * c) : 64;
        const int rowbase = seqrow0 + 64 * c;
        if (wave < 4) {
            const int s = lane; float dtv = 0.f;
            if (s < nvalid) { const float xr = MISCB[(size_t)(rowbase + s) * 256 + 4 * g + wave] + dtb[4 * g + wave]; dtv = xr > 20.f ? xr : log1pf(expf(xr)); }
            ((LAS float*)(lds + L_DT))[wave * 64 + s] = dtv;
        }
        {
            const int cg = tid >> 3, rs = tid & 7;
            const int col = (cg < 32) ? 256 * g + 8 * cg : (cg < 48 ? 2048 + 128 * g + 8 * (cg - 32) : 3072 + 128 * g + 8 * (cg - 48));
            u4 rawp[11];
#pragma unroll
            for (int i = 0; i < 11; ++i) {
                const int tl = 8 * rs - 3 + i, tseq = 64 * c + tl;
                if (tseq >= 0) rawp[i] = *(const u4*)(XBC + (size_t)(seqrow0 + tseq) * 4096 + col);
                else if (conv_halo) {
                    const f4 v0 = *(const f4*)(conv_halo + (size_t)(3 + tseq) * 4096 + col), v1 = *(const f4*)(conv_halo + (size_t)(3 + tseq) * 4096 + col + 4);
                    rawp[i].x = pk2(v0.x, v0.y); rawp[i].y = pk2(v0.z, v0.w); rawp[i].z = pk2(v1.x, v1.y); rawp[i].w = pk2(v1.z, v1.w);
                } else rawp[i] = (u4){0u, 0u, 0u, 0u};
            }
            const bool isB = (cg >= 32 && cg < 48);
            const int hh = cg >> 3, p0 = 8 * (cg & 7), n0 = 8 * (isB ? cg - 32 : cg - 48);
#define SSD_CONV_CH(j) \
                const float w0 = convw[col + j], w1 = convw[4096 + col + j], w2 = convw[2 * 4096 + col + j], w3 = convw[3 * 4096 + col + j], bb = convb[col + j]; \
                float r[11]; \
                _Pragma("unroll") for (int i = 0; i < 11; ++i) { const unsigned wd = rawp[i][j >> 1]; r[i] = (j & 1) ? SSD_HI(wd) : SSD_LO(wd); } \
                unsigned ob[8]; \
                _Pragma("unroll") for (int i = 0; i < 8; ++i) { \
                    float y = bb + w0 * r[i] + w1 * r[i + 1] + w2 * r[i + 2] + w3 * r[i + 3]; \
                    y = y * __builtin_amdgcn_rcpf(1.0f + __expf(-y)); \
                    if (8 * rs + i >= nvalid) y = 0.f; \
                    ob[i] = f2bf(y); } \
                u4 wt; wt.x = ob[0] | (ob[1] << 16); wt.y = ob[2] | (ob[3] << 16); wt.z = ob[4] | (ob[5] << 16); wt.w = ob[6] | (ob[7] << 16);
            if (wave < 4) {
#pragma unroll
                for (int j = 0; j < 8; ++j) { SSD_CONV_CH(j)
                    *(LAS u4*)(lds + L_XT + hh * 9216 + (p0 + j) * P_S + 16 * rs) = wt;
                    __builtin_amdgcn_sched_barrier(0); }
            } else {
                unsigned rowpk[8][4];
#pragma unroll
                for (int i = 0; i < 8; ++i)
#pragma unroll
                    for (int q = 0; q < 4; ++q) rowpk[i][q] = 0u;
#pragma unroll
                for (int j = 0; j < 8; ++j) { SSD_CONV_CH(j)
#pragma unroll
                    for (int i = 0; i < 8; ++i) rowpk[i][j >> 1] |= ob[i] << (16 * (j & 1));
                    if (isB) *(LAS u4*)(lds + L_BST + (n0 + j) * P_S + 16 * rs) = wt;
                    __builtin_amdgcn_sched_barrier(0); }
#pragma unroll
                for (int i = 0; i < 8; ++i) { u4 w; w.x = rowpk[i][0]; w.y = rowpk[i][1]; w.z = rowpk[i][2]; w.w = rowpk[i][3];
                    *(LAS u4*)(lds + (isB ? L_BS : L_CS) + (8 * rs + i) * P_C + n0 * 2) = w; }
            }
#undef SSD_CONV_CH
        }
        __syncthreads();
        if (wave < 4) {
            const LAS float* dtl = (const LAS float*)(lds + L_DT) + wave * 64; const float av = -expf(alog[4 * g + wave]);
            float cs = 0.f;
            for (int s2 = 0; s2 < 64; ++s2) { const float d = dtl[s2] * av; if (s2 <= lane) cs += d; }
            ((LAS float*)(lds + L_ACS))[wave * 64 + lane] = cs;
        }
        const int bC = l15 * P_C + 16 * lq, bS = l15 * P_S + 16 * lq;
        s16x8 cfr[4], btf[2];
#pragma unroll
        for (int ks = 0; ks < 4; ++ks) cfr[ks] = SSD_FRAG(bC + L_CS + 16 * tb * P_C + 64 * ks);
#pragma unroll
        for (int ks = 0; ks < 2; ++ks) btf[ks] = SSD_FRAG(bS + L_BST + 16 * nb * P_S + 64 * ks);
        f4 gt[2];
#pragma unroll
        for (int sbi = 0; sbi < 2; ++sbi) { gt[sbi] = (f4){0.f, 0.f, 0.f, 0.f};
#pragma unroll
            for (int ks = 0; ks < 4; ++ks) gt[sbi] = mfma16(SSD_FRAG(bC + L_BS + 16 * (2 * ph + sbi) * P_C + 64 * ks), cfr[ks], gt[sbi]); }
        const int tcol = 16 * tb + l15;
        float sq = 0.f;
        KArgs a2 = a_in; asm volatile("" : "+s"(a2));
        const bf16* Z = (const bf16*)(a2->ws + WS_Z); bf16* YS = (bf16*)(a2->ws + WS_YS); const float* dskip = (const float*)a2->in[I_DSKIP];
        __syncthreads();
#pragma unroll
        for (int h = 0; h < 4; ++h) {
            const LAS float* dtl = (const LAS float*)(lds + L_DT) + h * 64; const LAS float* acl = (const LAS float*)(lds + L_ACS) + h * 64;
            const float acs_end = acl[63], acs_t = acl[tcol];
#pragma unroll
            for (int pb = 0; pb < 4; ++pb) { const f4 v = hacc[h][pb]; u2 w; w.x = pk2(v.x, v.y); w.y = pk2(v.z, v.w);
                *(LAS u2*)(lds + L_HS + (16 * pb + l15) * P_C + (16 * nb + 4 * lq) * 2) = w; }
            { const int p = tid >> 3, s0 = 8 * (tid & 7);
              const u4 xv = *(const LAS u4*)(lds + L_XT + h * 9216 + p * P_S + s0 * 2);
              const f4 d0 = *(const LAS f4*)(dtl + s0), d1 = *(const LAS f4*)(dtl + s0 + 4), a0 = *(const LAS f4*)(acl + s0), a1 = *(const LAS f4*)(acl + s0 + 4);
              u4 w;
              w.x = pk2(SSD_LO(xv.x) * d0.x * __expf(acs_end - a0.x), SSD_HI(xv.x) * d0.y * __expf(acs_end - a0.y));
              w.y = pk2(SSD_LO(xv.y) * d0.z * __expf(acs_end - a0.z), SSD_HI(xv.y) * d0.w * __expf(acs_end - a0.w));
              w.z = pk2(SSD_LO(xv.z) * d1.x * __expf(acs_end - a1.x), SSD_HI(xv.z) * d1.y * __expf(acs_end - a1.y));
              w.w = pk2(SSD_LO(xv.w) * d1.z * __expf(acs_end - a1.z), SSD_HI(xv.w) * d1.w * __expf(acs_end - a1.w));
              *(LAS u4*)(lds + L_XWT + p * P_S + s0 * 2) = w; }
#pragma unroll
            for (int sbi = 0; sbi < 2; ++sbi) { const int s0 = 16 * (2 * ph + sbi) + 4 * lq;
                const f4 as = *(const LAS f4*)(acl + s0), ds = *(const LAS f4*)(dtl + s0); const f4 gv = gt[sbi];
                const float m0 = (s0 + 0 <= tcol) ? gv.x * __expf(acs_t - as.x) * ds.x : 0.f, m1 = (s0 + 1 <= tcol) ? gv.y * __expf(acs_t - as.y) * ds.y : 0.f;
                const float m2 = (s0 + 2 <= tcol) ? gv.z * __expf(acs_t - as.z) * ds.z : 0.f, m3 = (s0 + 3 <= tcol) ? gv.w * __expf(acs_t - as.w) * ds.w : 0.f;
                u2 w; w.x = pk2(m0, m1); w.y = pk2(m2, m3);
                *(LAS u2*)(lds + L_MS + tcol * P_S + s0 * 2) = w; }
            __syncthreads();
            const float e_t = __expf(acs_t), dsk = dskip[4 * g + h];
#pragma unroll
            for (int pbi = 0; pbi < 2; ++pbi) { const int pb = 2 * ph + pbi; f4 y = (f4){0.f, 0.f, 0.f, 0.f};
#pragma unroll
                for (int ks = 0; ks < 4; ++ks) y = mfma16(SSD_FRAG(bC + L_HS + 16 * pb * P_C + 64 * ks), cfr[ks], y);
                y = y * e_t;
#pragma unroll
                for (int ks = 0; ks < 2; ++ks) y = mfma16(SSD_FRAG(bS + L_XT + h * 9216 + 16 * pb * P_S + 64 * ks), SSD_FRAG(bS + L_MS + 16 * tb * P_S + 64 * ks), y);
                const int p0 = 16 * pb + 4 * lq;
                const LAS unsigned short* xp = (const LAS unsigned short*)(lds + L_XT + h * 9216 + p0 * P_S + tcol * 2);
                y.x += dsk * SSD_LO((unsigned)xp[0]); y.y += dsk * SSD_LO((unsigned)xp[P_S / 2]); y.z += dsk * SSD_LO((unsigned)xp[P_S]); y.w += dsk * SSD_LO((unsigned)xp[3 * P_S / 2]);
                if (tcol < nvalid) {
                    const u2 zz = *(const u2*)(Z + (size_t)(rowbase + tcol) * 2048 + 256 * g + 64 * h + p0);
                    y.x *= silu_f(SSD_LO(zz.x)); y.y *= silu_f(SSD_HI(zz.x)); y.z *= silu_f(SSD_LO(zz.y)); y.w *= silu_f(SSD_HI(zz.y));
                    u2 w; w.x = pk2(y.x, y.y); w.y = pk2(y.z, y.w);
                    *(u2*)(YS + (size_t)(rowbase + tcol) * 2048 + 256 * g + 64 * h + p0) = w;
                    const float q0 = SSD_LO(w.x), q1 = SSD_HI(w.x), q2 = SSD_LO(w.y), q3 = SSD_HI(w.y);
                    sq += (q0 * q0 + q1 * q1) + (q2 * q2 + q3 * q3);
                }
                __builtin_amdgcn_sched_barrier(0); }
            const float e_end = __expf(acs_end);
#pragma unroll
            for (int pb = 0; pb < 4; ++pb) { f4 v = hacc[h][pb] * e_end;
#pragma unroll
                for (int ks = 0; ks < 2; ++ks) v = mfma16(btf[ks], SSD_FRAG(bS + L_XWT + 16 * pb * P_S + 64 * ks), v);
                hacc[h][pb] = v; }
            __syncthreads();
        }
        ((LAS float*)(lds + L_SSQ))[(ph * 4 + lq) * 64 + tcol] = sq;
        __syncthreads();
        float tot = 0.f;
#pragma unroll
        for (int q = 0; q < 8; ++q) tot += ((const LAS float*)(lds + L_SSQ))[q * 64 + tcol];
        const float rsn = 1.0f / sqrtf(tot * (1.0f / 256.0f) + EPS);
        if (tcol < nvalid) {
#pragma unroll
            for (int h = 0; h < 4; ++h)
#pragma unroll
                for (int pbi = 0; pbi < 2; ++pbi) { u2* yp = (u2*)(YS + (size_t)(rowbase + tcol) * 2048 + 256 * g + 64 * h + 16 * (2 * ph + pbi) + 4 * lq);
                    const u2 w = *yp; u2 o;
                    o.x = pk2(SSD_LO(w.x) * rsn, SSD_HI(w.x) * rsn); o.y = pk2(SSD_LO(w.y) * rsn, SSD_HI(w.y) * rsn);
                    *yp = o; }
        }
        __syncthreads();
    }
    {
        const int lane = tid_in & 63, l15 = lane & 15, lq = lane >> 4;
        float* hout = a_in->out + (smp ? O_SSMS : O_SSMP) + (size_t)b * 32 * 64 * 128;
#pragma unroll
        for (int h = 0; h < 4; ++h)
#pragma unroll
            for (int pb = 0; pb < 4; ++pb) *(f4*)(hout + ((size_t)(4 * g + h) * 64 + 16 * pb + l15) * 128 + 16 * nb + 4 * lq) = hacc[h][pb];
    }
}
}

namespace dsa {
typedef short s16x8 __attribute__((ext_vector_type(8)));
typedef short s16x4 __attribute__((ext_vector_type(4)));
typedef float f4 __attribute__((ext_vector_type(4)));
typedef float f16v __attribute__((ext_vector_type(16)));
typedef unsigned u2 __attribute__((ext_vector_type(2)));
typedef unsigned u4 __attribute__((ext_vector_type(4)));
__device__ __forceinline__ f16v mfma32(s16x8 a, s16x8 b, f16v c) { return __builtin_amdgcn_mfma_f32_32x32x16_bf16(a, b, c, 0, 0, 0); }
__device__ __forceinline__ unsigned f2key(float f) { const unsigned b = __float_as_uint(f + 0.0f); return (b & 0x80000000u) ? ~b : (b | 0x80000000u); }
__device__ __forceinline__ int wave_count(bool p) { return (int)__builtin_popcountll(__builtin_amdgcn_ballot_w64(p)); }
__device__ __forceinline__ unsigned lower_count(bool p) { const unsigned long long bm = __builtin_amdgcn_ballot_w64(p);
    return __builtin_amdgcn_mbcnt_hi((unsigned)(bm >> 32), __builtin_amdgcn_mbcnt_lo((unsigned)bm, 0u)); }

__device__ __forceinline__ void idx_tile(const s16x8 (&afr)[4], const s16x8 (&bfr)[4], const f4 (&wv)[4], float (&sc)[4]) {
    f16v d;
#pragma unroll
    for (int i = 0; i < 16; ++i) d[i] = 0.f;
#pragma unroll
    for (int ks = 0; ks < 4; ++ks) d = mfma32(afr[ks], bfr[ks], d);
#pragma unroll
    for (int tq = 0; tq < 4; ++tq) {
        float p = wv[tq].x * fmaxf(d[4 * tq + 0], 0.f) + wv[tq].y * fmaxf(d[4 * tq + 1], 0.f) + wv[tq].z * fmaxf(d[4 * tq + 2], 0.f) + wv[tq].w * fmaxf(d[4 * tq + 3], 0.f);
        p += __shfl_xor(p, 32);
        sc[tq] = p;
    }
}

__device__ __forceinline__ unsigned topk256_wave(const unsigned (&key)[32]) {
    unsigned prefix = 0u;
    for (int bit = 31; bit >= 0; --bit) {
        const unsigned cand = prefix | (1u << bit);
        int cnt = 0;
#pragma unroll
        for (int i = 0; i < 32; ++i) cnt += wave_count(key[i] >= cand);
        if (cnt >= 256) prefix = cand;
    }
    unsigned p1 = prefix; asm volatile("" : "+s"(p1));
    int cgt = 0;
#pragma unroll
    for (int i = 0; i < 32; ++i) cgt += wave_count(key[i] > p1);
    unsigned p2 = prefix; asm volatile("" : "+s"(p2));
    unsigned lower = 0u;
#pragma unroll
    for (int i = 0; i < 32; ++i) lower += lower_count(key[i] == p2);
    const unsigned need = (unsigned)(256 - cgt);
    unsigned p3 = prefix; asm volatile("" : "+s"(p3));
    unsigned word = 0u, run = lower;
#pragma unroll
    for (int i = 0; i < 32; ++i) { bool sel = key[i] > p3; if (key[i] == p3) { sel = run < need; ++run; } word |= sel ? (1u << i) : 0u; }
    return word;
}

__device__ __forceinline__ void idx_prompt_unit(int tid, const bf16* __restrict__ QI, const bf16* __restrict__ KIB, const float* __restrict__ MISCB, float* __restrict__ SC, unsigned* __restrict__ MASK,
                                                int b, int qblk) {
    const int lane = tid & 63, wave = __builtin_amdgcn_readfirstlane(tid >> 6), r = lane & 31, hi = lane >> 5;
    const int qrow0 = b * SEQ + 32 * qblk + 4 * wave;
    if (qblk < 8) {
#pragma unroll
        for (int tq = 0; tq < 4; ++tq) { const int t = 32 * qblk + 4 * wave + tq, rel = t - 32 * lane;
            const unsigned word = rel >= 31 ? 0xffffffffu : (rel < 0 ? 0u : ((2u << rel) - 1u));
            MASK[(size_t)(qrow0 + tq) * 64 + lane] = word; }
        return;
    }
    s16x8 afr[4]; f4 wv[4];
#pragma unroll
    for (int ks = 0; ks < 4; ++ks) afr[ks] = *(const s16x8*)(QI + (size_t)qrow0 * 512 + r * 64 + 16 * ks + 8 * hi);
#pragma unroll
    for (int tq = 0; tq < 4; ++tq) wv[tq] = *(const f4*)(MISCB + (size_t)(qrow0 + tq) * 256 + 96 + 4 * hi);
    const int nkt = qblk + 1;
    for (int kt = 0; kt < nkt; ++kt) {
        s16x8 bfr[4];
#pragma unroll
        for (int ks = 0; ks < 4; ++ks) bfr[ks] = *(const s16x8*)(KIB + (size_t)(b * SEQ + 32 * kt + r) * 64 + 16 * ks + 8 * hi);
        float sc[4]; idx_tile(afr, bfr, wv, sc);
        SC[(size_t)(qrow0 + 2 * hi) * 2048 + 32 * kt + r] = hi ? sc[2] : sc[0];
        SC[(size_t)(qrow0 + 2 * hi + 1) * 2048 + 32 * kt + r] = hi ? sc[3] : sc[1];
    }
    asm volatile("s_waitcnt vmcnt(0)" ::: "memory");
    for (int tq = 0; tq < 4; ++tq) {
        const int t = 32 * qblk + 4 * wave + tq;
        unsigned key[32];
        const float* srow = SC + (size_t)(qrow0 + tq) * 2048 + 32 * lane;
        if (32 * lane <= t) {
#pragma unroll
            for (int i4 = 0; i4 < 8; ++i4) { const f4 v = *(const f4*)(srow + 4 * i4);
                key[4 * i4 + 0] = (32 * lane + 4 * i4 + 0 <= t) ? f2key(v.x) : 0u; key[4 * i4 + 1] = (32 * lane + 4 * i4 + 1 <= t) ? f2key(v.y) : 0u;
                key[4 * i4 + 2] = (32 * lane + 4 * i4 + 2 <= t) ? f2key(v.z) : 0u; key[4 * i4 + 3] = (32 * lane + 4 * i4 + 3 <= t) ? f2key(v.w) : 0u; }
        } else {
#pragma unroll
            for (int i = 0; i < 32; ++i) key[i] = 0u;
        }
        const unsigned word = topk256_wave(key);
        MASK[(size_t)(qrow0 + tq) * 64 + lane] = word;
    }
}

__device__ __forceinline__ void idx_sample_unit(int tid, const bf16* __restrict__ QI, const float* __restrict__ MISCB, const float* __restrict__ ckidx, const int* __restrict__ ptab,
                                                float* __restrict__ SCS, int b, int range) {
    const int lane = tid & 63, wave = __builtin_amdgcn_readfirstlane(tid >> 6), r = lane & 31, hi = lane >> 5;
    const int qrow0 = MP + 4 * b;
    s16x8 afr[4]; f4 wv[4];
#pragma unroll
    for (int ks = 0; ks < 4; ++ks) afr[ks] = *(const s16x8*)(QI + (size_t)qrow0 * 512 + r * 64 + 16 * ks + 8 * hi);
#pragma unroll
    for (int tq = 0; tq < 4; ++tq) wv[tq] = *(const f4*)(MISCB + (size_t)(qrow0 + tq) * 256 + 96 + 4 * hi);
    for (int k8 = 0; k8 < 8; ++k8) {
        const int s = range * 2048 + 32 * (wave * 8 + k8) + r;
        const int page = ptab[b * NPAGE + (s >> 7)];
        const float* src = ckidx + ((size_t)page * PAGE + (s & 127)) * 64 + 8 * hi;
        s16x8 bfr[4];
#pragma unroll
        for (int ks = 0; ks < 4; ++ks) { const f4 v0 = *(const f4*)(src + 16 * ks), v1 = *(const f4*)(src + 16 * ks + 4);
            u4 w; w.x = pk2(v0.x, v0.y); w.y = pk2(v0.z, v0.w); w.z = pk2(v1.x, v1.y); w.w = pk2(v1.z, v1.w); bfr[ks] = __builtin_bit_cast(s16x8, w); }
        float sc[4]; idx_tile(afr, bfr, wv, sc);
        SCS[(size_t)(4 * b + 2 * hi) * 16640 + s] = hi ? sc[2] : sc[0];
        SCS[(size_t)(4 * b + 2 * hi + 1) * 16640 + s] = hi ? sc[3] : sc[1];
    }
}

constexpr int AT_KP = 144;
constexpr int AT_K = 0, AT_V = 2 * 64 * AT_KP, AT_END = 4 * 64 * AT_KP;
__device__ __forceinline__ int crow(int reg, int hi) { return (reg & 3) + 8 * (reg >> 2) + 4 * hi; }
__device__ __forceinline__ void attn_prompt_unit(LAS unsigned char* lds, int tid, const bf16* __restrict__ Q, const bf16* __restrict__ KB, const bf16* __restrict__ VT, const unsigned* __restrict__ MASK,
                                                 bf16* __restrict__ YA, int b, int kvh, int qb) {
    const int lane = tid & 63, wave = __builtin_amdgcn_readfirstlane(tid >> 6), r = lane & 31, hi = lane >> 5;
    const int qrow = b * SEQ + 64 * qb + 8 * wave + (r >> 2), head = 4 * kvh + (r & 3);
    s16x8 qf[4];
#pragma unroll
    for (int ks = 0; ks < 4; ++ks) qf[ks] = *(const s16x8*)(Q + (size_t)qrow * 1024 + head * 64 + 16 * ks + 8 * hi);
    const int nkt = qb + 1;
    const int srow = tid >> 3, sch = tid & 7;
    const bf16* kg = KB + (size_t)(b * SEQ + srow) * 256 + kvh * 64 + 8 * sch;
    const bf16* vg = VT + (size_t)(b * 256 + kvh * 64 + srow) * SEQ + 8 * sch;
    u4 kreg = *(const u4*)kg, vreg = *(const u4*)vg;
    f16v o0, o1;
#pragma unroll
    for (int i = 0; i < 16; ++i) { o0[i] = 0.f; o1[i] = 0.f; }
    float mrun = -1e30f, lsum = 0.f;
    const float c2 = 0.125f * 1.4426950408889634f;
    for (int kt = 0; kt < nkt; ++kt) {
        LAS unsigned char* kl = lds + AT_K + (kt & 1) * 64 * AT_KP; LAS unsigned char* vl = lds + AT_V + (kt & 1) * 64 * AT_KP;
        *(LAS u4*)(kl + srow * AT_KP + 16 * sch) = kreg; *(LAS u4*)(vl + srow * AT_KP + 16 * sch) = vreg;
        __syncthreads();
        if (kt + 1 < nkt) { kreg = *(const u4*)(kg + (size_t)(kt + 1) * 64 * 256); vreg = *(const u4*)(vg + (kt + 1) * 64); }
        const u2 mw = *(const u2*)(MASK + (size_t)qrow * 64 + 2 * kt);
        f16v s0, s1;
#pragma unroll
        for (int i = 0; i < 16; ++i) { s0[i] = 0.f; s1[i] = 0.f; }
#pragma unroll
        for (int ks = 0; ks < 4; ++ks) {
            s0 = mfma32(*(const LAS s16x8*)(kl + r * AT_KP + 32 * ks + 16 * hi), qf[ks], s0);
            s1 = mfma32(*(const LAS s16x8*)(kl + (32 + r) * AT_KP + 32 * ks + 16 * hi), qf[ks], s1);
        }
        float mt = -1e30f;
#pragma unroll
        for (int i = 0; i < 16; ++i) { const int bit = crow(i, hi);
            s0[i] = ((mw.x >> bit) & 1u) ? s0[i] * c2 : -1e30f; s1[i] = ((mw.y >> bit) & 1u) ? s1[i] * c2 : -1e30f;
            mt = fmaxf(mt, fmaxf(s0[i], s1[i])); }
        mt = fmaxf(mt, __shfl_xor(mt, 32));
        const float mnew = fmaxf(mrun, mt), scale = __builtin_amdgcn_exp2f(mrun - mnew);
        mrun = mnew;
        float ps = 0.f;
#pragma unroll
        for (int i = 0; i < 16; ++i) { s0[i] = (s0[i] > -1e29f) ? __builtin_amdgcn_exp2f(s0[i] - mnew) : 0.f; s1[i] = (s1[i] > -1e29f) ? __builtin_amdgcn_exp2f(s1[i] - mnew) : 0.f; ps += s0[i] + s1[i]; }
        lsum = lsum * scale + ps;
#pragma unroll
        for (int i = 0; i < 16; ++i) { o0[i] *= scale; o1[i] *= scale; }
        s16x8 pf[2][2];
#pragma unroll
        for (int s = 0; s < 2; ++s) {
            u4 w; w.x = pk2(s0[8 * s + 0], s0[8 * s + 1]); w.y = pk2(s0[8 * s + 2], s0[8 * s + 3]); w.z = pk2(s0[8 * s + 4], s0[8 * s + 5]); w.w = pk2(s0[8 * s + 6], s0[8 * s + 7]); pf[0][s] = __builtin_bit_cast(s16x8, w);
            u4 x; x.x = pk2(s1[8 * s + 0], s1[8 * s + 1]); x.y = pk2(s1[8 * s + 2], s1[8 * s + 3]); x.z = pk2(s1[8 * s + 4], s1[8 * s + 5]); x.w = pk2(s1[8 * s + 6], s1[8 * s + 7]); pf[1][s] = __builtin_bit_cast(s16x8, x);
        }
#pragma unroll
        for (int rt = 0; rt < 2; ++rt)
#pragma unroll
            for (int s = 0; s < 2; ++s) {
                const int kb = (32 * rt + 16 * s + 4 * hi) * 2;
                const u2 a0 = *(const LAS u2*)(vl + r * AT_KP + kb), a1 = *(const LAS u2*)(vl + r * AT_KP + kb + 16);
                const u2 b0 = *(const LAS u2*)(vl + (32 + r) * AT_KP + kb), b1 = *(const LAS u2*)(vl + (32 + r) * AT_KP + kb + 16);
                u4 fa; fa.x = a0.x; fa.y = a0.y; fa.z = a1.x; fa.w = a1.y; u4 fb; fb.x = b0.x; fb.y = b0.y; fb.z = b1.x; fb.w = b1.y;
                o0 = mfma32(__builtin_bit_cast(s16x8, fa), pf[rt][s], o0);
                o1 = mfma32(__builtin_bit_cast(s16x8, fb), pf[rt][s], o1);
            }
    }
    lsum += __shfl_xor(lsum, 32);
    const float inv = 1.0f / lsum;
    bf16* yo = YA + (size_t)qrow * 1024 + head * 64;
#pragma unroll
    for (int g4 = 0; g4 < 4; ++g4) {
        u2 w; w.x = pk2(o0[4 * g4 + 0] * inv, o0[4 * g4 + 1] * inv); w.y = pk2(o0[4 * g4 + 2] * inv, o0[4 * g4 + 3] * inv);
        *(u2*)(yo + 8 * g4 + 4 * hi) = w;
        u2 x; x.x = pk2(o1[4 * g4 + 0] * inv, o1[4 * g4 + 1] * inv); x.y = pk2(o1[4 * g4 + 2] * inv, o1[4 * g4 + 3] * inv);
        *(u2*)(yo + 32 + 8 * g4 + 4 * hi) = x;
    }
    __syncthreads();
}

constexpr int SM_Q = 0  , SM_QI = 4096  , SM_WI = 6144  , SM_TMP = 6208  , SM_SCN = 6336  , SM_CNT = 6400  ,
              SM_WOFF = 6528  , SM_SEL = 6656  , SM_S = 8192  , SM_END = 8192 + 16384;
__device__ __forceinline__ void sample_query_unit(LAS unsigned char* lds, int tid, const bf16* __restrict__ Q, const bf16* __restrict__ QI, const float* __restrict__ MISCB, const float* __restrict__ SCS,
                                                  const float* __restrict__ ck, const float* __restrict__ cv, const int* __restrict__ ptab, const float* __restrict__ out, bf16* __restrict__ YA, int b, int tq) {
    const int lane = tid & 63, wave = __builtin_amdgcn_readfirstlane(tid >> 6);
    const int qrow = MP + 4 * b + tq;
    LAS float* q_l = (LAS float*)(lds + SM_Q); LAS float* qi_l = (LAS float*)(lds + SM_QI); LAS float* wi_l = (LAS float*)(lds + SM_WI); LAS float* tmp_l = (LAS float*)(lds + SM_TMP);
    LAS float* scn_l = (LAS float*)(lds + SM_SCN); LAS unsigned* cnt_l = (LAS unsigned*)(lds + SM_CNT); LAS unsigned* woff_l = (LAS unsigned*)(lds + SM_WOFF);
    LAS int* sel_l = (LAS int*)(lds + SM_SEL); LAS float* s_l = (LAS float*)(lds + SM_S);
    { const unsigned w = *(const unsigned*)(Q + (size_t)qrow * 1024 + 2 * tid); q_l[2 * tid] = __uint_as_float(w << 16); q_l[2 * tid + 1] = __uint_as_float(w & 0xffff0000u); }
    { const unsigned short w = QI[(size_t)qrow * 512 + tid]; qi_l[tid] = __uint_as_float((unsigned)w << 16); }
    if (tid < 8) wi_l[tid] = MISCB[(size_t)qrow * 256 + 96 + tid];
    __syncthreads();
    if (tid < 32) {
        const int h = tid >> 2, kk = tid & 3; const float* kin = MISCB + (size_t)(MP + 4 * b + kk) * 256 + 32; float d = 0.f;
        for (int e = 0; e < 64; ++e) d += qi_l[h * 64 + e] * kin[e];
        tmp_l[tid] = wi_l[h] * fmaxf(d, 0.f);
    }
    __syncthreads();
    if (tid < 4) { float s = 0.f; for (int h = 0; h < 8; ++h) s += tmp_l[h * 4 + tid]; scn_l[tid] = s; }
    __syncthreads();
    unsigned key[36];
    { const float* srow = SCS + (size_t)(4 * b + tq) * 16640 + 32 * tid;
#pragma unroll
      for (int i4 = 0; i4 < 8; ++i4) { const f4 v = *(const f4*)(srow + 4 * i4); key[4 * i4] = f2key(v.x); key[4 * i4 + 1] = f2key(v.y); key[4 * i4 + 2] = f2key(v.z); key[4 * i4 + 3] = f2key(v.w); }
#pragma unroll
      for (int e = 0; e < 4; ++e) key[32 + e] = (tid == 511 && e <= tq) ? f2key(scn_l[e]) : 0u; }
    unsigned prefix = 0u;
    for (int bit = 31; bit >= 0; --bit) {
        const unsigned cand = prefix | (1u << bit);
        int cnt = 0;
#pragma unroll
        for (int i = 0; i < 36; ++i) cnt += (key[i] >= cand) ? 1 : 0;
#pragma unroll
        for (int o = 1; o < 64; o <<= 1) cnt += __shfl_xor(cnt, o);
        if (lane == 0) cnt_l[(bit & 1) * 8 + wave] = (unsigned)cnt;
        __syncthreads();
        unsigned tot = 0u;
#pragma unroll
        for (int w = 0; w < 8; ++w) tot += cnt_l[(bit & 1) * 8 + w];
        if (tot >= 256u) prefix = cand;
    }
    int cgt = 0, ceq = 0;
#pragma unroll
    for (int i = 0; i < 36; ++i) { cgt += (key[i] > prefix) ? 1 : 0; ceq += (key[i] == prefix) ? 1 : 0; }
    int sgt = cgt, seq = ceq;
#pragma unroll
    for (int o = 1; o < 64; o <<= 1) { const int v0 = __shfl_up(sgt, o), v1 = __shfl_up(seq, o); if (lane >= o) { sgt += v0; seq += v1; } }
    __syncthreads();
    if (lane == 63) { cnt_l[wave] = (unsigned)sgt; cnt_l[8 + wave] = (unsigned)seq; }
    __syncthreads();
    unsigned tot_gt = 0u, eq_before = 0u;
#pragma unroll
    for (int w = 0; w < 8; ++w) { tot_gt += cnt_l[w]; if (w < wave) eq_before += cnt_l[8 + w]; }
    const unsigned need = 256u - tot_gt;
    unsigned long long selw = 0ull; unsigned run = eq_before + (unsigned)(seq - ceq);
    int csel = 0;
    asm volatile("" : "+v"(prefix));
#pragma unroll
    for (int i = 0; i < 36; ++i) { bool sel = key[i] > prefix; if (key[i] == prefix) { sel = run < need; ++run; } selw |= sel ? (1ull << i) : 0ull; csel += sel ? 1 : 0; }
    int ssel = csel;
#pragma unroll
    for (int o = 1; o < 64; o <<= 1) { const int v0 = __shfl_up(ssel, o); if (lane >= o) ssel += v0; }
    if (lane == 63) woff_l[wave] = (unsigned)ssel;
    __syncthreads();
    unsigned pos = (unsigned)(ssel - csel);
#pragma unroll
    for (int w = 0; w < 8; ++w) if (w < wave) pos += woff_l[w];
#pragma unroll
    for (int i = 0; i < 36; ++i) if ((selw >> i) & 1ull) {
        const int s = (i < 32) ? 32 * tid + i : PAST + (i - 32);
        const int idx = (s < PAST) ? ptab[b * NPAGE + (s >> 7)] * PAGE + (s & 127) : -1 - (s - PAST);
        if (pos < 256u) sel_l[pos] = idx;
        ++pos; }
    __syncthreads();
    {
        const int j = tid & 255, hh = tid >> 8, idx = sel_l[j];
        const float* krow = idx >= 0 ? ck + (size_t)idx * 256 : out + O_KS + (size_t)(4 * b + (-1 - idx)) * 256;
#pragma unroll
        for (int k2 = 0; k2 < 2; ++k2) {
            const int kvh = 2 * hh + k2; float d0 = 0.f, d1 = 0.f, d2 = 0.f, d3 = 0.f;
            for (int e4 = 0; e4 < 16; ++e4) { const f4 kv = *(const f4*)(krow + kvh * 64 + 4 * e4);
                const LAS float* qp = q_l + (4 * kvh) * 64 + 4 * e4;
                d0 += kv.x * qp[0] + kv.y * qp[1] + kv.z * qp[2] + kv.w * qp[3];
                d1 += kv.x * qp[64] + kv.y * qp[65] + kv.z * qp[66] + kv.w * qp[67];
                d2 += kv.x * qp[128] + kv.y * qp[129] + kv.z * qp[130] + kv.w * qp[131];
                d3 += kv.x * qp[192] + kv.y * qp[193] + kv.z * qp[194] + kv.w * qp[195]; }
            s_l[(4 * kvh + 0) * 256 + j] = d0 * 0.125f; s_l[(4 * kvh + 1) * 256 + j] = d1 * 0.125f; s_l[(4 * kvh + 2) * 256 + j] = d2 * 0.125f; s_l[(4 * kvh + 3) * 256 + j] = d3 * 0.125f;
        }
    }
    __syncthreads();
#pragma unroll
    for (int k2 = 0; k2 < 2; ++k2) {
        LAS float* sr = s_l + (2 * wave + k2) * 256;
        float v0 = sr[lane], v1 = sr[lane + 64], v2 = sr[lane + 128], v3 = sr[lane + 192];
        float mx = fmaxf(fmaxf(v0, v1), fmaxf(v2, v3));
#pragma unroll
        for (int o = 1; o < 64; o <<= 1) mx = fmaxf(mx, __shfl_xor(mx, o));
        v0 = __expf(v0 - mx); v1 = __expf(v1 - mx); v2 = __expf(v2 - mx); v3 = __expf(v3 - mx);
        const float inv = 1.0f / wave_sum((v0 + v1) + (v2 + v3));
        sr[lane] = v0 * inv; sr[lane + 64] = v1 * inv; sr[lane + 128] = v2 * inv; sr[lane + 192] = v3 * inv;
    }
    __syncthreads();
    {
        const int head = tid >> 5, d = 2 * (tid & 31), kvh = head >> 2; float a0 = 0.f, a1 = 0.f;
        for (int j = 0; j < 256; ++j) { const int idx = sel_l[j];
            const float* vrow = idx >= 0 ? cv + (size_t)idx * 256 : out + O_VS + (size_t)(4 * b + (-1 - idx)) * 256;
            typedef float f2v __attribute__((ext_vector_type(2)));
            const f2v vv = *(const f2v*)(vrow + kvh * 64 + d); const float p = s_l[head * 256 + j];
            a0 += p * vv.x; a1 += p * vv.y; }
        *(unsigned*)(YA + (size_t)qrow * 1024 + head * 64 + d) = pk2(a0, a1);
    }
    __syncthreads();
}
}

namespace pg8 {
__device__ __forceinline__ float ep_silu(float x) { return x * __builtin_amdgcn_rcpf(1.0f + __expf(-x)); }
__device__ __forceinline__ float ep_sigm(float x) { return __builtin_amdgcn_rcpf(1.0f + __expf(-x)); }
struct EpiGU {
    static constexpr bool PERM = true, AFTER_DRAIN = false;
    bf16_t* O;
    __device__ __forceinline__ void operator()(const f32x4 (&acc)[2][2][4][2], const Unit& u, int wr, int wc, int fr, int fq) const {
        const int row0 = u.pm * BM + wr * 64 + fr, col0 = u.pn * 128 + wc * 32 + 8 * fq;
#pragma unroll
        for (int ai = 0; ai < 2; ++ai)
#pragma unroll
            for (int m = 0; m < 4; ++m) {
                bf16_t* rowp = O + (size_t)(row0 + ai * HALF + m * 16) * 2816 + col0;
                const f32x4 g0 = acc[ai][0][m][0], g1 = acc[ai][0][m][1], u0 = acc[ai][1][m][0], u1 = acc[ai][1][m][1];
                u32x4 w;
                w.x = cvt_pk_bf16(ep_silu(g0[0]) * u0[0], ep_silu(g0[1]) * u0[1]); w.y = cvt_pk_bf16(ep_silu(g0[2]) * u0[2], ep_silu(g0[3]) * u0[3]);
                w.z = cvt_pk_bf16(ep_silu(g1[0]) * u1[0], ep_silu(g1[1]) * u1[1]); w.w = cvt_pk_bf16(ep_silu(g1[2]) * u1[2], ep_silu(g1[3]) * u1[3]);
                *(u32x4*)rowp = w;
            }
    }
};
struct EpiF32 {
    static constexpr bool PERM = false, AFTER_DRAIN = false;
    float* O; int ldc;
    __device__ __forceinline__ void operator()(const f32x4 (&acc)[2][2][4][2], const Unit& u, int wr, int wc, int fr, int fq) const {
        const int row0 = u.pm * BM + wr * 64 + fr, col0 = u.pn * BM + wc * 32 + 4 * fq;
#pragma unroll
        for (int ai = 0; ai < 2; ++ai)
#pragma unroll
            for (int m = 0; m < 4; ++m) { float* rowp = O + (size_t)(row0 + ai * HALF + m * 16) * ldc + col0;
#pragma unroll
                for (int bj = 0; bj < 2; ++bj)
#pragma unroll
                    for (int n = 0; n < 2; ++n) *(f32x4*)(rowp + bj * HALF + n * 16) = acc[ai][bj][m][n]; }
    }
};
struct EpiB16 {
    static constexpr bool PERM = true, AFTER_DRAIN = false;
    bf16_t* O; int ldc;
    __device__ __forceinline__ void operator()(const f32x4 (&acc)[2][2][4][2], const Unit& u, int wr, int wc, int fr, int fq) const {
        const int row0 = u.pm * BM + wr * 64 + fr, col0 = u.pn * BM + wc * 32 + 8 * fq;
#pragma unroll
        for (int ai = 0; ai < 2; ++ai)
#pragma unroll
            for (int m = 0; m < 4; ++m) { bf16_t* rowp = O + (size_t)(row0 + ai * HALF + m * 16) * ldc + col0;
#pragma unroll
                for (int bj = 0; bj < 2; ++bj) { const f32x4 v0 = acc[ai][bj][m][0], v1 = acc[ai][bj][m][1]; u32x4 w;
                    w.x = cvt_pk_bf16(v0[0], v0[1]); w.y = cvt_pk_bf16(v0[2], v0[3]); w.z = cvt_pk_bf16(v1[0], v1[1]); w.w = cvt_pk_bf16(v1[2], v1[3]);
                    *(u32x4*)(rowp + bj * HALF) = w; } }
    }
};
struct EpiMemKV {
    static constexpr bool PERM = false, AFTER_DRAIN = false;
    float* outk; float* outv; bf16_t* mkb;
    __device__ __forceinline__ void operator()(const f32x4 (&acc)[2][2][4][2], const Unit& u, int wr, int wc, int fr, int fq) const {
        const bool isv = u.pn >= 4; float* O = isv ? outv : outk;
        const int row0 = u.pm * BM + wr * 64 + fr, col0 = (u.pn & 3) * BM + wc * 32 + 4 * fq;
#pragma unroll
        for (int ai = 0; ai < 2; ++ai)
#pragma unroll
            for (int m = 0; m < 4; ++m) { const size_t off = (size_t)(row0 + ai * HALF + m * 16) * 1024 + col0;
#pragma unroll
                for (int bj = 0; bj < 2; ++bj)
#pragma unroll
                    for (int n = 0; n < 2; ++n) { const f32x4 v = acc[ai][bj][m][n]; *(f32x4*)(O + off + bj * HALF + n * 16) = v;
                        if (!isv) { typedef unsigned u32x2v __attribute__((ext_vector_type(2))); u32x2v w; w.x = cvt_pk_bf16(v[0], v[1]); w.y = cvt_pk_bf16(v[2], v[3]);
                            *(u32x2v*)(mkb + off + bj * HALF + n * 16) = w; } } }
    }
};
struct EpiWin {
    static constexpr bool PERM = true, AFTER_DRAIN = false;
    bf16_t *Z, *XBC, *Q, *KB, *QI, *GS, *GA, *KIB; float* MISC; float* out;
    __device__ __forceinline__ void operator()(const f32x4 (&acc)[2][2][4][2], const Unit& u, int wr, int wc, int fr, int fq) const {
        const int pn = u.pn, row0 = u.pm * BM + wr * 64 + fr, cl = wc * 32 + 8 * fq;
        bf16_t* base = nullptr; int ld = 0, colt = 0, kind = 0;
        if (pn < 8) { base = Z; ld = 2048; colt = pn * 256; }
        else if (pn < 24) { base = XBC; ld = 4096; colt = (pn - 8) * 256; kind = 1; }
        else if (pn < 28) { base = Q; ld = 1024; colt = (pn - 24) * 256; }
        else if (pn == 28) { base = KB; ld = 256; colt = 0; kind = 2; }
        else if (pn == 29) { kind = 3; }
        else if (pn < 32) { base = QI; ld = 512; colt = (pn - 30) * 256; }
        else if (pn < 36) { base = GS; ld = 1024; colt = (pn - 32) * 256; }
        else if (pn < 40) { base = GA; ld = 1024; colt = (pn - 36) * 256; }
        else kind = 4;
#pragma unroll
        for (int ai = 0; ai < 2; ++ai)
#pragma unroll
            for (int m = 0; m < 4; ++m) {
                const int row = row0 + ai * HALF + m * 16;
#pragma unroll
                for (int bj = 0; bj < 2; ++bj) {
                    const int c = colt + bj * HALF + cl;
                    const f32x4 v0 = acc[ai][bj][m][0], v1 = acc[ai][bj][m][1];
                    u32x4 w; w.x = cvt_pk_bf16(v0[0], v0[1]); w.y = cvt_pk_bf16(v0[2], v0[3]); w.z = cvt_pk_bf16(v1[0], v1[1]); w.w = cvt_pk_bf16(v1[2], v1[3]);
                    if (base) *(u32x4*)(base + (size_t)row * ld + c) = w;
                    if (kind == 1) {
                        float* o = nullptr;
                        if (row < 16384) { const int tt = row & 2047; if (tt >= 2045) o = out + 28442624 + (size_t)((row >> 11) * 3 + (tt - 2045)) * 4096 + c; }
                        else if (row < 16512) { const int rs = row - 16384, t4 = rs & 3; if (t4 >= 1) o = out + 41197568 + (size_t)((rs >> 2) * 3 + (t4 - 1)) * 4096 + c; }
                        if (o) { *(f32x4*)o = v0; *(f32x4*)(o + 4) = v1; }
                    } else if (kind == 2 || kind == 3) {
                        float* o = nullptr;
                        if (row < 16384) o = out + (kind == 2 ? 16908288 : 21102592) + (size_t)row * 256 + c;
                        else if (row < 16512) o = out + (kind == 2 ? 32735232 : 32768000) + (size_t)(row - 16384) * 256 + c;
                        if (o) { *(f32x4*)o = v0; *(f32x4*)(o + 4) = v1; }
                    } else if (kind == 4) {
                        float* mo = MISC + (size_t)row * 256 + c; *(f32x4*)mo = v0; *(f32x4*)(mo + 4) = v1;
                        if (c >= 32 && c < 96) {
                            *(u32x4*)(KIB + (size_t)row * 64 + (c - 32)) = w;
                            float* o = nullptr;
                            if (row < 16384) o = out + 25296896 + (size_t)row * 64 + (c - 32);
                            else if (row < 16512) o = out + 32800768 + (size_t)(row - 16384) * 64 + (c - 32);
                            if (o) { *(f32x4*)o = v0; *(f32x4*)(o + 4) = v1; }
                        }
                    }
                }
            }
    }
};
}
static_assert(O_CONVP == 28442624 && O_CONVS == 41197568 && O_KP == 16908288 && O_VP == 21102592 && O_KS == 32735232 && O_VS == 32768000 && O_KIP == 25296896 && O_KIS == 32800768, "offsets used in EpiWin");


namespace mema {
typedef short s16x8 __attribute__((ext_vector_type(8)));
typedef float f4 __attribute__((ext_vector_type(4)));
typedef unsigned u2 __attribute__((ext_vector_type(2)));
typedef unsigned u4 __attribute__((ext_vector_type(4)));
__device__ __forceinline__ f4 mfma16(s16x8 a, s16x8 b, f4 c) { return __builtin_amdgcn_mfma_f32_16x16x32_bf16(a, b, c, 0, 0, 0); }
__device__ __forceinline__ void memattn_unit(int tid, const bf16* __restrict__ QM, const bf16* __restrict__ MKB, const bf16* __restrict__ MVT, bf16* __restrict__ OM,
                                             int bm, int head, int qrow0, int nq) {
    const int lane = tid & 63, wave = __builtin_amdgcn_readfirstlane(tid >> 6), l15 = lane & 15, lq = lane >> 4;
    if (16 * wave >= nq) return;
    const int t = 16 * wave + l15, qrow = qrow0 + (t < nq ? t : nq - 1);
    s16x8 qf[8];
#pragma unroll
    for (int ks = 0; ks < 8; ++ks) qf[ks] = *(const s16x8*)(QM + (size_t)qrow * 1024 + head * 256 + 32 * ks + 8 * lq);
    const bf16* mk = MKB + (size_t)bm * 256 * 1024 + head * 256 + (size_t)l15 * 1024 + 8 * lq;
    const bf16* mv = MVT + ((size_t)bm * 1024 + head * 256 + l15) * 256 + 4 * lq;
    f4 s[16];
#pragma unroll
    for (int kt = 0; kt < 16; ++kt) { s[kt] = (f4){0.f, 0.f, 0.f, 0.f};
#pragma unroll
        for (int ks = 0; ks < 8; ++ks) s[kt] = mfma16(*(const s16x8*)(mk + (size_t)(16 * kt) * 1024 + 32 * ks), qf[ks], s[kt]); }
    float mx = -1e30f;
#pragma unroll
    for (int kt = 0; kt < 16; ++kt) mx = fmaxf(mx, fmaxf(fmaxf(s[kt].x, s[kt].y), fmaxf(s[kt].z, s[kt].w)));
    mx = fmaxf(mx, __shfl_xor(mx, 16)); mx = fmaxf(mx, __shfl_xor(mx, 32));
    const float c2 = 0.0625f * 1.4426950408889634f; float sum = 0.f;
#pragma unroll
    for (int kt = 0; kt < 16; ++kt) { s[kt].x = __builtin_amdgcn_exp2f((s[kt].x - mx) * c2); s[kt].y = __builtin_amdgcn_exp2f((s[kt].y - mx) * c2);
        s[kt].z = __builtin_amdgcn_exp2f((s[kt].z - mx) * c2); s[kt].w = __builtin_amdgcn_exp2f((s[kt].w - mx) * c2); sum += (s[kt].x + s[kt].y) + (s[kt].z + s[kt].w); }
    sum += __shfl_xor(sum, 16); sum += __shfl_xor(sum, 32);
    const float inv = 1.0f / sum;
    s16x8 pf[8];
#pragma unroll
    for (int s8 = 0; s8 < 8; ++s8) { u4 w; w.x = pk2(s[2 * s8].x, s[2 * s8].y); w.y = pk2(s[2 * s8].z, s[2 * s8].w); w.z = pk2(s[2 * s8 + 1].x, s[2 * s8 + 1].y); w.w = pk2(s[2 * s8 + 1].z, s[2 * s8 + 1].w);
        pf[s8] = __builtin_bit_cast(s16x8, w); }
    bf16* orow = OM + (size_t)qrow * 1024 + head * 256 + 4 * lq;
#pragma unroll 4
    for (int dt = 0; dt < 16; ++dt) { f4 o = (f4){0.f, 0.f, 0.f, 0.f};
#pragma unroll
        for (int s8 = 0; s8 < 8; ++s8) { const u2 a0 = *(const u2*)(mv + (size_t)(16 * dt) * 256 + 32 * s8), a1 = *(const u2*)(mv + (size_t)(16 * dt) * 256 + 32 * s8 + 16);
            u4 fa; fa.x = a0.x; fa.y = a0.y; fa.z = a1.x; fa.w = a1.y;
            o = mfma16(__builtin_bit_cast(s16x8, fa), pf[s8], o); }
        if (t < nq) { u2 w; w.x = pk2(o.x * inv, o.y * inv); w.y = pk2(o.z * inv, o.w * inv); *(u2*)(orow + 16 * dt) = w; }
    }
}
}

namespace pg8 {
struct EpiGateS {
    static constexpr bool PERM = false, AFTER_DRAIN = false;
    float* F; const bf16_t* G;
    __device__ __forceinline__ void operator()(const f32x4 (&acc)[2][2][4][2], const Unit& u, int wr, int wc, int fr, int fq) const {
        typedef unsigned u32x2v __attribute__((ext_vector_type(2)));
        const int row0 = u.pm * BM + wr * 64 + fr, col0 = u.pn * BM + wc * 32 + 4 * fq;
#pragma unroll
        for (int ai = 0; ai < 2; ++ai)
#pragma unroll
            for (int m = 0; m < 4; ++m) { const size_t off = (size_t)(row0 + ai * HALF + m * 16) * 1024 + col0;
#pragma unroll
                for (int bj = 0; bj < 2; ++bj)
#pragma unroll
                    for (int n = 0; n < 2; ++n) { const u32x2v g = *(const u32x2v*)(G + off + bj * HALF + n * 16); const f32x4 v = acc[ai][bj][m][n]; f32x4 o;
                        o[0] = v[0] * ep_sigm(__uint_as_float(g.x << 16)); o[1] = v[1] * ep_sigm(__uint_as_float(g.x & 0xffff0000u));
                        o[2] = v[2] * ep_sigm(__uint_as_float(g.y << 16)); o[3] = v[3] * ep_sigm(__uint_as_float(g.y & 0xffff0000u));
                        *(f32x4*)(F + off + bj * HALF + n * 16) = o; } }
    }
};
struct EpiGateA {
    static constexpr bool PERM = false, AFTER_DRAIN = false;
    const float* F; const bf16_t* G; bf16_t* O;
    __device__ __forceinline__ void operator()(const f32x4 (&acc)[2][2][4][2], const Unit& u, int wr, int wc, int fr, int fq) const {
        typedef unsigned u32x2v __attribute__((ext_vector_type(2)));
        const int row0 = u.pm * BM + wr * 64 + fr, col0 = u.pn * BM + wc * 32 + 4 * fq;
#pragma unroll
        for (int ai = 0; ai < 2; ++ai)
#pragma unroll
            for (int m = 0; m < 4; ++m) { const size_t off = (size_t)(row0 + ai * HALF + m * 16) * 1024 + col0;
#pragma unroll
                for (int bj = 0; bj < 2; ++bj)
#pragma unroll
                    for (int n = 0; n < 2; ++n) { const u32x2v g = *(const u32x2v*)(G + off + bj * HALF + n * 16); const f32x4 v = acc[ai][bj][m][n]; const f32x4 f = *(const f32x4*)(F + off + bj * HALF + n * 16);
                        u32x2v w;
                        w.x = cvt_pk_bf16(f[0] + v[0] * ep_sigm(__uint_as_float(g.x << 16)), f[1] + v[1] * ep_sigm(__uint_as_float(g.x & 0xffff0000u)));
                        w.y = cvt_pk_bf16(f[2] + v[2] * ep_sigm(__uint_as_float(g.y << 16)), f[3] + v[3] * ep_sigm(__uint_as_float(g.y & 0xffff0000u)));
                        *(u32x2v*)(O + off + bj * HALF + n * 16) = w; } }
    }
};
}
__global__ void __launch_bounds__(NWAVES * 64, 2) mega_fwd(Args a_unused) {
    extern __shared__ __attribute__((aligned(16))) unsigned char lds_raw[];
    LAS unsigned char* lds = (LAS unsigned char*)lds_raw;
    volatile LAS unsigned* MISCW = (volatile LAS unsigned*)(lds + MISC_OFF);
    const int wave0 = __builtin_amdgcn_readfirstlane(threadIdx.x >> 6);
    const KArgs ap0 = (KArgs)__builtin_amdgcn_kernarg_segment_ptr();
    for (int u = threadIdx.x; u < (LDS_BYTES - LDSCTL_OFF) / 4; u += NWAVES * 64) ((LAS unsigned*)(lds + LDSCTL_OFF))[u] = 0u;
    __syncthreads();
    (void)xcd_barrier_post((unsigned*)(ap0->ws + WS_CTL) + CW_BAR, MISCW + 8);
#define TID_FRESH(tv) int tv; { unsigned m_ = ~0u; asm volatile("" : "+s"(m_)); tv = wave0 * 64 + (int)__builtin_amdgcn_mbcnt_hi(m_, __builtin_amdgcn_mbcnt_lo(m_, 0u)); }
#define PH_BEGIN { TID_FRESH(tid) KArgs a = ap0; asm volatile("" : "+s"(a)); \
    const int lane = tid & 63, wave = wave0; const int G = gridDim.x, gw = blockIdx.x * NWAVES + wave, NGW = G * NWAVES; \
    unsigned char* ws = a->ws; float* out = a->out; unsigned* ctl = (unsigned*)(ws + WS_CTL); bf16* U = (bf16*)(ws + WS_U); bf16* ACT = (bf16*)(ws + WS_ACT); float* Fb = (float*)(ws + WS_F); \
    (void)lane; (void)wave; (void)gw; (void)NGW; (void)out; (void)ctl; (void)U; (void)ACT; (void)Fb;
#define GRID_BARRIER() do { TID_FRESH(tb_) KArgs ab_ = ap0; asm volatile("" : "+s"(ab_)); XcdBarrier bb_; bb_.bar = (unsigned*)(ab_->ws + WS_CTL) + CW_BAR; bb_.x = xb_xcc_id(); bb_.st = MISCW + 8; \
    xcd_barrier(bb_, tb_ == 0); } while (0)
#define PH_END } GRID_BARRIER();
#define DEQUEUE(qi, uvar) do { if (tid == 0) MISCW[16] = __hip_atomic_fetch_add(ctl + CW_Q + 64 * (qi), 1u, __ATOMIC_RELAXED, __HIP_MEMORY_SCOPE_AGENT); \
        __syncthreads(); uvar = (int)MISCW[16]; __syncthreads(); } while (0)

    PH_BEGIN
    prologue(a, lds, wave, lane, gw, NGW);
    PH_END

    PH_BEGIN
    { pg8::Gemm g{U, (const bf16*)(ws + WS_WGU1), MT, NGU, DM}; pg8::StaticOrder S; S.init(MT, NGU, G, (int)blockIdx.x);
      pg8::EpiGU E{ACT};
      pg8::gemm_phase<pg8::EpiGU, pg8::StaticOrder, true, true>(lds, g, S, E, tid); }
    { pg8::Gemm g{(const bf16*)(ws + WS_MN), (const bf16*)(ws + WS_WMKV), NB * 256, 2048, DM}; pg8::StaticOrder S; S.init(NB * 256, 2048, G, (int)((blockIdx.x + 96) % G));
      pg8::EpiMemKV E{out + O_MKP, out + O_MVP, (bf16*)(ws + WS_MKB)};
      pg8::gemm_phase<pg8::EpiMemKV, pg8::StaticOrder, true, true>(lds, g, S, E, tid); }
    PH_END

    PH_BEGIN
    { pg8::Gemm g{ACT, (const bf16*)(ws + WS_WD1), MT, DM, FF}; pg8::StaticOrder S; S.init(MT, DM, G, (int)blockIdx.x);
      pg8::EpiF32 E{Fb, DM};
      pg8::gemm_phase<pg8::EpiF32, pg8::StaticOrder, true, true>(lds, g, S, E, tid); }
    PH_END

    PH_BEGIN
    for (int r = gw; r < MR; r += NGW) {
        const float* hin = r < MP ? (const float*)a->in[I_XP] + (size_t)r * DM : (const float*)a->in[I_XS] + (size_t)(r - MP) * DM;
        post_norm_row(hin, Fb + (size_t)r * DM, (const float*)a->in[I_F1POST], 0.5f, out + (size_t)r * DM, (const float*)a->in[I_MIXPRE], U + (size_t)r * DM, lane);
    }
    { LAS float* scr = (LAS float*)(lds + wave * 16384);
      for (int it = gw; it < NB * 128; it += NGW) { const int b = it >> 7, q = it & 127, db = q >> 2, kb = q & 3;
          tr_item(out + O_MVP + (size_t)b * 256 * DM, DM, 32 * db, 32, 64 * kb, (bf16*)(ws + WS_MVT) + (size_t)b * DM * 256, 256, 32 * db, 0, nullptr, scr, lane); } }
    PH_END

    PH_BEGIN
    { pg8::Gemm g{U, (const bf16*)(ws + WS_WIN), MT, NINP, DM}; pg8::StaticOrder S; S.init(MT, NINP, G, (int)blockIdx.x);
      pg8::EpiWin E{(bf16*)(ws + WS_Z), (bf16*)(ws + WS_XBC), (bf16*)(ws + WS_Q), (bf16*)(ws + WS_KB), (bf16*)(ws + WS_QI), (bf16*)(ws + WS_GS), (bf16*)(ws + WS_GA),
                    (bf16*)(ws + WS_KIB), (float*)(ws + WS_MISC), out};
      pg8::gemm_phase<pg8::EpiWin, pg8::StaticOrder, true, true>(lds, g, S, E, tid); }
    PH_END

    PH_BEGIN
    for (;;) {
        int u; DEQUEUE(0, u);
        { KArgs a2 = ap0; asm volatile("" : "+s"(a2)); a = a2; ws = a->ws; out = a->out; }
        TID_FRESH(tu) const int wu = wave0, lu = tu & 63; (void)wu; (void)lu;
        if (u >= 64 + 512 + 256 + 256 + 32) break;
        if (u < 64 || (u >= 832 && u < 1088)) {
            const bool smp = u >= 64; const int v = smp ? u - 832 : u, b = v >> 3, g = v & 7;
            ssd::ssd_unit(lds, tu, a, smp ? MP + 4 * b : b * SEQ, smp ? DECS : SEQ, g, b, smp);
        } else if (u < 576) {
            const int v = u - 64, qblk = 63 - (v >> 3), b = v & 7;
            dsa::idx_prompt_unit(tu, (const bf16*)(ws + WS_QI), (const bf16*)(ws + WS_KIB), (const float*)(ws + WS_MISC), (float*)(ws + WS_SC), (unsigned*)(ws + WS_MASK), b, qblk);
        } else if (u < 832) {
            const int v = u - 576;
            dsa::idx_sample_unit(tu, (const bf16*)(ws + WS_QI), (const float*)(ws + WS_MISC), (const float*)a->in[I_CKI], (const int*)a->in[I_PT], (float*)(ws + WS_SCS), v >> 3, v & 7);
        } else {
            const int v = u - 1088; LAS float* scr = (LAS float*)(lds + wu * 16384);
            for (int i = 0; i < 8; ++i) { const int it = v * 64 + wu * 8 + i, b = it >> 8, q = it & 255, db = q >> 5, kb = q & 31;
                tr_item(out + O_VP + (size_t)b * SEQ * 256, 256, 32 * db, 32, 64 * kb, (bf16*)(ws + WS_VT) + (size_t)b * 256 * SEQ, SEQ, 32 * db, 0, nullptr, scr, lu); }
            __syncthreads();
        }
    }
    PH_END

    PH_BEGIN
    for (;;) {
        int u; DEQUEUE(1, u);
        { KArgs a2 = ap0; asm volatile("" : "+s"(a2)); a = a2; ws = a->ws; out = a->out; }
        TID_FRESH(tu) const int wu = wave0, lu = tu & 63; (void)wu; (void)lu;
        if (u >= 128 + 1024) break;
        if (u < 128) {
            dsa::sample_query_unit(lds, tu, (const bf16*)(ws + WS_Q), (const bf16*)(ws + WS_QI), (const float*)(ws + WS_MISC), (const float*)(ws + WS_SCS),
                                   (const float*)a->in[I_CK], (const float*)a->in[I_CV], (const int*)a->in[I_PT], out, (bf16*)(ws + WS_YA), u >> 2, u & 3);
        } else {
            const int v = u - 128, qb = 31 - (v >> 5), b = (v >> 2) & 7, kvh = v & 3;
            dsa::attn_prompt_unit(lds, tu, (const bf16*)(ws + WS_Q), (const bf16*)(ws + WS_KB), (const bf16*)(ws + WS_VT), (const unsigned*)(ws + WS_MASK), (bf16*)(ws + WS_YA), b, kvh, qb);
        }
    }
    PH_END

    PH_BEGIN
    { pg8::Gemm g{(const bf16*)(ws + WS_YS), (const bf16*)(ws + WS_WBRS), MT, DM, 2048}; pg8::StaticOrder S; S.init(MT, DM, G, (int)blockIdx.x);
      pg8::EpiGateS E{Fb, (const bf16*)(ws + WS_GS)};
      pg8::gemm_phase<pg8::EpiGateS, pg8::StaticOrder, true, true>(lds, g, S, E, tid); }
    { pg8::Gemm g{(const bf16*)(ws + WS_YA), (const bf16*)(ws + WS_WBRA), MT, DM, DM}; pg8::StaticOrder S; S.init(MT, DM, G, (int)blockIdx.x);
      pg8::EpiGateA E{Fb, (const bf16*)(ws + WS_GA), (bf16*)(ws + WS_MRG)};
      pg8::gemm_phase<pg8::EpiGateA, pg8::StaticOrder, true, true>(lds, g, S, E, tid); }
    PH_END

    PH_BEGIN
    { pg8::Gemm g{(const bf16*)(ws + WS_MRG), (const bf16*)(ws + WS_WOUT), MT, DM, DM}; pg8::StaticOrder S; S.init(MT, DM, G, (int)blockIdx.x);
      pg8::EpiF32 E{Fb, DM};
      pg8::gemm_phase<pg8::EpiF32, pg8::StaticOrder, true, true>(lds, g, S, E, tid); }
    PH_END

    PH_BEGIN
    for (int r = gw; r < MR; r += NGW)
        post_norm_row(out + (size_t)r * DM, Fb + (size_t)r * DM, (const float*)a->in[I_MIXPOST], 1.0f, out + (size_t)r * DM, (const float*)a->in[I_MEMPRE], U + (size_t)r * DM, lane);
    PH_END

    PH_BEGIN
    { pg8::Gemm g{U, (const bf16*)(ws + WS_WMQ), MT, DM, DM}; pg8::StaticOrder S; S.init(MT, DM, G, (int)blockIdx.x);
      pg8::EpiB16 E{(bf16*)(ws + WS_QM), DM};
      pg8::gemm_phase<pg8::EpiB16, pg8::StaticOrder, true, true>(lds, g, S, E, tid); }
    PH_END

    PH_BEGIN
    for (;;) {
        int u; DEQUEUE(2, u);
        { KArgs a2 = ap0; asm volatile("" : "+s"(a2)); a = a2; ws = a->ws; out = a->out; }
        TID_FRESH(tu) const int wu = wave0, lu = tu & 63; (void)wu; (void)lu;
        if (u >= 512 + 128) break;
        if (u < 512) { const int b = u >> 6, head = (u >> 4) & 3, qt = u & 15;
            mema::memattn_unit(tu, (const bf16*)(ws + WS_QM), (const bf16*)(ws + WS_MKB), (const bf16*)(ws + WS_MVT), (bf16*)(ws + WS_OM), b, head, b * SEQ + 128 * qt, 128);
        } else { const int v = u - 512, b = v >> 2, head = v & 3;
            mema::memattn_unit(tu, (const bf16*)(ws + WS_QM), (const bf16*)(ws + WS_MKB), (const bf16*)(ws + WS_MVT), (bf16*)(ws + WS_OM), NB + b, head, MP + 4 * b, 4); }
    }
    PH_END

    PH_BEGIN
    { pg8::Gemm g{(const bf16*)(ws + WS_OM), (const bf16*)(ws + WS_WMO), MT, DM, DM}; pg8::StaticOrder S; S.init(MT, DM, G, (int)blockIdx.x);
      pg8::EpiF32 E{Fb, DM};
      pg8::gemm_phase<pg8::EpiF32, pg8::StaticOrder, true, true>(lds, g, S, E, tid); }
    PH_END

    PH_BEGIN
    for (int r = gw; r < MR; r += NGW)
        post_norm_row(out + (size_t)r * DM, Fb + (size_t)r * DM, (const float*)a->in[I_MEMPOST], 1.0f, out + (size_t)r * DM, (const float*)a->in[I_F2PRE], U + (size_t)r * DM, lane);
    PH_END

    PH_BEGIN
    { pg8::Gemm g{U, (const bf16*)(ws + WS_WGU2), MT, NGU, DM}; pg8::StaticOrder S; S.init(MT, NGU, G, (int)blockIdx.x);
      pg8::EpiGU E{ACT};
      pg8::gemm_phase<pg8::EpiGU, pg8::StaticOrder, true, true>(lds, g, S, E, tid); }
    PH_END

    PH_BEGIN
    { pg8::Gemm g{ACT, (const bf16*)(ws + WS_WD2), MT, DM, FF}; pg8::StaticOrder S; S.init(MT, DM, G, (int)blockIdx.x);
      pg8::EpiF32 E{Fb, DM};
      pg8::gemm_phase<pg8::EpiF32, pg8::StaticOrder, true, true>(lds, g, S, E, tid); }
    PH_END

    PH_BEGIN
    for (int r = gw; r < MR; r += NGW)
        post_norm_row(out + (size_t)r * DM, Fb + (size_t)r * DM, (const float*)a->in[I_F2POST], 0.5f, out + (size_t)r * DM, nullptr, nullptr, lane);
    }
#ifdef DBG_MASK3
    GRID_BARRIER();
    PH_BEGIN
        const size_t offs[15] = {O_YP, O_YS, O_KP, O_VP, O_KIP, O_SSMP, O_CONVP, O_MKP, O_MVP, O_KS, O_VS, O_KIS, O_SSMS, O_CONVS, O_END};
#pragma unroll
        for (int o = 0; o < 14; ++o) {
            const bool m3 = (DBG_MASK3 >> o) & 1, m0 = (DBG_MASK0 >> o) & 1;
            if (m3 || m0) { f32x4* p = (f32x4*)(out + offs[o]); const size_t n4 = (offs[o + 1] - offs[o]) / 4;
                for (size_t i = (size_t)blockIdx.x * 512 + tid; i < n4; i += (size_t)G * 512) { f32x4 v = p[i]; p[i] = m3 ? v * 3.0f : (f32x4){0.f, 0.f, 0.f, 0.f}; } }
        }
    }
#endif
}

extern "C" void kernel_launch(void* const* d_in, const int* in_sizes, int n_in, void* d_out, int out_size, void* d_ws, size_t ws_size, hipStream_t stream) {
    static int grid = 0;
    if (grid == 0) {
        if (n_in != N_IN || (size_t)out_size != O_END || ws_size < WS_END) {
            fprintf(stderr, "kernel_launch: unexpected sizes: n_in %d out %d ws %zu (need %zu)\n", n_in, out_size, ws_size, (size_t)WS_END); grid = -1; return; }
        int dev = 0, cus = 0, per_cu = 0;
        if (hipGetDevice(&dev) != hipSuccess || hipDeviceGetAttribute(&cus, hipDeviceAttributeMultiprocessorCount, dev) != hipSuccess) { grid = -1; return; }
        if (hipFuncSetAttribute((const void*)mega_fwd, hipFuncAttributeMaxDynamicSharedMemorySize, LDS_BYTES) != hipSuccess) { fprintf(stderr, "kernel_launch: hipFuncSetAttribute failed\n"); grid = -1; return; }
        if (hipOccupancyMaxActiveBlocksPerMultiprocessor(&per_cu, (const void*)mega_fwd, NWAVES * 64, LDS_BYTES) != hipSuccess || per_cu < 1)
            fprintf(stderr, "kernel_launch: occupancy query reports %d\n", per_cu);
        (void)hipGetLastError();
        grid = cus;
    }
    if (grid < 0) return;
    if (hipMemsetAsync((char*)d_ws + WS_CTL, 0, CTL_ZERO_BYTES, stream) != hipSuccess) return;
    Args a{};
    for (int i = 0; i < N_IN; ++i) a.in[i] = d_in[i];
    a.out = (float*)d_out; a.ws = (unsigned char*)d_ws;
    hipLaunchKernelGGL(mega_fwd, dim3(grid), dim3(NWAVES * 64), LDS_BYTES, stream, a);
}
```

```cpp
#include <hip/hip_runtime.h>
#include <cstdio>
#include <cstdint>
namespace pg8 {
#define PG8_LAS __attribute__((address_space(3)))
typedef unsigned short bf16_t;
typedef short bf16x8 __attribute__((ext_vector_type(8)));
typedef float f32x4 __attribute__((ext_vector_type(4)));
typedef unsigned u32x4 __attribute__((ext_vector_type(4)));
constexpr int BM = 256, BK = 64, HALF = 128, HTB = HALF * BK * 2  , STAGE_BYTES = 8 * HTB, NXCD = 8, WGM = 8;

__host__ __device__ __forceinline__ int lds_byte(int r, int c) { const int st = (r >> 4) * 2 + (c >> 5), rr = r & 15, cc = c & 31, ob = rr * 64 + cc * 2; return st * 1024 + (ob ^ (((ob >> 9) & 1) << 5)); }
__host__ __device__ __forceinline__ void stage_rc(int b, int& R, int& C) { const int st = b / 1024, sb = b % 1024, swz = sb ^ (((sb >> 9) & 1) << 5); R = (st >> 1) * 16 + swz / 64; C = (st & 1) * 32 + (swz % 64) / 2; }
__host__ __device__ __forceinline__ int perm32(int rho) { const int n = rho >> 4, i = rho & 15; return 8 * (i >> 2) + 4 * n + (i & 3); }

struct Unit { int pm, pn; };
struct Gemm { const bf16_t* A; const bf16_t* Bt; int M, N, K; };

struct StaticOrder {
    int nM, nN, nwg, G, c;
    __host__ __device__ void init(int M, int N, int G_, int c_) { nM = M / BM; nN = N / BM; nwg = nM * nN; G = G_; c = c_; }
    __host__ __device__ __forceinline__ bool next(int i, Unit& u) const {
        const long L = (long)i * G + c; if (L >= nwg) return false;
        int wgid = (int)L; { const int q = nwg / NXCD, r = nwg % NXCD, xcd = wgid % NXCD, off = wgid / NXCD; wgid = (xcd < r ? xcd * (q + 1) : r * (q + 1) + (xcd - r) * q) + off; }
        const int nig = WGM * nN, gid = wgid / nig, fm = gid * WGM, gsz = (nM - fm) < WGM ? (nM - fm) : WGM;
        u.pm = fm + ((wgid % nig) % gsz); u.pn = (wgid % nig) / gsz; return true;
    }
    __device__ __forceinline__ void a_ready(const Unit&) const {}
    __device__ __forceinline__ void done(const Unit&) const {}
};

__device__ __forceinline__ unsigned cvt_pk_bf16(float lo, float hi) { unsigned r; asm volatile("v_cvt_pk_bf16_f32 %0, %1, %2" : "=v"(r) : "v"(lo), "v"(hi)); return r; }
typedef float f32x2 __attribute__((ext_vector_type(2)));
template <class Epi, class Sched, bool ALIGN_EPI = false, bool SP2 = false>
__device__ __forceinline__ void gemm_phase(PG8_LAS unsigned char* lds, const Gemm g, const Sched& S, const Epi& E, const int tid_in  ) {
    const int tid = tid_in, wid = __builtin_amdgcn_readfirstlane(tid >> 6), lane = tid & 63, wr = wid >> 2, wc = wid & 3, fr = lane & 15, fq = lane >> 4;
    const int K = g.K, nt = K / BK;
    unsigned voffA[2], voffB[2];
#pragma unroll
    for (int i = 0; i < 2; ++i) { int R, C; stage_rc(tid * 16 + i * 8192, R, C); const int Rb = Epi::PERM ? ((R & ~31) + perm32(R & 31)) : R;
        voffA[i] = (unsigned)(R * K + C) * 2u; voffB[i] = (unsigned)(Rb * K + C) * 2u; }
    const size_t kstep = (size_t)(BK * 2);
    const size_t hstep = (size_t)HALF * K * 2;
    const size_t tstep = 2 * hstep;
    const unsigned ldsw = (unsigned)wid * 1024u;
    const int aoff = lds_byte(wr * 64 + fr, fq * 8), boff = lds_byte(wc * 32 + fr, fq * 8);
#define PG8_SA(b, h) (((b) * 2 + (h)) * HTB)
#define PG8_SB(b, h) ((4 + (b) * 2 + (h)) * HTB)
#define PG8_STAGE(bufoff, gbase, voff) do { _Pragma("unroll") for (int _i = 0; _i < 2; ++_i) \
        __builtin_amdgcn_global_load_lds((const unsigned*)((const char*)(gbase) + (voff)[_i]), (PG8_LAS unsigned*)(lds + (bufoff) + ldsw + _i * 8192), 16, 0, 0); } while (0)
#define PG8_LDA(dst, b, h) do { _Pragma("unroll") for (int m = 0; m < 4; ++m) _Pragma("unroll") for (int k = 0; k < 2; ++k) dst[m][k] = *(const PG8_LAS bf16x8*)(lds + PG8_SA(b, h) + aoff + m * 2048 + k * 1024); } while (0)
#define PG8_LDB(dst, b, h) do { _Pragma("unroll") for (int n = 0; n < 2; ++n) _Pragma("unroll") for (int k = 0; k < 2; ++k) dst[n][k] = *(const PG8_LAS bf16x8*)(lds + PG8_SB(b, h) + boff + n * 2048 + k * 1024); } while (0)
#define PG8_MMA(ai, bj, At, Bt) do { __builtin_amdgcn_s_setprio(1); _Pragma("unroll") for (int m = 0; m < 4; ++m) _Pragma("unroll") for (int n = 0; n < 2; ++n) _Pragma("unroll") for (int k = 0; k < 2; ++k) \
        acc[ai][bj][m][n] = __builtin_amdgcn_mfma_f32_16x16x32_bf16(Bt[n][k], At[m][k], acc[ai][bj][m][n], 0, 0, 0); __builtin_amdgcn_s_setprio(0); } while (0)
#define PG8_WAIT_V(n) asm volatile("s_waitcnt vmcnt(" #n ")" ::: "memory")
#define PG8_WAIT_L(n) asm volatile("s_waitcnt lgkmcnt(" #n ")" ::: "memory")
#define PG8_BAR __builtin_amdgcn_s_barrier()
#define PG8_SCHED __builtin_amdgcn_sched_barrier(0)
    Unit cur, nxt; int ui = 0;
    if (!S.next(0, cur)) return;
    f32x4 acc[2][2][4][2];
#pragma unroll
    for (int a = 0; a < 2; ++a)
#pragma unroll
        for (int b = 0; b < 2; ++b)
#pragma unroll
            for (int m = 0; m < 4; ++m)
#pragma unroll
                for (int n = 0; n < 2; ++n) acc[a][b][m][n] = (f32x4){0.f, 0.f, 0.f, 0.f};
    bf16x8 At[4][2], B0[2][2], B1[2][2];
    const char* cA = (const char*)g.A + (size_t)cur.pm * tstep; const char* cB = (const char*)g.Bt + (size_t)cur.pn * tstep;
    S.a_ready(cur);
    if constexpr (SP2) {
        PG8_STAGE(PG8_SB(0, 0), cB, voffB); PG8_STAGE(PG8_SB(0, 1), cB + hstep, voffB); PG8_STAGE(PG8_SA(0, 0), cA, voffA); PG8_STAGE(PG8_SA(0, 1), cA + hstep, voffA);
        if (wr == 1) PG8_BAR;
        PG8_WAIT_V(2); PG8_BAR;
        PG8_STAGE(PG8_SB(1, 0), cB + kstep, voffB); PG8_STAGE(PG8_SA(1, 0), cA + kstep, voffA); PG8_STAGE(PG8_SB(1, 1), cB + hstep + kstep, voffB);
        PG8_WAIT_V(6); PG8_BAR;
    } else {
        PG8_STAGE(PG8_SB(0, 0), cB, voffB); PG8_STAGE(PG8_SA(0, 0), cA, voffA); PG8_STAGE(PG8_SB(0, 1), cB + hstep, voffB); PG8_STAGE(PG8_SA(0, 1), cA + hstep, voffA);
        if (wr == 1) PG8_BAR;
        PG8_WAIT_V(4); PG8_BAR;
        PG8_STAGE(PG8_SB(1, 0), cB + kstep, voffB); PG8_STAGE(PG8_SA(1, 0), cA + kstep, voffA); PG8_STAGE(PG8_SB(1, 1), cB + hstep + kstep, voffB);
        PG8_WAIT_V(6); PG8_BAR;
    }
    for (;;) {
        const bool has_next = S.next(ui + 1, nxt);
        const char* nA = has_next ? (const char*)g.A + (size_t)nxt.pm * tstep : cA; const char* nB = has_next ? (const char*)g.Bt + (size_t)nxt.pn * tstep : cB;
        for (int t = 0; t < nt; t += 2) {
            if constexpr (Epi::GROUPS) { if (t == 0) { } else if ((t & 3) == 0 && t < Epi::HOOK_T) E.hookg(acc, t >> 2, wr, fr); }
            if constexpr (Epi::HOOK_T > 0) { if (t == Epi::HOOK_T) E.hook(acc, cur, wr, wc, fr, fq); }
            const bool last = (t == nt - 2);
            const char* a1 = cA + (size_t)(t + 1) * kstep;
            const char* a2 = last ? nA : cA + (size_t)(t + 2) * kstep; const char* b2 = last ? nB : cB + (size_t)(t + 2) * kstep;
            const char* a3 = a2 + kstep; const char* b3 = b2 + kstep;
            if (last && has_next) S.a_ready(nxt);
            if constexpr (SP2) {
            PG8_LDB(B0, 0, 0); PG8_LDB(B1, 0, 1); PG8_SCHED; PG8_LDA(At, 0, 0); PG8_STAGE(PG8_SA(1, 1), a1 + hstep, voffA);
            PG8_WAIT_V(8); PG8_WAIT_L(0); PG8_BAR; PG8_MMA(0, 0, At, B0); PG8_MMA(0, 1, At, B1); PG8_BAR; PG8_SCHED;
            PG8_LDA(At, 0, 1); PG8_STAGE(PG8_SB(0, 0), b2, voffB); PG8_STAGE(PG8_SB(0, 1), b2 + hstep, voffB); PG8_STAGE(PG8_SA(0, 0), a2, voffA);
            PG8_WAIT_V(8); PG8_WAIT_L(0); PG8_BAR; PG8_MMA(1, 0, At, B0); PG8_MMA(1, 1, At, B1); PG8_BAR; PG8_SCHED;
            PG8_LDB(B0, 1, 0); PG8_LDB(B1, 1, 1); PG8_SCHED; PG8_LDA(At, 1, 0); PG8_STAGE(PG8_SA(0, 1), a2 + hstep, voffA);
            PG8_WAIT_V(8); PG8_WAIT_L(0); PG8_BAR; PG8_MMA(0, 0, At, B0); PG8_MMA(0, 1, At, B1); PG8_BAR; PG8_SCHED;
            PG8_LDA(At, 1, 1); PG8_STAGE(PG8_SB(1, 0), b3, voffB); PG8_STAGE(PG8_SB(1, 1), b3 + hstep, voffB); PG8_STAGE(PG8_SA(1, 0), a3, voffA);
            PG8_WAIT_V(8); PG8_WAIT_L(0); PG8_BAR; PG8_MMA(1, 0, At, B0); PG8_MMA(1, 1, At, B1); PG8_BAR; PG8_SCHED;
            } else {
            PG8_LDB(B0, 0, 0); PG8_SCHED; PG8_LDA(At, 0, 0); PG8_STAGE(PG8_SA(1, 1), a1 + hstep, voffA);
            PG8_WAIT_L(8); PG8_BAR; PG8_WAIT_L(0); PG8_MMA(0, 0, At, B0); PG8_BAR; PG8_SCHED;
            PG8_LDB(B1, 0, 1); PG8_STAGE(PG8_SB(0, 0), b2, voffB);
            PG8_BAR; PG8_WAIT_L(0); PG8_MMA(0, 1, At, B1); PG8_BAR;
            PG8_LDA(At, 0, 1); PG8_STAGE(PG8_SA(0, 0), a2, voffA);
            PG8_BAR; PG8_WAIT_L(0); PG8_MMA(1, 0, At, B0); PG8_BAR; PG8_SCHED;
            PG8_STAGE(PG8_SB(0, 1), b2 + hstep, voffB);
            PG8_WAIT_V(6); PG8_BAR; PG8_MMA(1, 1, At, B1); PG8_BAR;
            PG8_LDB(B0, 1, 0); PG8_SCHED; PG8_LDA(At, 1, 0); PG8_STAGE(PG8_SA(0, 1), a2 + hstep, voffA);
            PG8_WAIT_L(8); PG8_BAR; PG8_WAIT_L(0); PG8_MMA(0, 0, At, B0); PG8_BAR; PG8_SCHED;
            PG8_LDB(B1, 1, 1); PG8_STAGE(PG8_SB(1, 0), b3, voffB);
            PG8_BAR; PG8_WAIT_L(0); PG8_MMA(0, 1, At, B1); PG8_BAR;
            PG8_LDA(At, 1, 1); PG8_STAGE(PG8_SA(1, 0), a3, voffA);
            PG8_BAR; PG8_WAIT_L(0); PG8_MMA(1, 0, At, B0); PG8_BAR; PG8_SCHED;
            PG8_STAGE(PG8_SB(1, 1), b3 + hstep, voffB);
            PG8_WAIT_V(6); PG8_BAR; PG8_MMA(1, 1, At, B1); PG8_BAR;
            }
        }
        if constexpr (ALIGN_EPI) { if (wr == 0) PG8_BAR; }
        if constexpr (!Epi::AFTER_DRAIN) { E(acc, cur, wr, wc, fr, fq); S.done(cur); }
        if (!has_next) break;
#pragma unroll
        for (int a = 0; a < 2; ++a)
#pragma unroll
            for (int b = 0; b < 2; ++b)
#pragma unroll
                for (int m = 0; m < 4; ++m)
#pragma unroll
                    for (int n = 0; n < 2; ++n) acc[a][b][m][n] = (f32x4){0.f, 0.f, 0.f, 0.f};
        cur = nxt; cA = nA; cB = nB; ++ui;
        if constexpr (ALIGN_EPI) { if (wr == 1) PG8_BAR; }
    }
    PG8_WAIT_V(0);
    if constexpr (!ALIGN_EPI) { if (wr == 0) PG8_BAR; }
    PG8_BAR;
    if constexpr (Epi::AFTER_DRAIN) { E.fused(acc, cur, wr, wc, fr, fq, lds, wid, lane); S.done(cur); }
#undef PG8_SA
#undef PG8_SB
#undef PG8_STAGE
#undef PG8_LDA
#undef PG8_LDB
#undef PG8_MMA
#undef PG8_WAIT_V
#undef PG8_WAIT_L
#undef PG8_BAR
#undef PG8_SCHED
}
}
#define GAS __attribute__((address_space(1)))
#define LAS __attribute__((address_space(3)))
typedef unsigned short bf16;
typedef unsigned v4u __attribute__((ext_vector_type(4)));
typedef float f32x4 __attribute__((ext_vector_type(4)));
typedef short bf16x8 __attribute__((ext_vector_type(8)));
typedef GAS unsigned gu32;
typedef GAS unsigned long long gu64;
#define RLX_AGENT __ATOMIC_RELAXED, __HIP_MEMORY_SCOPE_AGENT
#define LDS_WAIT() asm volatile("s_waitcnt lgkmcnt(0)" ::: "memory")
#define VM_WAIT() asm volatile("s_waitcnt vmcnt(0)" ::: "memory")
__device__ __forceinline__ unsigned long long rt() { return __builtin_amdgcn_s_memrealtime(); }
typedef float f32x2_cv __attribute__((ext_vector_type(2))); typedef __bf16 bf16x2_cv __attribute__((ext_vector_type(2)));
__device__ __forceinline__ unsigned pk2(float lo, float hi) { const f32x2_cv v = {lo, hi}; const bf16x2_cv b = __builtin_convertvector(v, bf16x2_cv); return __builtin_bit_cast(unsigned, b); }
__device__ __forceinline__ unsigned f2bf(float f) { return pk2(f, 0.f) & 0xffffu; }

#define XB_TMO      128
#define XB_XCNT(j)  (256  + 64 * (j))
#define XB_XSUB(j)  (1280 + 64 * (j))
#define XB_XGEN(j)  (2304 + 64 * (j))
#define XB_TOP      3328
#define XB_TOPGEN   3392
#define XCD_BAR_WORDS 3456
#define XB_SPIN_CAP (1u << 18)

__device__ __forceinline__ unsigned xb_ld(unsigned* p)              { return __hip_atomic_load(p, __ATOMIC_RELAXED, __HIP_MEMORY_SCOPE_AGENT); }
__device__ __forceinline__ unsigned xb_add(unsigned* p, unsigned v) { return __hip_atomic_fetch_add(p, v, __ATOMIC_RELAXED, __HIP_MEMORY_SCOPE_AGENT); }
__device__ __forceinline__ unsigned xb_xcc_id() { return (unsigned)__builtin_amdgcn_s_getreg((3 << 11) | 20) & 0xFu; }
#define XB_SPIN(cond, bar) do { unsigned _sp = 0; while (cond) { __builtin_amdgcn_s_sleep(1); \
    if ((++_sp & 255u) == 0u) { if (xb_ld(&(bar)[XB_TMO])) break; if (_sp > XB_SPIN_CAP) { atomicAdd(&(bar)[XB_TMO], 1u); break; } } } } while (0)

struct XcdBarrier {
    unsigned* bar; unsigned x;
    volatile LAS unsigned* st;
};

__device__ __forceinline__ XcdBarrier xcd_barrier_post(unsigned* bar, volatile LAS unsigned* st) {
    XcdBarrier b; b.bar = bar; b.x = xb_xcc_id(); b.st = st;
    if (threadIdx.x == 0) (void)xb_add(&bar[XB_XCNT(b.x)], 1u);
    return b;
}
__device__ __forceinline__ void xcd_barrier_complete(unsigned* bar, unsigned x, unsigned& nloc, unsigned& nx) {
    const unsigned G = gridDim.x * gridDim.y * gridDim.z;
    unsigned sum, cnt, mine, sp = 0u;
    for (;;) {
        sum = 0u; cnt = 0u; mine = 0u;
#pragma unroll
        for (unsigned j = 0; j < 16; ++j) { const unsigned c = xb_ld(&bar[XB_XCNT(j)]); sum += c; cnt += (c > 0u) ? 1u : 0u; mine = (j == x) ? c : mine; }
        if (sum == G) break;
        __builtin_amdgcn_s_sleep(1);
        if ((++sp & 255u) == 0u) { if (xb_ld(&bar[XB_TMO])) break; if (sp > XB_SPIN_CAP) { atomicAdd(&bar[XB_TMO], 1u); break; } }
    }
    nloc = mine > 0u ? mine : 1u; nx = cnt > 0u ? cnt : 1u;
}

__device__ __forceinline__ void xcd_barrier(const XcdBarrier& b, bool leader  ) {
    asm volatile("s_waitcnt vmcnt(0)" ::: "memory");
    __syncthreads();
    if (leader) {
        unsigned* bar = b.bar;
        __builtin_amdgcn_s_waitcnt(0);
        unsigned nloc = b.st[0], nx = b.st[1];
        if (nloc == 0u) { xcd_barrier_complete(bar, b.x, nloc, nx); b.st[0] = nloc; b.st[1] = nx; }
        const unsigned old = xb_add(&bar[XB_XSUB(b.x)], 1u);
        const unsigned gen = old / nloc;
        if (old + 1u == (gen + 1u) * nloc) {
            __builtin_amdgcn_fence(__ATOMIC_RELEASE, "agent");
            asm volatile("s_waitcnt vmcnt(0)" ::: "memory");
            const unsigned og = xb_add(&bar[XB_TOP], 1u);
            const unsigned tg = og / nx;
            if (og + 1u == (tg + 1u) * nx) xb_add(&bar[XB_TOPGEN], 1u);
            else XB_SPIN(xb_ld(&bar[XB_TOPGEN]) == tg, bar);
            __builtin_amdgcn_fence(__ATOMIC_ACQUIRE, "agent");
            xb_add(&bar[XB_XGEN(b.x)], 1u);
            asm volatile("s_waitcnt vmcnt(0)" ::: "memory");
        } else {
            XB_SPIN(xb_ld(&bar[XB_XGEN(b.x)]) == gen, bar);
            __builtin_amdgcn_fence(__ATOMIC_ACQUIRE, "agent");
            asm volatile("s_waitcnt vmcnt(0)" ::: "memory");
        }
    }
    __syncthreads();
}

constexpr int DM = 1024, NB = 8, SEQ = 2048, DECB = 32, DECS = 4, PAST = 16384, PAGE = 128, NPAGE = 128;
constexpr int MP = NB * SEQ;
constexpr int MS = DECB * DECS;
constexpr int MR = MP + MS;
constexpr int MT = 16640;
constexpr int FF = 2816, NGU = 2 * FF, NINP = 10496;
constexpr float EPS = 1e-6f;
constexpr int NWAVES = 8;

enum { I_XP = 0, I_XS, I_MEMP, I_CK, I_CV, I_CKI, I_SSM, I_CONV, I_CMK, I_CMV, I_PT,
       I_F1PRE, I_F1WG, I_F1WU, I_F1WD, I_F1POST, I_MIXPRE, I_WIN, I_CONVW, I_CONVB, I_DTB, I_ALOG, I_DSKIP, I_SSDG,
       I_WBRS, I_WBRA, I_WOUT, I_MIXPOST, I_MEMPRE, I_MEMKVG, I_WMQ, I_WMK, I_WMV, I_WMO, I_MEMPOST,
       I_F2PRE, I_F2WG, I_F2WU, I_F2WD, I_F2POST, N_IN };

constexpr size_t O_YP = 0;
constexpr size_t O_YS = O_YP + (size_t)MP * DM;
constexpr size_t O_KP = O_YS + (size_t)MS * DM;
constexpr size_t O_VP = O_KP + (size_t)MP * 256;
constexpr size_t O_KIP = O_VP + (size_t)MP * 256;
constexpr size_t O_SSMP = O_KIP + (size_t)MP * 64;
constexpr size_t O_CONVP = O_SSMP + (size_t)NB * 32 * 64 * 128;
constexpr size_t O_MKP = O_CONVP + (size_t)NB * 3 * 4096;
constexpr size_t O_MVP = O_MKP + (size_t)NB * 256 * 1024;
constexpr size_t O_KS = O_MVP + (size_t)NB * 256 * 1024;
constexpr size_t O_VS = O_KS + (size_t)MS * 256;
constexpr size_t O_KIS = O_VS + (size_t)MS * 256;
constexpr size_t O_SSMS = O_KIS + (size_t)MS * 64;
constexpr size_t O_CONVS = O_SSMS + (size_t)DECB * 32 * 64 * 128;
constexpr size_t O_END = O_CONVS + (size_t)DECB * 3 * 4096;
static_assert(O_END == 41590784, "output size");

constexpr size_t MiB = 1u << 20;
constexpr size_t al(size_t x) { return (x + MiB - 1) / MiB * MiB; }
constexpr size_t WS_CTL = 0, CTL_ZERO_BYTES = 1 * MiB;
constexpr size_t WS_WGU1 = 1 * MiB;
constexpr size_t WS_WD1 = WS_WGU1 + al((size_t)NGU * DM * 2);
constexpr size_t WS_WIN = WS_WD1 + al((size_t)DM * FF * 2);
constexpr size_t WS_WBRS = WS_WIN + al((size_t)NINP * DM * 2);
constexpr size_t WS_WBRA = WS_WBRS + al((size_t)DM * 3072 * 2);
constexpr size_t WS_WOUT = WS_WBRA + al((size_t)DM * DM * 2);
constexpr size_t WS_WMQ = WS_WOUT + al((size_t)DM * DM * 2);
constexpr size_t WS_WMKV = WS_WMQ + al((size_t)DM * DM * 2);
constexpr size_t WS_WMO = WS_WMKV + al((size_t)2048 * DM * 2);
constexpr size_t WS_WGU2 = WS_WMO + al((size_t)DM * DM * 2);
constexpr size_t WS_WD2 = WS_WGU2 + al((size_t)NGU * DM * 2);
constexpr size_t WS_U = WS_WD2 + al((size_t)DM * FF * 2);
constexpr size_t WS_ACT = WS_U + al((size_t)MT * DM * 2);
constexpr size_t WS_F = WS_ACT + al((size_t)MT * FF * 2);
constexpr size_t WS_Z = WS_F + al((size_t)MT * DM * 4);
constexpr size_t WS_XBC = WS_Z + al((size_t)MT * 2048 * 2);
constexpr size_t WS_Q = WS_XBC + al((size_t)MT * 4096 * 2);
constexpr size_t WS_KB = WS_Q + al((size_t)MT * DM * 2);
constexpr size_t WS_VT = WS_KB + al((size_t)MT * 256 * 2);
constexpr size_t WS_QI = WS_VT + al((size_t)NB * 256 * SEQ * 2);
constexpr size_t WS_GS = WS_QI + al((size_t)MT * 512 * 2);
constexpr size_t WS_GA = WS_GS + al((size_t)MT * DM * 2);
constexpr size_t WS_MISC = WS_GA + al((size_t)MT * DM * 2);
constexpr size_t WS_KIB = WS_MISC + al((size_t)MT * 256 * 4);
constexpr size_t WS_YC = WS_KIB + al((size_t)MT * 64 * 2);
constexpr int YCP = 3072;
constexpr size_t WS_MRG = WS_YC + al((size_t)MT * YCP * 2);
constexpr size_t WS_QM = WS_MRG + al((size_t)MT * DM * 2);
constexpr size_t WS_OM = WS_QM + al((size_t)MT * DM * 2);
constexpr size_t WS_MN = WS_OM + al((size_t)MT * DM * 2);
constexpr size_t WS_MKB = WS_MN + al((size_t)2048 * DM * 2);
constexpr size_t WS_MVT = WS_MKB + al((size_t)40 * 256 * DM * 2);
constexpr size_t WS_SC = WS_MVT + al((size_t)40 * 256 * DM * 2);
constexpr size_t WS_SCS = WS_SC + al((size_t)MP * 2048 * 4);
constexpr size_t WS_MASK = WS_SCS + al((size_t)MS * 16640 * 4);
constexpr size_t WS_SSQ = WS_MASK + al((size_t)MP * 64 * 4);
constexpr size_t WS_XBCA = WS_SSQ + al((size_t)MT * 32 * 4);
constexpr size_t WS_FB = WS_XBCA + al((size_t)MT * 4096 * 2);
constexpr size_t WS_HB = WS_FB + al((size_t)MT * DM * 2);
constexpr size_t WS_DUMMY = WS_HB + al((size_t)MT * DM * 2);
constexpr size_t WS_DUMMY_OLD = WS_XBCA + al((size_t)MT * 4096 * 2);
constexpr size_t WS_END = WS_DUMMY + 1 * MiB;

constexpr int CW_BAR = 4096;
constexpr int CW_Q = 16384;

constexpr int RING_BYTES = 131072;
constexpr int LDSCTL_OFF = RING_BYTES, MISC_OFF = LDSCTL_OFF + 320;
constexpr int LDS_BYTES = 147456;

struct Args { const void* in[N_IN]; float* out; unsigned char* ws; };
typedef const __attribute__((address_space(4))) Args* KArgs;

__device__ __forceinline__ float wave_sum(float v) {
#pragma unroll
    for (int o = 1; o < 64; o <<= 1) v += __shfl_xor(v, o);
    return v;
}
__device__ __forceinline__ float silu_f(float x) { return x * __builtin_amdgcn_rcpf(1.0f + __expf(-x)); }
__device__ __forceinline__ float sigmoid_f(float x) { return __builtin_amdgcn_rcpf(1.0f + __expf(-x)); }

__device__ __forceinline__ void tr_item(const float* __restrict__ W, int ldw, int col0, int nvalid, int k0, bf16* WT, int ldt, int drow0, int dk0,
                                        const float* kscale, LAS float* scr, int lane) {
    const int c = lane & 31;
#pragma unroll 8
    for (int i = 0; i < 32; ++i) {
        const int kk = 2 * i + (lane >> 5);
        float v = (c < nvalid) ? W[(size_t)(k0 + kk) * ldw + col0 + c] : 0.f;
        if (kscale) v *= kscale[k0 + kk];
        scr[kk * 33 + c] = v;
    }
    LDS_WAIT(); asm volatile("" ::: "memory");
    const int c8 = lane & 7;
#pragma unroll
    for (int j = 0; j < 4; ++j) {
        const int n = (lane >> 3) + 8 * j; const LAS float* s = scr + (8 * c8) * 33 + n;
        v4u o; o.x = pk2(s[0 * 33], s[1 * 33]); o.y = pk2(s[2 * 33], s[3 * 33]); o.z = pk2(s[4 * 33], s[5 * 33]); o.w = pk2(s[6 * 33], s[7 * 33]);
        *(GAS v4u*)(WT + (size_t)(drow0 + n) * ldt + dk0 + k0 + 8 * c8) = o;
    }
    LDS_WAIT(); asm volatile("" ::: "memory");
}

__device__ __forceinline__ void rms_row_bf16(const float* xrow, const float* g, bf16* orow, int lane) {
    const GAS f32x4* xr = (const GAS f32x4*)xrow + lane; const GAS f32x4* gr = (const GAS f32x4*)g + lane;
    f32x4 v[4]; float s = 0.f;
#pragma unroll
    for (int j = 0; j < 4; ++j) { v[j] = xr[64 * j]; s += (v[j].x * v[j].x + v[j].y * v[j].y) + (v[j].z * v[j].z + v[j].w * v[j].w); }
    const float rs = 1.0f / sqrtf(wave_sum(s) * (1.0f / DM) + EPS);
    GAS unsigned long long* o8 = (GAS unsigned long long*)orow + lane;
#pragma unroll
    for (int j = 0; j < 4; ++j) { const f32x4 gg = gr[64 * j];
        o8[64 * j] = (unsigned long long)pk2(v[j].x * rs * gg.x, v[j].y * rs * gg.y) | ((unsigned long long)pk2(v[j].z * rs * gg.z, v[j].w * rs * gg.w) << 32); }
}
__device__ __forceinline__ void cvt_row_bf16(const float* xrow, bf16* orow, int lane) {
    const GAS f32x4* xr = (const GAS f32x4*)xrow + lane; GAS unsigned long long* o8 = (GAS unsigned long long*)orow + lane;
#pragma unroll
    for (int j = 0; j < 4; ++j) { const f32x4 v = xr[64 * j]; o8[64 * j] = (unsigned long long)pk2(v.x, v.y) | ((unsigned long long)pk2(v.z, v.w) << 32); }
}
__device__ __forceinline__ void post_norm_row(const float* hin, const float* frow, const float* post_g, float rscale, float* hout, const float* pre_g, bf16* urow, int lane) {
    const GAS f32x4* fr = (const GAS f32x4*)frow + lane; const GAS f32x4* hr = (const GAS f32x4*)hin + lane; const GAS f32x4* pg = (const GAS f32x4*)post_g + lane;
    f32x4 f[4], h[4]; float s = 0.f;
#pragma unroll
    for (int j = 0; j < 4; ++j) { f[j] = fr[64 * j]; h[j] = hr[64 * j]; s += (f[j].x * f[j].x + f[j].y * f[j].y) + (f[j].z * f[j].z + f[j].w * f[j].w); }
    const float rs = rscale / sqrtf(wave_sum(s) * (1.0f / DM) + EPS);
    float s2 = 0.f;
    GAS f32x4* ho = (GAS f32x4*)hout + lane;
#pragma unroll
    for (int j = 0; j < 4; ++j) { const f32x4 gg = pg[64 * j]; h[j] = h[j] + f[j] * rs * gg; ho[64 * j] = h[j];
        s2 += (h[j].x * h[j].x + h[j].y * h[j].y) + (h[j].z * h[j].z + h[j].w * h[j].w); }
    if (pre_g) {
        const float rs2 = 1.0f / sqrtf(wave_sum(s2) * (1.0f / DM) + EPS);
        const GAS f32x4* qg = (const GAS f32x4*)pre_g + lane; GAS unsigned long long* o8 = (GAS unsigned long long*)urow + lane;
#pragma unroll
        for (int j = 0; j < 4; ++j) { const f32x4 gg = qg[64 * j];
            o8[64 * j] = (unsigned long long)pk2(h[j].x * rs2 * gg.x, h[j].y * rs2 * gg.y) | ((unsigned long long)pk2(h[j].z * rs2 * gg.z, h[j].w * rs2 * gg.w) << 32); }
    }
}

typedef unsigned u32x2n __attribute__((ext_vector_type(2)));
__device__ __forceinline__ void pn_load(const float* hin32, const bf16* hin16, const bf16* frow, int lane, f32x4 (&f)[4], f32x4 (&h)[4]) {
    const GAS u32x2n* fr = (const GAS u32x2n*)frow + lane;
#pragma unroll
    for (int j = 0; j < 4; ++j) { const u32x2n w = fr[64 * j];
        f[j] = (f32x4){__uint_as_float(w.x << 16), __uint_as_float(w.x & 0xffff0000u), __uint_as_float(w.y << 16), __uint_as_float(w.y & 0xffff0000u)};
        if (hin32) h[j] = ((const GAS f32x4*)hin32 + lane)[64 * j];
        else { const u32x2n v = ((const GAS u32x2n*)hin16 + lane)[64 * j];
            h[j] = (f32x4){__uint_as_float(v.x << 16), __uint_as_float(v.x & 0xffff0000u), __uint_as_float(v.y << 16), __uint_as_float(v.y & 0xffff0000u)}; } }
}
__device__ __forceinline__ void pn_finish(f32x4 (&f)[4], f32x4 (&h)[4], const float* post_g, float rscale, bf16* hout16, float* hout32, const float* pre_g, bf16* urow, int lane) {
    const GAS f32x4* pg = (const GAS f32x4*)post_g + lane;
    float s = 0.f;
#pragma unroll
    for (int j = 0; j < 4; ++j) s += (f[j].x * f[j].x + f[j].y * f[j].y) + (f[j].z * f[j].z + f[j].w * f[j].w);
    const float rs = rscale / sqrtf(wave_sum(s) * (1.0f / DM) + EPS);
    float s2 = 0.f;
#pragma unroll
    for (int j = 0; j < 4; ++j) { const f32x4 gg = pg[64 * j]; h[j] = h[j] + f[j] * rs * gg;
        if (hout32) ((GAS f32x4*)hout32 + lane)[64 * j] = h[j];
        if (hout16) { u32x2n w; w.x = pk2(h[j].x, h[j].y); w.y = pk2(h[j].z, h[j].w); ((GAS u32x2n*)hout16 + lane)[64 * j] = w; }
        s2 += (h[j].x * h[j].x + h[j].y * h[j].y) + (h[j].z * h[j].z + h[j].w * h[j].w); }
    if (pre_g) {
        const float rs2 = 1.0f / sqrtf(wave_sum(s2) * (1.0f / DM) + EPS);
        const GAS f32x4* qg = (const GAS f32x4*)pre_g + lane; GAS unsigned long long* o8 = (GAS unsigned long long*)urow + lane;
#pragma unroll
        for (int j = 0; j < 4; ++j) { const f32x4 gg = qg[64 * j];
            o8[64 * j] = (unsigned long long)pk2(h[j].x * rs2 * gg.x, h[j].y * rs2 * gg.y) | ((unsigned long long)pk2(h[j].z * rs2 * gg.z, h[j].w * rs2 * gg.w) << 32); }
    }
}

constexpr int IT_GU = 176 * 16, IT_D = 32 * 44, IT_IN = 328 * 16, IT_BRS = 32 * 32, IT_SQ = 32 * 16, IT_MKV = 64 * 16, IT_CMV = DECB * 128;
constexpr int IT_W = 2 * IT_GU + 2 * IT_D + IT_IN + IT_BRS + 4 * IT_SQ + IT_MKV + IT_CMV;
constexpr int IT_ROWS = MT   + NB * 256   + DECB * 256  ;
struct TrDesc { const float* W; bf16* WT; int ldw, col0, nvalid, k0, ldt, drow0, dk, sc; };
__device__ __forceinline__ TrDesc tr_decode(KArgs a, int r) {
    unsigned char* ws = a->ws; TrDesc d; d.nvalid = 32; d.dk = 0; d.sc = 0;
    if (r < IT_GU) { const int db = r >> 4, kb = r & 15, tile = db >> 3, within = db & 7, half = within >> 2, sub = within & 3;
        d.W = (const float*)a->in[half ? I_F1WU : I_F1WG]; d.ldw = FF; d.col0 = 128 * tile + 32 * sub; d.k0 = 64 * kb; d.WT = (bf16*)(ws + WS_WGU1); d.ldt = DM; d.drow0 = 32 * db; return d; }
    r -= IT_GU;
    if (r < IT_GU) { const int db = r >> 4, kb = r & 15, tile = db >> 3, within = db & 7, half = within >> 2, sub = within & 3;
        d.W = (const float*)a->in[half ? I_F2WU : I_F2WG]; d.ldw = FF; d.col0 = 128 * tile + 32 * sub; d.k0 = 64 * kb; d.WT = (bf16*)(ws + WS_WGU2); d.ldt = DM; d.drow0 = 32 * db; return d; }
    r -= IT_GU;
    if (r < IT_D) { const int db = r / 44, kb = r % 44; d.W = (const float*)a->in[I_F1WD]; d.ldw = DM; d.col0 = 32 * db; d.k0 = 64 * kb; d.WT = (bf16*)(ws + WS_WD1); d.ldt = FF; d.drow0 = 32 * db; return d; }
    r -= IT_D;
    if (r < IT_D) { const int db = r / 44, kb = r % 44; d.W = (const float*)a->in[I_F2WD]; d.ldw = DM; d.col0 = 32 * db; d.k0 = 64 * kb; d.WT = (bf16*)(ws + WS_WD2); d.ldt = FF; d.drow0 = 32 * db; return d; }
    r -= IT_D;
    if (r < IT_IN) {
        const int db = r >> 4, kb = r & 15, dd = 32 * db; int col, nv = 32;
        if (dd < 6144) col = dd;
        else if (dd < 8192) col = dd + 32;
        else if (dd < 10240) col = dd + 104;
        else if (dd < 10272) col = dd - 10240 + 6144;
        else if (dd < 10336) col = dd - 10272 + 8224;
        else if (dd < 10368) { col = 8288; nv = 8; }
        else { col = 0; nv = 0; }
        d.W = (const float*)a->in[I_WIN]; d.ldw = 10344; d.col0 = col; d.nvalid = nv; d.k0 = 64 * kb; d.WT = (bf16*)(ws + WS_WIN); d.ldt = DM; d.drow0 = dd; return d; }
    r -= IT_IN;
    if (r < IT_BRS) { const int db = r >> 5, kb = r & 31; d.W = (const float*)a->in[I_WBRS]; d.ldw = DM; d.col0 = 32 * db; d.k0 = 64 * kb; d.WT = (bf16*)(ws + WS_WBRS); d.ldt = 3072; d.drow0 = 32 * db; d.sc = 1; return d; }
    r -= IT_BRS;
    if (r < 4 * IT_SQ) { const int w = r / IT_SQ, q = r % IT_SQ, db = q >> 4, kb = q & 15;
        d.W = (const float*)a->in[w == 0 ? I_WBRA : w == 1 ? I_WOUT : w == 2 ? I_WMQ : I_WMO];
        d.WT = (bf16*)(ws + (w == 0 ? WS_WBRS : w == 1 ? WS_WOUT : w == 2 ? WS_WMQ : WS_WMO)); d.ldw = DM; d.col0 = 32 * db; d.k0 = 64 * kb; d.ldt = w == 0 ? 3072 : DM; d.dk = w == 0 ? 2048 : 0; d.drow0 = 32 * db; return d; }
    r -= 4 * IT_SQ;
    if (r < IT_MKV) { const int db = r >> 4, kb = r & 15; d.W = (const float*)a->in[db < 32 ? I_WMK : I_WMV]; d.ldw = DM; d.col0 = 32 * (db & 31); d.k0 = 64 * kb; d.WT = (bf16*)(ws + WS_WMKV); d.ldt = DM; d.drow0 = 32 * db; return d; }
    r -= IT_MKV;
    { const int b = r >> 7, q = r & 127, db = q >> 2, kb = q & 3;
      d.W = (const float*)a->in[I_CMV] + (size_t)b * 256 * DM; d.ldw = DM; d.col0 = 32 * db; d.k0 = 64 * kb; d.WT = (bf16*)(ws + WS_MVT) + (size_t)(NB + b) * DM * 256; d.ldt = 256; d.drow0 = 32 * db; return d; }
}
__device__ __forceinline__ void tr_load(const TrDesc& d, const float* ksc, int lane, float (&v)[32], f32x4 (&gk)[2]) {
    const int c = lane & 31, ce = c < d.nvalid ? c : 0;
    const float* p = d.W + (size_t)(d.k0 + (lane >> 5)) * d.ldw + d.col0 + ce;
#pragma unroll
    for (int i = 0; i < 32; ++i) v[i] = p[(size_t)(2 * i) * d.ldw];
    const float* gp = ksc + (d.sc ? d.k0 : 0) + 8 * (lane & 7);
    gk[0] = *(const f32x4*)gp; gk[1] = *(const f32x4*)(gp + 4);
}
__device__ __forceinline__ void tr_store(const TrDesc& d, int lane, const float (&v)[32], const f32x4 (&gkin)[2], LAS float* scr) {
    f32x4 gk[2] = {gkin[0], gkin[1]};
    if (!d.sc) { gk[0] = (f32x4){1.f, 1.f, 1.f, 1.f}; gk[1] = (f32x4){1.f, 1.f, 1.f, 1.f}; }
    const int c = lane & 31; const bool ok = c < d.nvalid;
#pragma unroll
    for (int i = 0; i < 32; ++i) scr[(2 * i + (lane >> 5)) * 33 + c] = ok ? v[i] : 0.f;
    LDS_WAIT(); asm volatile("" ::: "memory");
    const int c8 = lane & 7;
#pragma unroll
    for (int j = 0; j < 4; ++j) {
        const int n = (lane >> 3) + 8 * j; const LAS float* s = scr + (8 * c8) * 33 + n;
        v4u o; o.x = pk2(s[0 * 33] * gk[0].x, s[1 * 33] * gk[0].y); o.y = pk2(s[2 * 33] * gk[0].z, s[3 * 33] * gk[0].w); o.z = pk2(s[4 * 33] * gk[1].x, s[5 * 33] * gk[1].y); o.w = pk2(s[6 * 33] * gk[1].z, s[7 * 33] * gk[1].w);
        *(GAS v4u*)(d.WT + (size_t)(d.drow0 + n) * d.ldt + d.dk + d.k0 + 8 * c8) = o;
    }
    LDS_WAIT(); asm volatile("" ::: "memory");
}
__device__ __forceinline__ void row_src(KArgs a, int r, const float*& src, const float*& g, bf16*& dst, int& kind) {
    unsigned char* ws = a->ws;
    if (r < MT) { const int rr = r < MR ? r : MR - 1; src = rr < MP ? (const float*)a->in[I_XP] + (size_t)rr * DM : (const float*)a->in[I_XS] + (size_t)(rr - MP) * DM;
        g = (const float*)a->in[I_F1PRE]; dst = (bf16*)(ws + WS_U) + (size_t)r * DM; kind = r < MR ? 0 : 2; return; }
    r -= MT;
    if (r < NB * 256) { src = (const float*)a->in[I_MEMP] + (size_t)r * DM; g = (const float*)a->in[I_MEMKVG]; dst = (bf16*)(ws + WS_MN) + (size_t)r * DM; kind = 0; return; }
    r -= NB * 256;
    src = (const float*)a->in[I_CMK] + (size_t)r * DM; g = (const float*)a->in[I_F1PRE]; dst = (bf16*)(ws + WS_MKB) + (size_t)(NB * 256 + r) * DM; kind = 1;
}
__device__ __forceinline__ void row_finish(const f32x4 (&v)[4], const float* g, bf16* dst, int kind, int lane) {
    float s = 0.f;
#pragma unroll
    for (int j = 0; j < 4; ++j) s += (v[j].x * v[j].x + v[j].y * v[j].y) + (v[j].z * v[j].z + v[j].w * v[j].w);
    const float rs = kind == 0 ? 1.0f / sqrtf(wave_sum(s) * (1.0f / DM) + EPS) : (kind == 1 ? 1.0f : 0.0f);
    const GAS f32x4* gr = (const GAS f32x4*)g + lane; GAS unsigned long long* o8 = (GAS unsigned long long*)dst + lane;
#pragma unroll
    for (int j = 0; j < 4; ++j) { f32x4 gg = gr[64 * j]; if (kind != 0) gg = (f32x4){1.f, 1.f, 1.f, 1.f};
        o8[64 * j] = (unsigned long long)pk2(v[j].x * rs * gg.x, v[j].y * rs * gg.y) | ((unsigned long long)pk2(v[j].z * rs * gg.z, v[j].w * rs * gg.w) << 32); }
}
constexpr int TR_GU2 = IT_GU, TR_D1 = 2 * IT_GU, TR_D2 = TR_D1 + IT_D, TR_IN = TR_D2 + IT_D, TR_BRS = TR_IN + IT_IN, TR_MKV = TR_BRS + IT_BRS + 4 * IT_SQ, TR_CMV = TR_MKV + IT_MKV;
struct TrSet { int n0, lo0, n1, lo1, n2, lo2, n3, lo3; };
__device__ __forceinline__ int tr_map(const TrSet& s, int v) {
    if (v < s.n0) return s.lo0 + v;
    v -= s.n0; if (v < s.n1) return s.lo1 + v;
    v -= s.n1; if (v < s.n2) return s.lo2 + v;
    return s.lo3 + (v - s.n2);
}
__device__ __forceinline__ void tr_run(KArgs a, LAS float* scr, int lane, int first, int stride, const TrSet& s) {
    const int total = s.n0 + s.n1 + s.n2 + s.n3;
    if (first < total) {
        const float* ksc = (const float*)a->in[I_SSDG];
        TrDesc dc = tr_decode(a, tr_map(s, first)); float vc[32]; f32x4 gc[2]; tr_load(dc, ksc, lane, vc, gc);
        for (int it = first; it < total; it += stride) {
            const int nit = it + stride < total ? it + stride : it;
            const TrDesc dn = tr_decode(a, tr_map(s, nit)); float vn[32]; f32x4 gn[2]; tr_load(dn, ksc, lane, vn, gn);
            tr_store(dc, lane, vc, gc, scr);
            dc = dn; gc[0] = gn[0]; gc[1] = gn[1];
#pragma unroll
            for (int i = 0; i < 32; ++i) vc[i] = vn[i];
        }
    }
}
__device__ __forceinline__ void tr_tail(KArgs a, LAS unsigned char* lds, int wave, int lane, int thr, int G, const TrSet& s) {
    const int c = (int)blockIdx.x;
    if (c < thr) return;
    tr_run(a, (LAS float*)(lds + wave * 16384), lane, (c - thr) * NWAVES + wave, (G - thr) * NWAVES, s);
}
__device__ __forceinline__ void rows_run(KArgs a, int lane, int first, int stride, int lo, int hi) {
    for (int r = lo + first; r < hi; r += 2 * stride) {
        const int r2 = r + stride < hi ? r + stride : r;
        const float *s0, *g0, *s1, *g1; bf16 *d0, *d1; int k0, k1;
        row_src(a, r, s0, g0, d0, k0); row_src(a, r2, s1, g1, d1, k1);
        f32x4 v0[4], v1[4];
#pragma unroll
        for (int j = 0; j < 4; ++j) { v0[j] = ((const GAS f32x4*)s0 + lane)[64 * j]; v1[j] = ((const GAS f32x4*)s1 + lane)[64 * j]; }
        row_finish(v0, g0, d0, k0, lane);
        if (r2 != r) row_finish(v1, g1, d1, k1, lane);
    }
}
constexpr int ROWS_P0 = MT + NB * 256;
__device__ __forceinline__ void prologue(KArgs a, LAS unsigned char* lds, int wave, int lane, int gw, int NGW) {
    LAS float* scr = (LAS float*)(lds + wave * 16384);
    tr_run(a, scr, lane, gw, NGW, TrSet{IT_GU, 0, IT_D, TR_D1, IT_IN, TR_IN, IT_MKV, TR_MKV});
    rows_run(a, lane, gw, NGW, 0, ROWS_P0);
}

namespace ssd {
typedef short s16x8 __attribute__((ext_vector_type(8)));
typedef float f4 __attribute__((ext_vector_type(4)));
typedef unsigned u2 __attribute__((ext_vector_type(2)));
typedef unsigned u4 __attribute__((ext_vector_type(4)));
constexpr int P_C = 272, P_S = 144;
constexpr int L_CS = 0, L_BS = 17408, L_BST = 34816, L_XT = 53248, L_XWT = 62464, L_HS = 71680, L_MS = 89088, L_DT = 98304, L_ACS = 98560, L_SSQ = 98816, L_WG = 100864, L_END = 101120;
static_assert(L_END <= 131072, "ssd LDS");
__device__ __forceinline__ f4 mfma16(s16x8 a, s16x8 b, f4 c) { return __builtin_amdgcn_mfma_f32_16x16x32_bf16(a, b, c, 0, 0, 0); }
#define SSD_FRAG(off) (*(const LAS s16x8*)(lds + (off)))
#define SSD_LO(w) __uint_as_float((w) << 16)
#define SSD_HI(w) __uint_as_float((w) & 0xffff0000u)
#define SSD_SYNC() asm volatile("s_waitcnt lgkmcnt(0)\n\ts_barrier" ::: "memory")
#ifdef DBG_SSDMARK
#define SSD_MARK(k_) { const unsigned long long now_ = __builtin_amdgcn_s_memtime(); tacc_[k_] += now_ - tmark_; tmark_ = now_; }
#define SSD_MARK_INIT() unsigned long long tmark_ = __builtin_amdgcn_s_memtime(); unsigned long long tacc_[4] = {0ull, 0ull, 0ull, 0ull};
#define SSD_MARK_FLUSH() if (tid_in == 0 && !smp) { for (int k_ = 0; k_ < 4; ++k_) atomicAdd((unsigned*)(a_in->ws + WS_CTL + 768 * 1024) + 16 + k_, (unsigned)(tacc_[k_] >> 4)); }
#else
#define SSD_MARK(k_)
#define SSD_MARK_INIT()
#define SSD_MARK_FLUSH()
#endif

__device__ __forceinline__ int chan_col(int ci, int g, int h) { return ci < 64 ? 256 * g + 64 * h + ci : (ci < 192 ? 2048 + 128 * g + (ci - 64) : 3072 + 128 * g + (ci - 192)); }


__device__ __forceinline__ void conv_rows(int tid, const bf16* __restrict__ XBC, bf16* __restrict__ XA, const float* __restrict__ convw, const float* __restrict__ convb,
                                          int rowstart, int nrows, int seq_t0, const float* __restrict__ halo) {
    const int col = 8 * tid;
    float w[4][8], bb[8], win[3][8];
#pragma unroll
    for (int k = 0; k < 4; ++k) { const f4 a0 = *(const f4*)(convw + k * 4096 + col), a1 = *(const f4*)(convw + k * 4096 + col + 4);
        w[k][0] = a0.x; w[k][1] = a0.y; w[k][2] = a0.z; w[k][3] = a0.w; w[k][4] = a1.x; w[k][5] = a1.y; w[k][6] = a1.z; w[k][7] = a1.w; }
    { const f4 a0 = *(const f4*)(convb + col), a1 = *(const f4*)(convb + col + 4); bb[0] = a0.x; bb[1] = a0.y; bb[2] = a0.z; bb[3] = a0.w; bb[4] = a1.x; bb[5] = a1.y; bb[6] = a1.z; bb[7] = a1.w; }
#pragma unroll
    for (int k = 0; k < 3; ++k) {
        const int t = seq_t0 - 3 + k;
        if (t >= 0) { const u4 v = *(const u4*)(XBC + (size_t)(rowstart - 3 + k) * 4096 + col);
            win[k][0] = SSD_LO(v.x); win[k][1] = SSD_HI(v.x); win[k][2] = SSD_LO(v.y); win[k][3] = SSD_HI(v.y); win[k][4] = SSD_LO(v.z); win[k][5] = SSD_HI(v.z); win[k][6] = SSD_LO(v.w); win[k][7] = SSD_HI(v.w);
        } else if (halo) { const f4 a0 = *(const f4*)(halo + (size_t)(3 + t) * 4096 + col), a1 = *(const f4*)(halo + (size_t)(3 + t) * 4096 + col + 4);
            win[k][0] = a0.x; win[k][1] = a0.y; win[k][2] = a0.z; win[k][3] = a0.w; win[k][4] = a1.x; win[k][5] = a1.y; win[k][6] = a1.z; win[k][7] = a1.w;
        } else {
#pragma unroll
            for (int j = 0; j < 8; ++j) win[k][j] = 0.f; }
    }
    for (int i0 = 0; i0 < nrows; i0 += 16) {
        u4 rv[16];
#pragma unroll
        for (int i = 0; i < 16; ++i) { const int ri = i0 + i < nrows ? i0 + i : nrows - 1; rv[i] = *(const u4*)(XBC + (size_t)(rowstart + ri) * 4096 + col); }
#pragma unroll
        for (int i = 0; i < 16; ++i) {
            const u4 v = rv[i];
            float cur[8]; cur[0] = SSD_LO(v.x); cur[1] = SSD_HI(v.x); cur[2] = SSD_LO(v.y); cur[3] = SSD_HI(v.y); cur[4] = SSD_LO(v.z); cur[5] = SSD_HI(v.z); cur[6] = SSD_LO(v.w); cur[7] = SSD_HI(v.w);
            float y[8];
#pragma unroll
            for (int j = 0; j < 8; ++j) { const float t = bb[j] + w[0][j] * win[0][j] + w[1][j] * win[1][j] + w[2][j] * win[2][j] + w[3][j] * cur[j];
                y[j] = t * __builtin_amdgcn_rcpf(1.0f + __expf(-t)); win[0][j] = win[1][j]; win[1][j] = win[2][j]; win[2][j] = cur[j]; }
            u4 o; o.x = pk2(y[0], y[1]); o.y = pk2(y[2], y[3]); o.z = pk2(y[4], y[5]); o.w = pk2(y[6], y[7]);
            if (i0 + i < nrows) *(u4*)(XA + (size_t)(rowstart + i0 + i) * 4096 + col) = o;
        }
    }
}

__device__ __forceinline__ void ssd_unit(LAS unsigned char* lds, int tid_in, KArgs a_in, int seqrow0, int ntok, int g, int h, int b, bool smp) {
    const int wave = __builtin_amdgcn_readfirstlane(tid_in >> 6);
    const int tb = wave & 3, ph = wave >> 2, nb = wave;
    const int nchunks = (ntok + 63) >> 6;
    const int hd = 4 * g + h;
    f4 hacc[4];
    u2 zn[2];
    u4 rawp[8];
    float dt_raw = 0.f;
    {
        const int lane = tid_in & 63, l15 = lane & 15, lq = lane >> 4;
        const float* h0 = smp ? (const float*)a_in->in[I_SSM] + (size_t)b * 32 * 64 * 128 : nullptr;
#pragma unroll
        for (int pb = 0; pb < 4; ++pb) {
            if (h0) hacc[pb] = *(const f4*)(h0 + ((size_t)hd * 64 + 16 * pb + l15) * 128 + 16 * nb + 4 * lq);
            else hacc[pb] = (f4){0.f, 0.f, 0.f, 0.f};
        }
        if (tid_in < 320) {
            const int cg = tid_in >> 3, rs = tid_in & 7, col = chan_col(8 * cg, g, h);
            const bf16* XA = (const bf16*)(a_in->ws + WS_XBCA);
#pragma unroll
            for (int i = 0; i < 8; ++i) rawp[i] = *(const u4*)(XA + (size_t)(seqrow0 + 8 * rs + i) * 4096 + col);
        } else if (wave == 5) { if (lane < ntok) dt_raw = ((const float*)(a_in->ws + WS_MISC))[(size_t)(seqrow0 + lane) * 256 + hd]; }
        { const int tc0 = 16 * tb + l15, trow = seqrow0 + (tc0 < ntok ? tc0 : 0); const bf16* Z = (const bf16*)(a_in->ws + WS_Z);
#pragma unroll
          for (int pbi = 0; pbi < 2; ++pbi) zn[pbi] = *(const u2*)(Z + (size_t)trow * 2048 + 64 * hd + 16 * (2 * ph + pbi) + 4 * lq); }
    }
    const float dt_bias = ((const float*)a_in->in[I_DTB])[hd], a_neg = -expf(((const float*)a_in->in[I_ALOG])[hd]), dsk = ((const float*)a_in->in[I_DSKIP])[hd];
    __syncthreads();
    unsigned char* const ws_unit = a_in->ws;
    SSD_MARK_INIT()
    for (int c = 0; c < nchunks; ++c) {
        SSD_MARK(0)
        int tid = tid_in; asm volatile("" : "+v"(tid));
        unsigned char* wsp = ws_unit;
        const int lane = tid & 63, l15 = lane & 15, lq = lane >> 4;
        const int nvalid = (ntok - 64 * c) < 64 ? (ntok - 64 * c) : 64;
        const int rowbase = seqrow0 + 64 * c;
        if (tid < 320) {
            const int cg = tid >> 3, rs = tid & 7;
            u4 rw[8];
#pragma unroll
            for (int i = 0; i < 8; ++i) rw[i] = (8 * rs + i < nvalid) ? rawp[i] : (u4){0u, 0u, 0u, 0u};
            if (wave != 0) {
                const bool isB = wave < 3; const int n0 = 8 * (isB ? cg - 8 : cg - 24);
#pragma unroll
                for (int i = 0; i < 8; ++i) *(LAS u4*)(lds + (isB ? L_BS : L_CS) + (8 * rs + i) * P_C + n0 * 2) = rw[i];
            }
            if (wave < 3) {
                const int c0 = (wave == 0) ? 8 * cg : 8 * (cg - 8);
                LAS unsigned char* tb_ = lds + (wave == 0 ? L_XT : L_BST) + c0 * P_S + 16 * rs;
#pragma unroll
                for (int q = 0; q < 4; ++q) {
                    u4 lo, hi;
                    lo.x = (rw[0][q] & 0xffffu) | (rw[1][q] << 16); lo.y = (rw[2][q] & 0xffffu) | (rw[3][q] << 16); lo.z = (rw[4][q] & 0xffffu) | (rw[5][q] << 16); lo.w = (rw[6][q] & 0xffffu) | (rw[7][q] << 16);
                    hi.x = (rw[0][q] >> 16) | (rw[1][q] & 0xffff0000u); hi.y = (rw[2][q] >> 16) | (rw[3][q] & 0xffff0000u); hi.z = (rw[4][q] >> 16) | (rw[5][q] & 0xffff0000u); hi.w = (rw[6][q] >> 16) | (rw[7][q] & 0xffff0000u);
                    *(LAS u4*)(tb_ + (2 * q) * P_S) = lo; *(LAS u4*)(tb_ + (2 * q + 1) * P_S) = hi; }
            }
        } else if (wave == 5) {
            float dtv = 0.f;
            if (lane < nvalid) { const float xr = dt_raw + dt_bias;
                const float e = __expf(fminf(xr, 20.f)); dtv = xr > 20.f ? xr : (e < 1e-4f ? e * (1.0f - 0.5f * e) : __logf(1.0f + e)); }
            LAS float* dtl = (LAS float*)(lds + L_DT); LAS float* acl = (LAS float*)(lds + L_ACS);
            dtl[lane] = dtv;
            float cs = dtv * a_neg;
#define SSD_DPP_ADD(ctrl, rmask) cs += __builtin_bit_cast(float, __builtin_amdgcn_update_dpp(0, __builtin_bit_cast(int, cs), ctrl, rmask, 0xf, false))
            SSD_DPP_ADD(0x111, 0xf); SSD_DPP_ADD(0x112, 0xf); SSD_DPP_ADD(0x114, 0xf); SSD_DPP_ADD(0x118, 0xf); SSD_DPP_ADD(0x142, 0xa); SSD_DPP_ADD(0x143, 0xc);
#undef SSD_DPP_ADD
            acl[lane] = cs;
            const float cs_end = __builtin_bit_cast(float, __builtin_amdgcn_readlane(__builtin_bit_cast(int, cs), 63));
            ((LAS float*)(lds + L_WG))[lane] = dtv * __expf(cs_end - cs);
        } else if (wave == 6 && c > 0) {
            float tot = 0.f;
#pragma unroll
            for (int q = 0; q < 8; ++q) tot += ((const LAS float*)(lds + L_SSQ))[q * 64 + lane];
            ((float*)(wsp + WS_SSQ))[(size_t)(rowbase - 64 + lane) * 32 + hd] = tot;
        }
        SSD_SYNC();
        SSD_MARK(1)
        const int bC = l15 * P_C + 16 * lq, bS = l15 * P_S + 16 * lq;
        const int tcol = 16 * tb + l15;
        u2 zz[2];
        {
            zz[0] = zn[0]; zz[1] = zn[1];
            const bool more = c + 1 < nchunks;
            const int nb_row = more ? rowbase + 64 : rowbase;
            { const bf16* Z = (const bf16*)(wsp + WS_Z); const int nv2 = more ? ntok - 64 * (c + 1) : nvalid; const int trow = nb_row + (tcol < nv2 ? tcol : 0);
#pragma unroll
              for (int pbi = 0; pbi < 2; ++pbi) zn[pbi] = *(const u2*)(Z + (size_t)trow * 2048 + 64 * hd + 16 * (2 * ph + pbi) + 4 * lq); }
            { const int tl = lane < ntok - (nb_row - seqrow0) ? lane : 0; dt_raw = ((const float*)(wsp + WS_MISC))[(size_t)(nb_row + tl) * 256 + hd]; }
            { const int t2 = tid < 320 ? tid : 0, cg = t2 >> 3, rs = t2 & 7, col = chan_col(8 * cg, g, h); const bf16* XA = (const bf16*)(wsp + WS_XBCA);
#pragma unroll
              for (int i = 0; i < 8; ++i) rawp[i] = *(const u4*)(XA + (size_t)(nb_row + 8 * rs + i) * 4096 + col); }
        }
        s16x8 cfr[4], btf[2];
#pragma unroll
        for (int ks = 0; ks < 4; ++ks) cfr[ks] = SSD_FRAG(bC + L_CS + 16 * tb * P_C + 64 * ks);
#pragma unroll
        for (int ks = 0; ks < 2; ++ks) btf[ks] = SSD_FRAG(bS + L_BST + 16 * nb * P_S + 64 * ks);
        f4 gt[2];
#pragma unroll
        for (int sbi = 0; sbi < 2; ++sbi) { gt[sbi] = (f4){0.f, 0.f, 0.f, 0.f};
#pragma unroll
            for (int ks = 0; ks < 4; ++ks) gt[sbi] = mfma16(SSD_FRAG(bC + L_BS + 16 * (2 * ph + sbi) * P_C + 64 * ks), cfr[ks], gt[sbi]); }
        const LAS float* dtl = (const LAS float*)(lds + L_DT); const LAS float* acl = (const LAS float*)(lds + L_ACS);
        const float acs_end = acl[63], acs_t = acl[tcol];
#pragma unroll
        for (int pb = 0; pb < 4; ++pb) { const f4 v = hacc[pb]; u2 w; w.x = pk2(v.x, v.y); w.y = pk2(v.z, v.w);
            *(LAS u2*)(lds + L_HS + (16 * pb + l15) * P_C + (16 * nb + 4 * lq) * 2) = w; }
        { const int p = tid >> 3, s0 = 8 * (tid & 7);
          const u4 xv = *(const LAS u4*)(lds + L_XT + p * P_S + s0 * 2);
          const f4 w0 = *(const LAS f4*)((const LAS float*)(lds + L_WG) + s0), w1 = *(const LAS f4*)((const LAS float*)(lds + L_WG) + s0 + 4);
          u4 w;
          w.x = pk2(SSD_LO(xv.x) * w0.x, SSD_HI(xv.x) * w0.y); w.y = pk2(SSD_LO(xv.y) * w0.z, SSD_HI(xv.y) * w0.w);
          w.z = pk2(SSD_LO(xv.z) * w1.x, SSD_HI(xv.z) * w1.y); w.w = pk2(SSD_LO(xv.w) * w1.z, SSD_HI(xv.w) * w1.w);
          *(LAS u4*)(lds + L_XWT + p * P_S + s0 * 2) = w; }
#pragma unroll
        for (int sbi = 0; sbi < 2; ++sbi) { const int s0 = 16 * (2 * ph + sbi) + 4 * lq;
            const f4 as = *(const LAS f4*)(acl + s0), ds = *(const LAS f4*)(dtl + s0); const f4 gv = gt[sbi];
            const float m0 = (s0 + 0 <= tcol) ? gv.x * __expf(acs_t - as.x) * ds.x : 0.f, m1 = (s0 + 1 <= tcol) ? gv.y * __expf(acs_t - as.y) * ds.y : 0.f;
            const float m2 = (s0 + 2 <= tcol) ? gv.z * __expf(acs_t - as.z) * ds.z : 0.f, m3 = (s0 + 3 <= tcol) ? gv.w * __expf(acs_t - as.w) * ds.w : 0.f;
            u2 w; w.x = pk2(m0, m1); w.y = pk2(m2, m3);
            *(LAS u2*)(lds + L_MS + tcol * P_S + s0 * 2) = w; }
        SSD_SYNC();
        SSD_MARK(2)
        const float e_t = __expf(acs_t);
        float sq = 0.f;
        bf16* YS = (bf16*)(wsp + WS_YC);
#pragma unroll
        for (int pbi = 0; pbi < 2; ++pbi) { const int pb = 2 * ph + pbi; f4 y = (f4){0.f, 0.f, 0.f, 0.f};
#pragma unroll
            for (int ks = 0; ks < 4; ++ks) y = mfma16(SSD_FRAG(bC + L_HS + 16 * pb * P_C + 64 * ks), cfr[ks], y);
            y = y * e_t;
#pragma unroll
            for (int ks = 0; ks < 2; ++ks) y = mfma16(SSD_FRAG(bS + L_XT + 16 * pb * P_S + 64 * ks), SSD_FRAG(bS + L_MS + 16 * tb * P_S + 64 * ks), y);
            const int p0 = 16 * pb + 4 * lq;
            const LAS unsigned short* xp = (const LAS unsigned short*)(lds + L_XT + p0 * P_S + tcol * 2);
            y.x += dsk * SSD_LO((unsigned)xp[0]); y.y += dsk * SSD_LO((unsigned)xp[P_S / 2]); y.z += dsk * SSD_LO((unsigned)xp[P_S]); y.w += dsk * SSD_LO((unsigned)xp[3 * P_S / 2]);
            {
                const bool ok = tcol < nvalid;
                const u2 z2 = zz[pbi];
                y.x *= silu_f(SSD_LO(z2.x)); y.y *= silu_f(SSD_HI(z2.x)); y.z *= silu_f(SSD_LO(z2.y)); y.w *= silu_f(SSD_HI(z2.y));
                u2 w; w.x = pk2(y.x, y.y); w.y = pk2(y.z, y.w);
                bf16* dst = ok ? YS + (size_t)(rowbase + tcol) * YCP + 64 * hd + p0 : (bf16*)(wsp + WS_DUMMY) + (size_t)tid * 8 + 4 * pbi;
                *(u2*)dst = w;
                const float q0 = SSD_LO(w.x), q1 = SSD_HI(w.x), q2 = SSD_LO(w.y), q3 = SSD_HI(w.y);
                sq += ok ? (q0 * q0 + q1 * q1) + (q2 * q2 + q3 * q3) : 0.f;
            } }
        ((LAS float*)(lds + L_SSQ))[(ph * 4 + lq) * 64 + tcol] = sq;
        const float e_end = __expf(acs_end);
#pragma unroll
        for (int pb = 0; pb < 4; ++pb) { f4 v = hacc[pb] * e_end;
#pragma unroll
            for (int ks = 0; ks < 2; ++ks) v = mfma16(btf[ks], SSD_FRAG(bS + L_XWT + 16 * pb * P_S + 64 * ks), v);
            hacc[pb] = v; }
        SSD_SYNC();
        SSD_MARK(3)
    }
    SSD_MARK_FLUSH()
    {
        const int lane = tid_in & 63, l15 = lane & 15, lq = lane >> 4;
        if (wave == 6) {
            float tot = 0.f;
#pragma unroll
            for (int q = 0; q < 8; ++q) tot += ((const LAS float*)(lds + L_SSQ))[q * 64 + lane];
            if (lane < ntok - 64 * (nchunks - 1)) ((float*)(a_in->ws + WS_SSQ))[(size_t)(seqrow0 + 64 * (nchunks - 1) + lane) * 32 + hd] = tot;
        }
        float* hout = a_in->out + (smp ? O_SSMS : O_SSMP) + (size_t)b * 32 * 64 * 128;
#pragma unroll
        for (int pb = 0; pb < 4; ++pb) *(f4*)(hout + ((size_t)hd * 64 + 16 * pb + l15) * 128 + 16 * nb + 4 * lq) = hacc[pb];
    }
    __syncthreads();
}


__device__ __forceinline__ void ssd_sample_unit(LAS unsigned char* lds, int tid, KArgs a, int b, int hd) {
    const int p = tid >> 3, nc = tid & 7, g = hd >> 2;
    unsigned char* ws = a->ws;
    const float* hin = (const float*)a->in[I_SSM] + ((size_t)(b * 32 + hd) * 64 + p) * 128 + 16 * nc;
    float* hout = a->out + O_SSMS + ((size_t)(b * 32 + hd) * 64 + p) * 128 + 16 * nc;
    f4 h[4];
#pragma unroll
    for (int q = 0; q < 4; ++q) h[q] = *(const f4*)(hin + 4 * q);
    const float dt_bias = ((const float*)a->in[I_DTB])[hd], a_neg = -expf(((const float*)a->in[I_ALOG])[hd]), dsk = ((const float*)a->in[I_DSKIP])[hd];
    const bf16* XA = (const bf16*)(ws + WS_XBCA); const bf16* Z = (const bf16*)(ws + WS_Z); const float* MI = (const float*)(ws + WS_MISC); bf16* YS = (bf16*)(ws + WS_YC);
    u4 bv[4][2], cv[4][2]; float xv[4], zv[4], dtr[4];
#pragma unroll
    for (int t = 0; t < 4; ++t) { const size_t row = (size_t)(MP + 4 * b + t);
        bv[t][0] = *(const u4*)(XA + row * 4096 + 2048 + 128 * g + 16 * nc); bv[t][1] = *(const u4*)(XA + row * 4096 + 2048 + 128 * g + 16 * nc + 8);
        cv[t][0] = *(const u4*)(XA + row * 4096 + 3072 + 128 * g + 16 * nc); cv[t][1] = *(const u4*)(XA + row * 4096 + 3072 + 128 * g + 16 * nc + 8);
        xv[t] = __uint_as_float((unsigned)XA[row * 4096 + 64 * hd + p] << 16); zv[t] = __uint_as_float((unsigned)Z[row * 2048 + 64 * hd + p] << 16); dtr[t] = MI[row * 256 + hd]; }
    LAS float* sql = (LAS float*)lds;
#pragma unroll
    for (int t = 0; t < 4; ++t) {
        const float xr = dtr[t] + dt_bias; const float e = __expf(fminf(xr, 20.f)); const float dt = xr > 20.f ? xr : (e < 1e-4f ? e * (1.0f - 0.5f * e) : __logf(1.0f + e));
        const float dec = __expf(dt * a_neg), dx = dt * xv[t];
        float yp = 0.f;
#pragma unroll
        for (int q = 0; q < 4; ++q) {
            const unsigned b0 = bv[t][q >> 1][2 * (q & 1)], b1 = bv[t][q >> 1][2 * (q & 1) + 1], c0 = cv[t][q >> 1][2 * (q & 1)], c1 = cv[t][q >> 1][2 * (q & 1) + 1];
            h[q].x = h[q].x * dec + dx * SSD_LO(b0); h[q].y = h[q].y * dec + dx * SSD_HI(b0); h[q].z = h[q].z * dec + dx * SSD_LO(b1); h[q].w = h[q].w * dec + dx * SSD_HI(b1);
            yp += (SSD_LO(c0) * h[q].x + SSD_HI(c0) * h[q].y) + (SSD_LO(c1) * h[q].z + SSD_HI(c1) * h[q].w);
        }
#define SSD_DPP_FADD(ctrl) yp += __builtin_bit_cast(float, __builtin_amdgcn_update_dpp(0, __builtin_bit_cast(int, yp), ctrl, 0xf, 0xf, false))
        SSD_DPP_FADD(0xB1); SSD_DPP_FADD(0x4E); SSD_DPP_FADD(0x141);
#undef SSD_DPP_FADD
        float y = (yp + dsk * xv[t]) * silu_f(zv[t]);
        const unsigned yb = f2bf(y); y = __uint_as_float(yb << 16);
        if (nc == 0) { YS[(size_t)(MP + 4 * b + t) * YCP + 64 * hd + p] = (bf16)yb; sql[t * 64 + p] = y * y; }
    }
#pragma unroll
    for (int q = 0; q < 4; ++q) *(f4*)(hout + 4 * q) = h[q];
    __syncthreads();
    if (tid < 4) { float sm = 0.f; for (int i = 0; i < 64; ++i) sm += sql[tid * 64 + i]; ((float*)(ws + WS_SSQ))[(size_t)(MP + 4 * b + tid) * 32 + hd] = sm; }
    __syncthreads();
}

__device__ __forceinline__ void ssd_norm_rows4(bf16* yrow0, const float* ssq_row0, const float* __restrict__ gain, int lane) {
    u4 v[4][4]; f4 s4[4];
#pragma unroll
    for (int r = 0; r < 4; ++r) { s4[r] = *(const f4*)(ssq_row0 + r * 32 + 4 * (lane >> 3));
#pragma unroll
        for (int i = 0; i < 4; ++i) v[r][i] = ((const u4*)(yrow0 + (size_t)r * YCP + 32 * lane))[i]; }
    const f4* gp = (const f4*)(gain + 32 * lane);
#pragma unroll
    for (int r = 0; r < 4; ++r) {
        const float rs = 1.0f / sqrtf(((s4[r].x + s4[r].y) + (s4[r].z + s4[r].w)) * (1.0f / 256.0f) + EPS);
        u4* p = (u4*)(yrow0 + (size_t)r * YCP + 32 * lane);
#pragma unroll
        for (int i = 0; i < 4; ++i) { const u4 x = v[r][i]; const f4 g0 = gp[2 * i], g1 = gp[2 * i + 1]; u4 o;
            o.x = pk2(SSD_LO(x.x) * rs * g0.x, SSD_HI(x.x) * rs * g0.y); o.y = pk2(SSD_LO(x.y) * rs * g0.z, SSD_HI(x.y) * rs * g0.w);
            o.z = pk2(SSD_LO(x.z) * rs * g1.x, SSD_HI(x.z) * rs * g1.y); o.w = pk2(SSD_LO(x.w) * rs * g1.z, SSD_HI(x.w) * rs * g1.w);
            p[i] = o; }
    }
}
}

namespace dsa {
typedef short s16x8 __attribute__((ext_vector_type(8)));
typedef short s16x4 __attribute__((ext_vector_type(4)));
typedef float f4 __attribute__((ext_vector_type(4)));
typedef float f16v __attribute__((ext_vector_type(16)));
typedef unsigned u2 __attribute__((ext_vector_type(2)));
typedef unsigned u4 __attribute__((ext_vector_type(4)));
__device__ __forceinline__ f16v mfma32(s16x8 a, s16x8 b, f16v c) { return __builtin_amdgcn_mfma_f32_32x32x16_bf16(a, b, c, 0, 0, 0); }
__device__ __forceinline__ unsigned f2key(float f) { const unsigned b = __float_as_uint(f + 0.0f); return (b & 0x80000000u) ? ~b : (b | 0x80000000u); }
__device__ __forceinline__ int wave_count(bool p) { return (int)__builtin_popcountll(__builtin_amdgcn_ballot_w64(p)); }
__device__ __forceinline__ unsigned lower_count(bool p) { const unsigned long long bm = __builtin_amdgcn_ballot_w64(p);
    return __builtin_amdgcn_mbcnt_hi((unsigned)(bm >> 32), __builtin_amdgcn_mbcnt_lo((unsigned)bm, 0u)); }

__device__ __forceinline__ void idx_tile(const s16x8 (&afr)[4], const s16x8 (&bfr)[4], const f4 (&wv)[4], float (&sc)[4]) {
    f16v d;
#pragma unroll
    for (int i = 0; i < 16; ++i) d[i] = 0.f;
#pragma unroll
    for (int ks = 0; ks < 4; ++ks) d = mfma32(afr[ks], bfr[ks], d);
#pragma unroll
    for (int tq = 0; tq < 4; ++tq) {
        float p = wv[tq].x * fmaxf(d[4 * tq + 0], 0.f) + wv[tq].y * fmaxf(d[4 * tq + 1], 0.f) + wv[tq].z * fmaxf(d[4 * tq + 2], 0.f) + wv[tq].w * fmaxf(d[4 * tq + 3], 0.f);
        p += __shfl_xor(p, 32);
        sc[tq] = p;
    }
}

__device__ __forceinline__ void idx_tile2(const s16x8 (&afr)[4], const s16x8 (&b0)[4], const s16x8 (&b1)[4], const f4 (&wv)[4], float (&s0)[4], float (&s1)[4]) {
    f16v d0, d1;
#pragma unroll
    for (int i = 0; i < 16; ++i) { d0[i] = 0.f; d1[i] = 0.f; }
#pragma unroll
    for (int ks = 0; ks < 4; ++ks) { d0 = mfma32(afr[ks], b0[ks], d0); d1 = mfma32(afr[ks], b1[ks], d1); }
    float p0[4], p1[4];
#pragma unroll
    for (int tq = 0; tq < 4; ++tq) {
        p0[tq] = wv[tq].x * fmaxf(d0[4 * tq + 0], 0.f) + wv[tq].y * fmaxf(d0[4 * tq + 1], 0.f) + wv[tq].z * fmaxf(d0[4 * tq + 2], 0.f) + wv[tq].w * fmaxf(d0[4 * tq + 3], 0.f);
        p1[tq] = wv[tq].x * fmaxf(d1[4 * tq + 0], 0.f) + wv[tq].y * fmaxf(d1[4 * tq + 1], 0.f) + wv[tq].z * fmaxf(d1[4 * tq + 2], 0.f) + wv[tq].w * fmaxf(d1[4 * tq + 3], 0.f);
    }
    auto hsum = [](float a, float b) { const auto r = __builtin_amdgcn_permlane32_swap(__float_as_uint(a), __float_as_uint(b), false, false); return __uint_as_float(r[0]) + __uint_as_float(r[1]); };
    s0[0] = s0[2] = hsum(p0[0], p0[2]); s0[1] = s0[3] = hsum(p0[1], p0[3]);
    s1[0] = s1[2] = hsum(p1[0], p1[2]); s1[1] = s1[3] = hsum(p1[1], p1[3]);
}

__device__ __forceinline__ unsigned topk256_wave(const unsigned (&key)[32]) {
    unsigned prefix = 0u;
    for (int bit = 31; bit >= 0; --bit) {
        const unsigned cand = prefix | (1u << bit);
        int c0 = 0, c1 = 0;
#pragma unroll
        for (int i = 0; i < 32; i += 2) { c0 += (key[i] >= cand) ? 1 : 0; c1 += (key[i + 1] >= cand) ? 1 : 0; }
        int ps = c0 + c1;
#define TK_DPP_ADD(ctrl, rmask) ps += __builtin_amdgcn_update_dpp(0, ps, ctrl, rmask, 0xf, false)
        TK_DPP_ADD(0x111, 0xf); TK_DPP_ADD(0x112, 0xf); TK_DPP_ADD(0x114, 0xf); TK_DPP_ADD(0x118, 0xf); TK_DPP_ADD(0x142, 0xa); TK_DPP_ADD(0x143, 0xc);
#undef TK_DPP_ADD
        const int cnt = __builtin_amdgcn_readlane(ps, 63);
        if (cnt >= 256) prefix = cand;
        if (cnt == 256) {
            unsigned pe = cand; asm volatile("" : "+v"(pe)); pe = __builtin_amdgcn_readfirstlane(pe);
            unsigned w = 0u;
#pragma unroll
            for (int i = 0; i < 32; ++i) w |= (key[i] >= pe) ? (1u << i) : 0u;
            return w;
        }
    }
    unsigned p1 = prefix; asm volatile("" : "+v"(p1)); p1 = __builtin_amdgcn_readfirstlane(p1);
    int cgt = 0;
#pragma unroll
    for (int i = 0; i < 32; ++i) cgt += wave_count(key[i] > p1);
    unsigned p2 = prefix; asm volatile("" : "+v"(p2)); p2 = __builtin_amdgcn_readfirstlane(p2);
    unsigned lower = 0u;
#pragma unroll
    for (int i = 0; i < 32; ++i) lower += lower_count(key[i] == p2);
    const unsigned need = (unsigned)(256 - cgt);
    unsigned p3 = prefix; asm volatile("" : "+v"(p3)); p3 = __builtin_amdgcn_readfirstlane(p3);
    unsigned word = 0u, run = lower;
#pragma unroll
    for (int i = 0; i < 32; ++i) { bool sel = key[i] > p3; if (key[i] == p3) { sel = run < need; ++run; } word |= sel ? (1u << i) : 0u; }
    return word;
}


__device__ __forceinline__ float key2f(unsigned k) { return __uint_as_float((k & 0x80000000u) ? (k ^ 0x80000000u) : ~k); }
__device__ __forceinline__ unsigned topk256_bucket(LAS unsigned* wl, const unsigned (&key)[32], int lane) {
    unsigned kmin = 0xffffffffu, kmax = 0u;
#pragma unroll
    for (int i = 0; i < 32; ++i) { kmax = key[i] > kmax ? key[i] : kmax; const unsigned kk = key[i] ? key[i] : 0xffffffffu; kmin = kk < kmin ? kk : kmin; }
#pragma unroll
    for (int j = 0; j < 4; ++j) wl[4 * lane + j] = 0u;
    if (lane == 0) { wl[256] = 0xffffffffu; wl[257] = 0u; wl[258] = 0u; }
    wl[448 + lane] = 0u;
    asm volatile("s_waitcnt lgkmcnt(0)" ::: "memory");
    __hip_atomic_fetch_min(&wl[256], kmin, __ATOMIC_RELAXED, __HIP_MEMORY_SCOPE_WORKGROUP);
    __hip_atomic_fetch_max(&wl[257], kmax, __ATOMIC_RELAXED, __HIP_MEMORY_SCOPE_WORKGROUP);
    asm volatile("s_waitcnt lgkmcnt(0)" ::: "memory");
    const float lo = key2f(wl[256]), hi = key2f(wl[257]);
    const float scale = 255.99f / (hi - lo);
    unsigned bins[8];
#pragma unroll
    for (int i = 0; i < 32; ++i) {
        int bn = (int)((key2f(key[i]) - lo) * scale); bn = bn < 0 ? 0 : (bn > 255 ? 255 : bn);
        if (key[i]) __hip_atomic_fetch_add(&wl[bn], 1u, __ATOMIC_RELAXED, __HIP_MEMORY_SCOPE_WORKGROUP);
        if ((i & 3) == 0) bins[i >> 2] = 0u;
        bins[i >> 2] |= (unsigned)bn << (8 * (i & 3));
    }
    asm volatile("s_waitcnt lgkmcnt(0)" ::: "memory");
    const unsigned c0 = wl[4 * lane], c1 = wl[4 * lane + 1], c2 = wl[4 * lane + 2], c3 = wl[4 * lane + 3];
    int ps = (int)(c0 + c1 + c2 + c3);
#define TK_DPP_ADD(ctrl, rmask) ps += __builtin_amdgcn_update_dpp(0, ps, ctrl, rmask, 0xf, false)
    TK_DPP_ADD(0x111, 0xf); TK_DPP_ADD(0x112, 0xf); TK_DPP_ADD(0x114, 0xf); TK_DPP_ADD(0x118, 0xf); TK_DPP_ADD(0x142, 0xa); TK_DPP_ADD(0x143, 0xc);
#undef TK_DPP_ADD
    const int total = __builtin_amdgcn_readlane(ps, 63);
    const int ab3 = total - ps, ab2 = ab3 + (int)c3, ab1 = ab2 + (int)c2, ab0 = ab1 + (int)c1;
    int myb = -1, myab = 0;
    if (ab3 < 256 && ab3 + (int)c3 >= 256) { myb = 4 * lane + 3; myab = ab3; }
    if (ab2 < 256 && ab2 + (int)c2 >= 256) { myb = 4 * lane + 2; myab = ab2; }
    if (ab1 < 256 && ab1 + (int)c1 >= 256) { myb = 4 * lane + 1; myab = ab1; }
    if (ab0 < 256 && ab0 + (int)c0 >= 256) { myb = 4 * lane; myab = ab0; }
    const unsigned long long own = __builtin_amdgcn_ballot_w64(myb >= 0);
    const int src = (int)__builtin_ctzll(own);
    const int bb = __builtin_amdgcn_readlane(myb, src), above = __builtin_amdgcn_readlane(myab, src);
    const unsigned need = (unsigned)(256 - above);
    unsigned word = 0u;
#pragma unroll
    for (int i = 0; i < 32; ++i) {
        const int bn = (int)((bins[i >> 2] >> (8 * (i & 3))) & 255u);
        if (key[i] && bn > bb) word |= 1u << i;
        if (key[i] && bn == bb) { const unsigned pos = __hip_atomic_fetch_add(&wl[258], 1u, __ATOMIC_RELAXED, __HIP_MEMORY_SCOPE_WORKGROUP);
            if (pos < 64u) { wl[320 + 2 * pos] = key[i]; wl[321 + 2 * pos] = (unsigned)(32 * lane + i); } }
    }
    asm volatile("s_waitcnt lgkmcnt(0)" ::: "memory");
    const unsigned nc = wl[258];
    if (nc > 64u) return topk256_wave(key);
    {
        const unsigned myk = lane < (int)nc ? wl[320 + 2 * lane] : 0u, myi = lane < (int)nc ? wl[321 + 2 * lane] : 0u;
        unsigned rank = 0u;
        for (unsigned m = 0; m < nc; ++m) { const unsigned km = wl[320 + 2 * m], im = wl[321 + 2 * m]; rank += (km > myk || (km == myk && im < myi)) ? 1u : 0u; }
        if (lane < (int)nc && rank < need) __hip_atomic_fetch_or(&wl[448 + (myi >> 5)], 1u << (myi & 31u), __ATOMIC_RELAXED, __HIP_MEMORY_SCOPE_WORKGROUP);
    }
    asm volatile("s_waitcnt lgkmcnt(0)" ::: "memory");
    return word | wl[448 + lane];
}

constexpr int IX_P = 144, IX_BUF = 256 * IX_P;
__device__ __forceinline__ void idx_prompt_unit(LAS unsigned char* lds, int tid, const bf16* __restrict__ QI, const bf16* __restrict__ KIB, const float* __restrict__ MISCB, float* __restrict__ SC, unsigned* __restrict__ MASK,
                                                int b, int qblk) {
    const int lane = tid & 63, wave = __builtin_amdgcn_readfirstlane(tid >> 6), r = lane & 31, hi = lane >> 5;
    const int qrow0 = b * SEQ + 32 * qblk + 4 * wave;
    if (qblk < 8) {
#pragma unroll
        for (int tq = 0; tq < 4; ++tq) { const int t = 32 * qblk + 4 * wave + tq, rel = t - 32 * lane;
            const unsigned word = rel >= 31 ? 0xffffffffu : (rel < 0 ? 0u : ((2u << rel) - 1u));
            MASK[(size_t)(qrow0 + tq) * 64 + lane] = word; }
        return;
    }
#ifdef DBG_IDXMARK
    unsigned long long tm0_ = __builtin_amdgcn_s_memtime();
#endif
    s16x8 afr[4]; f4 wv[4];
#pragma unroll
    for (int ks = 0; ks < 4; ++ks) afr[ks] = *(const s16x8*)(QI + (size_t)qrow0 * 512 + r * 64 + 16 * ks + 8 * hi);
#pragma unroll
    for (int tq = 0; tq < 4; ++tq) wv[tq] = *(const f4*)(MISCB + (size_t)(qrow0 + tq) * 256 + 96 + 4 * hi);
    const int nkt = qblk + 1, nch = (nkt + 7) >> 3;
    const bf16* kg = KIB + (size_t)b * SEQ * 64 + (size_t)tid * 8;
    u4 st[4];
#pragma unroll
    for (int i = 0; i < 4; ++i) st[i] = *(const u4*)(kg + (size_t)i * 4096);
    for (int ch = 0; ch < nch; ++ch) {
        LAS unsigned char* buf = lds + (ch & 1) * IX_BUF;
#pragma unroll
        for (int i = 0; i < 4; ++i) { const int idx = i * 512 + tid; *(LAS u4*)(buf + (idx >> 3) * IX_P + 16 * (idx & 7)) = st[i]; }
        __syncthreads();
        if (ch + 1 < nch) {
#pragma unroll
            for (int i = 0; i < 4; ++i) st[i] = *(const u4*)(kg + (size_t)(ch + 1) * 16384 + (size_t)i * 4096);
        }
        const int ntile = (nkt - 8 * ch) < 8 ? (nkt - 8 * ch) : 8;
        for (int k8 = 0; k8 < ntile; k8 += 2) {
            const int k8b = k8 + 1 < ntile ? k8 + 1 : k8;
            s16x8 bfr[4], bfr2[4];
#pragma unroll
            for (int ks = 0; ks < 4; ++ks) { bfr[ks] = *(const LAS s16x8*)(buf + (32 * k8 + r) * IX_P + 32 * ks + 16 * hi); bfr2[ks] = *(const LAS s16x8*)(buf + (32 * k8b + r) * IX_P + 32 * ks + 16 * hi); }
            float sc[4], sc2[4]; idx_tile2(afr, bfr, bfr2, wv, sc, sc2);
            const int kt = 8 * ch + k8, kt2 = 8 * ch + k8b;
            SC[(size_t)(qrow0 + 2 * hi) * 2048 + 32 * kt + r] = hi ? sc[2] : sc[0];
            SC[(size_t)(qrow0 + 2 * hi + 1) * 2048 + 32 * kt + r] = hi ? sc[3] : sc[1];
            SC[(size_t)(qrow0 + 2 * hi) * 2048 + 32 * kt2 + r] = hi ? sc2[2] : sc2[0];
            SC[(size_t)(qrow0 + 2 * hi + 1) * 2048 + 32 * kt2 + r] = hi ? sc2[3] : sc2[1];
        }
    }
    asm volatile("s_waitcnt vmcnt(0)" ::: "memory");
#ifdef DBG_IDXMARK
    unsigned long long tm1_ = __builtin_amdgcn_s_memtime();
#endif
    for (int tq = 0; tq < 4; ++tq) {
        const int t = 32 * qblk + 4 * wave + tq;
        unsigned key[32];
        const float* srow = SC + (size_t)(qrow0 + tq) * 2048 + 32 * lane;
        if (32 * lane <= t) {
#pragma unroll
            for (int i4 = 0; i4 < 8; ++i4) { const f4 v = *(const f4*)(srow + 4 * i4);
                key[4 * i4 + 0] = (32 * lane + 4 * i4 + 0 <= t) ? f2key(v.x) : 0u; key[4 * i4 + 1] = (32 * lane + 4 * i4 + 1 <= t) ? f2key(v.y) : 0u;
                key[4 * i4 + 2] = (32 * lane + 4 * i4 + 2 <= t) ? f2key(v.z) : 0u; key[4 * i4 + 3] = (32 * lane + 4 * i4 + 3 <= t) ? f2key(v.w) : 0u; }
        } else {
#pragma unroll
            for (int i = 0; i < 32; ++i) key[i] = 0u;
        }
        const unsigned word = topk256_wave(key);
        MASK[(size_t)(qrow0 + tq) * 64 + lane] = word;
    }
#ifdef DBG_IDXMARK
    if (tid == 0) { const unsigned long long tm2_ = __builtin_amdgcn_s_memtime(); atomicAdd(DBG_IDXMARK + 16, (unsigned)((tm1_ - tm0_) >> 4)); atomicAdd(DBG_IDXMARK + 17, (unsigned)((tm2_ - tm1_) >> 4)); atomicAdd(DBG_IDXMARK + 18, 0u); atomicAdd(DBG_IDXMARK + 19, 0u); }
#endif
    __syncthreads();
}

__device__ __forceinline__ void idx_sample_unit(int tid, const bf16* __restrict__ QI, const float* __restrict__ MISCB, const float* __restrict__ ckidx, const int* __restrict__ ptab,
                                                float* __restrict__ SCS, int b, int range) {
    const int lane = tid & 63, wave = __builtin_amdgcn_readfirstlane(tid >> 6), r = lane & 31, hi = lane >> 5;
    const int qrow0 = MP + 4 * b;
    s16x8 afr[4]; f4 wv[4];
#pragma unroll
    for (int ks = 0; ks < 4; ++ks) afr[ks] = *(const s16x8*)(QI + (size_t)qrow0 * 512 + r * 64 + 16 * ks + 8 * hi);
#pragma unroll
    for (int tq = 0; tq < 4; ++tq) wv[tq] = *(const f4*)(MISCB + (size_t)(qrow0 + tq) * 256 + 96 + 4 * hi);
    int pg[8];
#pragma unroll
    for (int k = 0; k < 8; ++k) pg[k] = ptab[b * NPAGE + ((range * 2048 + 32 * (wave * 8 + k)) >> 7)];
    f4 va[8], vb[8];
    auto ld2 = [&](int k8) {
        const int sA = range * 2048 + 32 * (wave * 8 + k8) + r, sB = sA + 32;
        const float* srcA = ckidx + ((size_t)pg[k8] * PAGE + (sA & 127)) * 64 + 8 * hi; const float* srcB = ckidx + ((size_t)pg[k8 + 1] * PAGE + (sB & 127)) * 64 + 8 * hi;
#pragma unroll
        for (int ks = 0; ks < 4; ++ks) { va[2 * ks] = *(const f4*)(srcA + 16 * ks); va[2 * ks + 1] = *(const f4*)(srcA + 16 * ks + 4); vb[2 * ks] = *(const f4*)(srcB + 16 * ks); vb[2 * ks + 1] = *(const f4*)(srcB + 16 * ks + 4); }
    };
    ld2(0);
#pragma unroll
    for (int k8 = 0; k8 < 8; k8 += 2) {
        const int sA = range * 2048 + 32 * (wave * 8 + k8) + r, sB = sA + 32;
        s16x8 bfa[4], bfb[4];
#pragma unroll
        for (int ks = 0; ks < 4; ++ks) { u4 w; w.x = pk2(va[2 * ks].x, va[2 * ks].y); w.y = pk2(va[2 * ks].z, va[2 * ks].w); w.z = pk2(va[2 * ks + 1].x, va[2 * ks + 1].y); w.w = pk2(va[2 * ks + 1].z, va[2 * ks + 1].w); bfa[ks] = __builtin_bit_cast(s16x8, w);
            u4 x; x.x = pk2(vb[2 * ks].x, vb[2 * ks].y); x.y = pk2(vb[2 * ks].z, vb[2 * ks].w); x.z = pk2(vb[2 * ks + 1].x, vb[2 * ks + 1].y); x.w = pk2(vb[2 * ks + 1].z, vb[2 * ks + 1].w); bfb[ks] = __builtin_bit_cast(s16x8, x); }
        if (k8 + 2 < 8) ld2(k8 + 2);
        float sc[4], sc2[4]; idx_tile2(afr, bfa, bfb, wv, sc, sc2);
        SCS[(size_t)(4 * b + 2 * hi) * 16640 + sA] = hi ? sc[2] : sc[0];
        SCS[(size_t)(4 * b + 2 * hi + 1) * 16640 + sA] = hi ? sc[3] : sc[1];
        SCS[(size_t)(4 * b + 2 * hi) * 16640 + sB] = hi ? sc2[2] : sc2[0];
        SCS[(size_t)(4 * b + 2 * hi + 1) * 16640 + sB] = hi ? sc2[3] : sc2[1];
    }
}

constexpr int AT_KP = 144;
constexpr int AT_K = 0, AT_V = 2 * 64 * AT_KP, AT_M = 4 * 64 * AT_KP, AT_END = AT_M + 64 * 65 * 4;
__device__ __forceinline__ int crow(int reg, int hi) { return (reg & 3) + 8 * (reg >> 2) + 4 * hi; }
constexpr int A2_KP = 144, A2_VP = 272, A2_KB = 128 * A2_KP, A2_VB = 64 * A2_VP, A2_BUF = A2_KB + A2_VB, A2_M = 3 * A2_BUF, A2_END = A2_M + 64 * 65 * 4;
static_assert(A2_END <= 131072, "attention LDS");
typedef unsigned short us2v __attribute__((ext_vector_type(2)));
__device__ __forceinline__ unsigned pkclamp(unsigned w) { return __builtin_bit_cast(unsigned, __builtin_elementwise_min(__builtin_bit_cast(us2v, w), (us2v){(unsigned short)0x5F80, (unsigned short)0x5F80})); }
__device__ __forceinline__ void attn_prompt_unit(LAS unsigned char* lds, int tid, const bf16* __restrict__ Q, const bf16* __restrict__ KB, const bf16* __restrict__ VT, const unsigned* __restrict__ MASK,
                                                 bf16* __restrict__ YA, int b, int kvh, int qb) {
    const int lane = tid & 63, wave = __builtin_amdgcn_readfirstlane(tid >> 6), r = lane & 31, hi = lane >> 5;
    const int qrow = b * SEQ + 64 * qb + 8 * wave + (r >> 2), head = 4 * kvh + (r & 3);
    s16x8 qf[4];
#pragma unroll
    for (int ks = 0; ks < 4; ++ks) {
        const u4 qv = *(const u4*)(Q + (size_t)qrow * 1024 + head * 64 + 16 * ks + 8 * hi); const float cq = 0.125f * 1.4426950408889634f; u4 qs;
        qs.x = pk2(__uint_as_float(qv.x << 16) * cq, __uint_as_float(qv.x & 0xffff0000u) * cq); qs.y = pk2(__uint_as_float(qv.y << 16) * cq, __uint_as_float(qv.y & 0xffff0000u) * cq);
        qs.z = pk2(__uint_as_float(qv.z << 16) * cq, __uint_as_float(qv.z & 0xffff0000u) * cq); qs.w = pk2(__uint_as_float(qv.w << 16) * cq, __uint_as_float(qv.w & 0xffff0000u) * cq);
        qf[ks] = __builtin_bit_cast(s16x8, qs); }
    const int nst = (qb + 2) >> 1;
    const int srow = tid >> 3, sch = tid & 7;
    const bf16* kg = KB + (size_t)(b * SEQ + srow) * 256 + kvh * 64 + 8 * sch;
    const bf16* vg = VT + (size_t)(b * 256 + kvh * 64 + srow) * SEQ + 8 * sch;
    u4 kreg0 = *(const u4*)kg, kreg1 = *(const u4*)(kg + (size_t)64 * 256), vreg0 = *(const u4*)vg, vreg1 = *(const u4*)(vg + 64);
    {
        LAS unsigned* ml = (LAS unsigned*)(lds + A2_M);
        const unsigned* mg = MASK + (size_t)(b * SEQ + 64 * qb) * 64;
#pragma unroll
        for (int i = 0; i < 8; ++i) { const int idx = i * 512 + tid; ml[(idx >> 6) * 65 + (idx & 63)] = mg[idx]; }
    }
    const LAS unsigned* mrow = (const LAS unsigned*)(lds + A2_M) + (8 * wave + (r >> 2)) * 65;
    f16v o0, o1, o2;
#pragma unroll
    for (int i = 0; i < 16; ++i) { o0[i] = 0.f; o1[i] = 0.f; o2[i] = 0.f; }
    const short one_b = (r == 0) ? (short)0x3F80 : (short)0;
    const s16x8 onesf = (s16x8){one_b, one_b, one_b, one_b, one_b, one_b, one_b, one_b};
    const bool late = wave >= 4;
    s16x8 pf[4][2];
#pragma unroll
    for (int rt = 0; rt < 4; ++rt) { pf[rt][0] = (s16x8){0, 0, 0, 0, 0, 0, 0, 0}; pf[rt][1] = pf[rt][0]; }
    auto pv = [&](const LAS unsigned char* vl) {
#pragma unroll
        for (int rt = 0; rt < 4; ++rt)
#pragma unroll
            for (int s = 0; s < 2; ++s) {
                const int kb = (32 * rt + 16 * s + 4 * hi) * 2;
                const u2 a0 = *(const LAS u2*)(vl + r * A2_VP + kb), a1 = *(const LAS u2*)(vl + r * A2_VP + kb + 16);
                const u2 b0 = *(const LAS u2*)(vl + (32 + r) * A2_VP + kb), b1 = *(const LAS u2*)(vl + (32 + r) * A2_VP + kb + 16);
                u4 fa; fa.x = a0.x; fa.y = a0.y; fa.z = a1.x; fa.w = a1.y; u4 fb; fb.x = b0.x; fb.y = b0.y; fb.z = b1.x; fb.w = b1.y;
                o0 = mfma32(__builtin_bit_cast(s16x8, fa), pf[rt][s], o0);
                o1 = mfma32(__builtin_bit_cast(s16x8, fb), pf[rt][s], o1);
                o2 = mfma32(onesf, pf[rt][s], o2);
            }
    };
    int bi = 0, pbi = 0;
    for (int st = 0; st <= nst; ++st) {
        LAS unsigned char* kl = lds + bi * A2_BUF; LAS unsigned char* vl = kl + A2_KB;
        if (st < nst) {
            *(LAS u4*)(kl + srow * A2_KP + 16 * sch) = kreg0; *(LAS u4*)(kl + (64 + srow) * A2_KP + 16 * sch) = kreg1;
            *(LAS u4*)(vl + srow * A2_VP + 16 * sch) = vreg0; *(LAS u4*)(vl + srow * A2_VP + 128 + 16 * sch) = vreg1;
        }
        __syncthreads();
        { const int sn = st + 1 < nst ? st + 1 : nst - 1;
          kreg0 = *(const u4*)(kg + (size_t)sn * 128 * 256); kreg1 = *(const u4*)(kg + (size_t)(sn * 128 + 64) * 256); vreg0 = *(const u4*)(vg + sn * 128); vreg1 = *(const u4*)(vg + sn * 128 + 64); }
        if (late && st > 0) pv(lds + pbi * A2_BUF + A2_KB);
        if (st < nst) {
            f16v sc[4];
#pragma unroll
            for (int rt = 0; rt < 4; ++rt) {
#pragma unroll
                for (int i = 0; i < 16; ++i) sc[rt][i] = 0.f;
#pragma unroll
                for (int ks = 0; ks < 4; ++ks) sc[rt] = mfma32(*(const LAS s16x8*)(kl + (32 * rt + r) * A2_KP + 32 * ks + 16 * hi), qf[ks], sc[rt]);
            }
#pragma unroll
            for (int rt = 0; rt < 4; ++rt) { const unsigned mw = mrow[4 * st + rt];
#pragma unroll
                for (int i = 0; i < 16; ++i) { sc[rt][i] = __uint_as_float(__float_as_uint(__builtin_amdgcn_exp2f(sc[rt][i])) & (unsigned)__builtin_amdgcn_sbfe((int)mw, crow(i, hi), 1)); }
#pragma unroll
                for (int s = 0; s < 2; ++s) { u4 w; w.x = pkclamp(pk2(sc[rt][8 * s + 0], sc[rt][8 * s + 1])); w.y = pkclamp(pk2(sc[rt][8 * s + 2], sc[rt][8 * s + 3])); w.z = pkclamp(pk2(sc[rt][8 * s + 4], sc[rt][8 * s + 5]));
                    w.w = pkclamp(pk2(sc[rt][8 * s + 6], sc[rt][8 * s + 7]));
                    pf[rt][s] = __builtin_bit_cast(s16x8, w); }
            }
            if (!late) pv(vl);
        }
        pbi = bi; bi = bi == 2 ? 0 : bi + 1;
    }
    const float lsum = o2[0] + __shfl_xor(o2[0], 32);
    const float inv = 1.0f / lsum;
    bf16* yo = YA + (size_t)qrow * YCP + head * 64;
#pragma unroll
    for (int k = 0; k < 2; ++k) {
        u2 a, c, e, f;
        a.x = pk2(o0[8 * k + 0] * inv, o0[8 * k + 1] * inv); a.y = pk2(o0[8 * k + 2] * inv, o0[8 * k + 3] * inv);
        c.x = pk2(o0[8 * k + 4] * inv, o0[8 * k + 5] * inv); c.y = pk2(o0[8 * k + 6] * inv, o0[8 * k + 7] * inv);
        e.x = pk2(o1[8 * k + 0] * inv, o1[8 * k + 1] * inv); e.y = pk2(o1[8 * k + 2] * inv, o1[8 * k + 3] * inv);
        f.x = pk2(o1[8 * k + 4] * inv, o1[8 * k + 5] * inv); f.y = pk2(o1[8 * k + 6] * inv, o1[8 * k + 7] * inv);
        { auto r0 = __builtin_amdgcn_permlane32_swap(a.x, c.x, false, false); a.x = r0[0]; c.x = r0[1]; auto r1 = __builtin_amdgcn_permlane32_swap(a.y, c.y, false, false); a.y = r1[0]; c.y = r1[1]; }
        { auto r0 = __builtin_amdgcn_permlane32_swap(e.x, f.x, false, false); e.x = r0[0]; f.x = r0[1]; auto r1 = __builtin_amdgcn_permlane32_swap(e.y, f.y, false, false); e.y = r1[0]; f.y = r1[1]; }
        u4 w0; w0.x = a.x; w0.y = a.y; w0.z = c.x; w0.w = c.y;
        u4 w1; w1.x = e.x; w1.y = e.y; w1.z = f.x; w1.w = f.y;
        *(u4*)(yo + 16 * k + 8 * hi) = w0;
        *(u4*)(yo + 32 + 16 * k + 8 * hi) = w1;
    }
    __syncthreads();
}

constexpr int SM_Q = 0  , SM_QI = 4096  , SM_WI = 6144  , SM_TMP = 6208  , SM_SCN = 6336  , SM_CNT = 6400  ,
              SM_WOFF = 6528  , SM_SEL = 6656  , SM_S = 8192  , SM_END = 8192 + 16384;
__device__ __forceinline__ void sample_query_unit(LAS unsigned char* lds, int tid, const bf16* __restrict__ Q, const bf16* __restrict__ QI, const float* __restrict__ MISCB, const float* __restrict__ SCS,
                                                  const float* __restrict__ ck, const float* __restrict__ cv, const int* __restrict__ ptab, const float* __restrict__ out, bf16* __restrict__ YA, int b, int tq) {
    const int lane = tid & 63, wave = __builtin_amdgcn_readfirstlane(tid >> 6);
    const int qrow = MP + 4 * b + tq;
    LAS float* q_l = (LAS float*)(lds + SM_Q); LAS float* qi_l = (LAS float*)(lds + SM_QI); LAS float* wi_l = (LAS float*)(lds + SM_WI); LAS float* tmp_l = (LAS float*)(lds + SM_TMP);
    LAS float* scn_l = (LAS float*)(lds + SM_SCN); LAS unsigned* cnt_l = (LAS unsigned*)(lds + SM_CNT); LAS unsigned* woff_l = (LAS unsigned*)(lds + SM_WOFF);
    LAS int* sel_l = (LAS int*)(lds + SM_SEL); LAS float* s_l = (LAS float*)(lds + SM_S);
    { const unsigned w = *(const unsigned*)(Q + (size_t)qrow * 1024 + 2 * tid); q_l[2 * tid] = __uint_as_float(w << 16); q_l[2 * tid + 1] = __uint_as_float(w & 0xffff0000u); }
    { const unsigned short w = QI[(size_t)qrow * 512 + tid]; qi_l[tid] = __uint_as_float((unsigned)w << 16); }
    if (tid < 8) wi_l[tid] = MISCB[(size_t)qrow * 256 + 96 + tid];
    __syncthreads();
    if (tid < 32) {
        const int h = tid >> 2, kk = tid & 3; const float* kin = MISCB + (size_t)(MP + 4 * b + kk) * 256 + 32; float d = 0.f;
        f4 kr[16];
#pragma unroll
        for (int e4 = 0; e4 < 16; ++e4) kr[e4] = *(const f4*)(kin + 4 * e4);
#pragma unroll
        for (int e4 = 0; e4 < 16; ++e4) d += qi_l[h * 64 + 4 * e4] * kr[e4].x + qi_l[h * 64 + 4 * e4 + 1] * kr[e4].y + qi_l[h * 64 + 4 * e4 + 2] * kr[e4].z + qi_l[h * 64 + 4 * e4 + 3] * kr[e4].w;
        tmp_l[tid] = wi_l[h] * fmaxf(d, 0.f);
    }
    __syncthreads();
    if (tid < 4) { float s = 0.f; for (int h = 0; h < 8; ++h) s += tmp_l[h * 4 + tid]; scn_l[tid] = s; }
    __syncthreads();
    unsigned key[36];
    { const float* srow = SCS + (size_t)(4 * b + tq) * 16640 + 32 * tid;
#pragma unroll
      for (int i4 = 0; i4 < 8; ++i4) { const f4 v = *(const f4*)(srow + 4 * i4); key[4 * i4] = f2key(v.x); key[4 * i4 + 1] = f2key(v.y); key[4 * i4 + 2] = f2key(v.z); key[4 * i4 + 3] = f2key(v.w); }
#pragma unroll
      for (int e = 0; e < 4; ++e) key[32 + e] = (tid == 511 && e <= tq) ? f2key(scn_l[e]) : 0u; }
    unsigned prefix = 0u; int par = 0;
    for (int bit = 31; bit >= 1; bit -= 2) {
        const unsigned cA = prefix | (1u << (bit - 1)), cB = prefix | (1u << bit), cC = cB | (1u << (bit - 1));
        int nA = 0, nB = 0, nC = 0;
#pragma unroll
        for (int i = 0; i < 36; ++i) { nA += (key[i] >= cA) ? 1 : 0; nB += (key[i] >= cB) ? 1 : 0; nC += (key[i] >= cC) ? 1 : 0; }
#define SQ_DPP_ADD(v, ctrl, rmask) v += __builtin_amdgcn_update_dpp(0, v, ctrl, rmask, 0xf, false)
#define SQ_WAVE_SUM(v) SQ_DPP_ADD(v, 0x111, 0xf); SQ_DPP_ADD(v, 0x112, 0xf); SQ_DPP_ADD(v, 0x114, 0xf); SQ_DPP_ADD(v, 0x118, 0xf); SQ_DPP_ADD(v, 0x142, 0xa); SQ_DPP_ADD(v, 0x143, 0xc)
        SQ_WAVE_SUM(nA); SQ_WAVE_SUM(nB); SQ_WAVE_SUM(nC);
#undef SQ_WAVE_SUM
#undef SQ_DPP_ADD
        if (lane == 63) { cnt_l[par * 16 + wave] = (unsigned)nA | ((unsigned)nB << 16); cnt_l[par * 16 + 8 + wave] = (unsigned)nC; }
        __syncthreads();
        unsigned tx = 0u, ty = 0u;
#pragma unroll
        for (int w = 0; w < 8; ++w) { tx += cnt_l[par * 16 + w]; ty += cnt_l[par * 16 + 8 + w]; }
        if (ty >= 256u) prefix = cC; else if ((tx >> 16) >= 256u) prefix = cB; else if ((tx & 0xffffu) >= 256u) prefix = cA;
        par ^= 1;
    }
    int cgt = 0, ceq = 0;
#pragma unroll
    for (int i = 0; i < 36; ++i) { cgt += (key[i] > prefix) ? 1 : 0; ceq += (key[i] == prefix) ? 1 : 0; }
    int sgt = cgt, seq = ceq;
#pragma unroll
    for (int o = 1; o < 64; o <<= 1) { const int v0 = __shfl_up(sgt, o), v1 = __shfl_up(seq, o); if (lane >= o) { sgt += v0; seq += v1; } }
    __syncthreads();
    if (lane == 63) { cnt_l[wave] = (unsigned)sgt; cnt_l[8 + wave] = (unsigned)seq; }
    __syncthreads();
    unsigned tot_gt = 0u, eq_before = 0u;
#pragma unroll
    for (int w = 0; w < 8; ++w) { tot_gt += cnt_l[w]; if (w < wave) eq_before += cnt_l[8 + w]; }
    const unsigned need = 256u - tot_gt;
    unsigned long long selw = 0ull; unsigned run = eq_before + (unsigned)(seq - ceq);
    int csel = 0;
    asm volatile("" : "+v"(prefix));
#pragma unroll
    for (int i = 0; i < 36; ++i) { bool sel = key[i] > prefix; if (key[i] == prefix) { sel = run < need; ++run; } selw |= sel ? (1ull << i) : 0ull; csel += sel ? 1 : 0; }
    int ssel = csel;
#pragma unroll
    for (int o = 1; o < 64; o <<= 1) { const int v0 = __shfl_up(ssel, o); if (lane >= o) ssel += v0; }
    if (lane == 63) woff_l[wave] = (unsigned)ssel;
    __syncthreads();
    unsigned pos = (unsigned)(ssel - csel);
#pragma unroll
    for (int w = 0; w < 8; ++w) if (w < wave) pos += woff_l[w];
    const int pgbase = ptab[b * NPAGE + ((32 * tid) >> 7)] * PAGE;
#pragma unroll
    for (int i = 0; i < 36; ++i) if ((selw >> i) & 1ull) {
        const int s = (i < 32) ? 32 * tid + i : PAST + (i - 32);
        const int idx = (s < PAST) ? pgbase + (s & 127) : -1 - (s - PAST);
        if (pos < 256u) sel_l[pos] = idx;
        ++pos; }
    __syncthreads();
    {
        const int kvh = lane >> 4, dq = lane & 15;
        f4 qr[4];
#pragma unroll
        for (int hq = 0; hq < 4; ++hq) qr[hq] = *(const LAS f4*)(q_l + (4 * kvh + hq) * 64 + 4 * dq);
        f4 kr2[32];
#pragma unroll
        for (int j = 0; j < 32; ++j) { const int idx = sel_l[32 * wave + j];
            const float* krow = idx >= 0 ? ck + (size_t)idx * 256 : out + O_KS + (size_t)(4 * b + (-1 - idx)) * 256;
            kr2[j] = *(const f4*)(krow + 4 * lane); }
#pragma unroll
        for (int j = 0; j < 32; ++j)
#pragma unroll
            for (int hq = 0; hq < 4; ++hq) {
                float d = (kr2[j].x * qr[hq].x + kr2[j].y * qr[hq].y) + (kr2[j].z * qr[hq].z + kr2[j].w * qr[hq].w);
#define SQ_DPP_FADD(ctrl) d += __builtin_bit_cast(float, __builtin_amdgcn_update_dpp(0, __builtin_bit_cast(int, d), ctrl, 0xf, 0xf, false))
                SQ_DPP_FADD(0x111); SQ_DPP_FADD(0x112); SQ_DPP_FADD(0x114); SQ_DPP_FADD(0x118);
#undef SQ_DPP_FADD
                if (dq == 15) s_l[(4 * kvh + hq) * 256 + 32 * wave + j] = d * 0.125f;
            }
    }
    __syncthreads();
#pragma unroll
    for (int k2 = 0; k2 < 2; ++k2) {
        LAS float* sr = s_l + (2 * wave + k2) * 256;
        float v0 = sr[lane], v1 = sr[lane + 64], v2 = sr[lane + 128], v3 = sr[lane + 192];
        float mx = fmaxf(fmaxf(v0, v1), fmaxf(v2, v3));
#pragma unroll
        for (int o = 1; o < 64; o <<= 1) mx = fmaxf(mx, __shfl_xor(mx, o));
        v0 = __expf(v0 - mx); v1 = __expf(v1 - mx); v2 = __expf(v2 - mx); v3 = __expf(v3 - mx);
        const float inv = 1.0f / wave_sum((v0 + v1) + (v2 + v3));
        sr[lane] = v0 * inv; sr[lane + 64] = v1 * inv; sr[lane + 128] = v2 * inv; sr[lane + 192] = v3 * inv;
    }
    __syncthreads();
    {
        const int kvh = lane >> 4, dq = lane & 15;
        f4 vv[32];
#pragma unroll
        for (int j = 0; j < 32; ++j) { const int idx = sel_l[32 * wave + j];
            const float* vrow = idx >= 0 ? cv + (size_t)idx * 256 : out + O_VS + (size_t)(4 * b + (-1 - idx)) * 256;
            vv[j] = *(const f4*)(vrow + 4 * lane); }
        f4 acc[4] = {(f4){0.f, 0.f, 0.f, 0.f}, (f4){0.f, 0.f, 0.f, 0.f}, (f4){0.f, 0.f, 0.f, 0.f}, (f4){0.f, 0.f, 0.f, 0.f}};
#pragma unroll
        for (int j4 = 0; j4 < 8; ++j4)
#pragma unroll
            for (int hq = 0; hq < 4; ++hq) { const f4 p = *(const LAS f4*)(s_l + (4 * kvh + hq) * 256 + 32 * wave + 4 * j4);
                acc[hq] += p.x * vv[4 * j4] + p.y * vv[4 * j4 + 1] + p.z * vv[4 * j4 + 2] + p.w * vv[4 * j4 + 3]; }
        LAS float* red = (LAS float*)(lds + SM_END);
#pragma unroll
        for (int hq = 0; hq < 4; ++hq) *(LAS f4*)(red + ((wave * 16 + 4 * kvh + hq) * 64 + 4 * dq)) = acc[hq];
        __syncthreads();
        const int head = tid >> 5, d = 2 * (tid & 31); float a0 = 0.f, a1 = 0.f;
#pragma unroll
        for (int w = 0; w < 8; ++w) { const float* rp = nullptr; (void)rp; const LAS float* q2 = red + ((w * 16 + head) * 64 + d); a0 += q2[0]; a1 += q2[1]; }
        *(unsigned*)(YA + (size_t)qrow * YCP + head * 64 + d) = pk2(a0, a1);
    }
    __syncthreads();
}
}

namespace pg8 {
__device__ __forceinline__ float ep_silu(float x) { return x * __builtin_amdgcn_rcpf(1.0f + __expf(-x)); }
__device__ __forceinline__ float ep_sigm(float x) { return __builtin_amdgcn_rcpf(1.0f + __expf(-x)); }
struct EpiGU {
    static constexpr bool PERM = true, AFTER_DRAIN = false; static constexpr int HOOK_T = 0; static constexpr bool GROUPS = false;
    bf16_t* O;
    __device__ __forceinline__ void operator()(const f32x4 (&acc)[2][2][4][2], const Unit& u, int wr, int wc, int fr, int fq) const {
        const int row0 = u.pm * BM + wr * 64 + fr, col0 = u.pn * 128 + wc * 32 + 8 * fq;
#pragma unroll
        for (int ai = 0; ai < 2; ++ai)
#pragma unroll
            for (int m = 0; m < 4; ++m) {
                bf16_t* rowp = O + (size_t)(row0 + ai * HALF + m * 16) * 2816 + col0;
                const f32x4 g0 = acc[ai][0][m][0], g1 = acc[ai][0][m][1], u0 = acc[ai][1][m][0], u1 = acc[ai][1][m][1];
                u32x4 w;
                w.x = cvt_pk_bf16(ep_silu(g0[0]) * u0[0], ep_silu(g0[1]) * u0[1]); w.y = cvt_pk_bf16(ep_silu(g0[2]) * u0[2], ep_silu(g0[3]) * u0[3]);
                w.z = cvt_pk_bf16(ep_silu(g1[0]) * u1[0], ep_silu(g1[1]) * u1[1]); w.w = cvt_pk_bf16(ep_silu(g1[2]) * u1[2], ep_silu(g1[3]) * u1[3]);
                *(u32x4*)rowp = w;
            }
    }
};
struct EpiF32 {
    static constexpr bool PERM = false, AFTER_DRAIN = false; static constexpr int HOOK_T = 0; static constexpr bool GROUPS = false;
    float* O; int ldc;
    __device__ __forceinline__ void operator()(const f32x4 (&acc)[2][2][4][2], const Unit& u, int wr, int wc, int fr, int fq) const {
        const int row0 = u.pm * BM + wr * 64 + fr, col0 = u.pn * BM + wc * 32 + 4 * fq;
#pragma unroll
        for (int ai = 0; ai < 2; ++ai)
#pragma unroll
            for (int m = 0; m < 4; ++m) { float* rowp = O + (size_t)(row0 + ai * HALF + m * 16) * ldc + col0;
#pragma unroll
                for (int bj = 0; bj < 2; ++bj)
#pragma unroll
                    for (int n = 0; n < 2; ++n) *(f32x4*)(rowp + bj * HALF + n * 16) = acc[ai][bj][m][n]; }
    }
};
struct EpiB16 {
    static constexpr bool PERM = true, AFTER_DRAIN = false; static constexpr int HOOK_T = 0; static constexpr bool GROUPS = false;
    bf16_t* O; int ldc;
    __device__ __forceinline__ void operator()(const f32x4 (&acc)[2][2][4][2], const Unit& u, int wr, int wc, int fr, int fq) const {
        const int row0 = u.pm * BM + wr * 64 + fr, col0 = u.pn * BM + wc * 32 + 8 * fq;
#pragma unroll
        for (int ai = 0; ai < 2; ++ai)
#pragma unroll
            for (int m = 0; m < 4; ++m) { bf16_t* rowp = O + (size_t)(row0 + ai * HALF + m * 16) * ldc + col0;
#pragma unroll
                for (int bj = 0; bj < 2; ++bj) { const f32x4 v0 = acc[ai][bj][m][0], v1 = acc[ai][bj][m][1]; u32x4 w;
                    w.x = cvt_pk_bf16(v0[0], v0[1]); w.y = cvt_pk_bf16(v0[2], v0[3]); w.z = cvt_pk_bf16(v1[0], v1[1]); w.w = cvt_pk_bf16(v1[2], v1[3]);
                    *(u32x4*)(rowp + bj * HALF) = w; } }
    }
};
struct EpiMemKV {
    static constexpr bool PERM = false, AFTER_DRAIN = false; static constexpr int HOOK_T = 0; static constexpr bool GROUPS = false;
    float* outk; float* outv; bf16_t* mkb;
    __device__ __forceinline__ void operator()(const f32x4 (&acc)[2][2][4][2], const Unit& u, int wr, int wc, int fr, int fq) const {
        const bool isv = u.pn >= 4; float* O = isv ? outv : outk;
        const int row0 = u.pm * BM + wr * 64 + fr, col0 = (u.pn & 3) * BM + wc * 32 + 4 * fq;
#pragma unroll
        for (int ai = 0; ai < 2; ++ai)
#pragma unroll
            for (int m = 0; m < 4; ++m) { const size_t off = (size_t)(row0 + ai * HALF + m * 16) * 1024 + col0;
#pragma unroll
                for (int bj = 0; bj < 2; ++bj)
#pragma unroll
                    for (int n = 0; n < 2; ++n) { const f32x4 v = acc[ai][bj][m][n]; *(f32x4*)(O + off + bj * HALF + n * 16) = v;
                        if (!isv) { typedef unsigned u32x2v __attribute__((ext_vector_type(2))); u32x2v w; w.x = cvt_pk_bf16(v[0], v[1]); w.y = cvt_pk_bf16(v[2], v[3]);
                            *(u32x2v*)(mkb + off + bj * HALF + n * 16) = w; } } }
    }
};
struct EpiWin {
    static constexpr bool PERM = true, AFTER_DRAIN = false; static constexpr int HOOK_T = 0; static constexpr bool GROUPS = false;
    bf16_t *Z, *XBC, *Q, *KB, *QI, *GS, *GA, *KIB; float* MISC; float* out;
    __device__ __forceinline__ void operator()(const f32x4 (&acc)[2][2][4][2], const Unit& u, int wr, int wc, int fr, int fq) const {
        const int pn = u.pn, row0 = u.pm * BM + wr * 64 + fr, cl = wc * 32 + 8 * fq;
        bf16_t* base = nullptr; int ld = 0, colt = 0, kind = 0;
        if (pn < 8) { base = Z; ld = 2048; colt = pn * 256; }
        else if (pn < 24) { base = XBC; ld = 4096; colt = (pn - 8) * 256; kind = 1; }
        else if (pn < 28) { base = Q; ld = 1024; colt = (pn - 24) * 256; }
        else if (pn == 28) { base = KB; ld = 256; colt = 0; kind = 2; }
        else if (pn == 29) { kind = 3; }
        else if (pn < 32) { base = QI; ld = 512; colt = (pn - 30) * 256; }
        else if (pn < 36) { base = GS; ld = 1024; colt = (pn - 32) * 256; }
        else if (pn < 40) { base = GA; ld = 1024; colt = (pn - 36) * 256; }
        else kind = 4;
#pragma unroll
        for (int ai = 0; ai < 2; ++ai)
#pragma unroll
            for (int m = 0; m < 4; ++m) {
                const int row = row0 + ai * HALF + m * 16;
#pragma unroll
                for (int bj = 0; bj < 2; ++bj) {
                    const int c = colt + bj * HALF + cl;
                    const f32x4 v0 = acc[ai][bj][m][0], v1 = acc[ai][bj][m][1];
                    u32x4 w; w.x = cvt_pk_bf16(v0[0], v0[1]); w.y = cvt_pk_bf16(v0[2], v0[3]); w.z = cvt_pk_bf16(v1[0], v1[1]); w.w = cvt_pk_bf16(v1[2], v1[3]);
                    if (base) *(u32x4*)(base + (size_t)row * ld + c) = w;
                    if (kind == 1) {
                        float* o = nullptr;
                        if (row < 16384) { const int tt = row & 2047; if (tt >= 2045) o = out + 28442624 + (size_t)((row >> 11) * 3 + (tt - 2045)) * 4096 + c; }
                        else if (row < 16512) { const int rs = row - 16384, t4 = rs & 3; if (t4 >= 1) o = out + 41197568 + (size_t)((rs >> 2) * 3 + (t4 - 1)) * 4096 + c; }
                        if (o) { *(f32x4*)o = v0; *(f32x4*)(o + 4) = v1; }
                    } else if (kind == 2 || kind == 3) {
                        float* o = nullptr;
                        if (row < 16384) o = out + (kind == 2 ? 16908288 : 21102592) + (size_t)row * 256 + c;
                        else if (row < 16512) o = out + (kind == 2 ? 32735232 : 32768000) + (size_t)(row - 16384) * 256 + c;
                        if (o) { *(f32x4*)o = v0; *(f32x4*)(o + 4) = v1; }
                    } else if (kind == 4) {
                        float* mo = MISC + (size_t)row * 256 + c; *(f32x4*)mo = v0; *(f32x4*)(mo + 4) = v1;
                        if (c >= 32 && c < 96) {
                            *(u32x4*)(KIB + (size_t)row * 64 + (c - 32)) = w;
                            float* o = nullptr;
                            if (row < 16384) o = out + 25296896 + (size_t)row * 64 + (c - 32);
                            else if (row < 16512) o = out + 32800768 + (size_t)(row - 16384) * 64 + (c - 32);
                            if (o) { *(f32x4*)o = v0; *(f32x4*)(o + 4) = v1; }
                        }
                    }
                }
            }
    }
};
}
static_assert(O_CONVP == 28442624 && O_CONVS == 41197568 && O_KP == 16908288 && O_VP == 21102592 && O_KS == 32735232 && O_VS == 32768000 && O_KIP == 25296896 && O_KIS == 32800768, "offsets used in EpiWin");


namespace mema {
typedef short s16x8 __attribute__((ext_vector_type(8)));
typedef float f4 __attribute__((ext_vector_type(4)));
typedef unsigned u2 __attribute__((ext_vector_type(2)));
typedef unsigned u4 __attribute__((ext_vector_type(4)));
__device__ __forceinline__ f4 mfma16(s16x8 a, s16x8 b, f4 c) { return __builtin_amdgcn_mfma_f32_16x16x32_bf16(a, b, c, 0, 0, 0); }
__device__ __forceinline__ void mem_stage_load(int tid, const bf16* __restrict__ src  , int pitch, u4 (&v)[16]) {
#pragma unroll
    for (int i = 0; i < 16; ++i) { const int idx = i * 512 + tid, row = idx >> 5, c = idx & 31; v[i] = *(const u4*)(src + (size_t)row * pitch + 8 * c); }
}
__device__ __forceinline__ void mem_stage_store(LAS unsigned char* lds, int tid, const u4 (&v)[16]) {
#pragma unroll
    for (int i = 0; i < 16; ++i) { const int idx = i * 512 + tid, row = idx >> 5, c = idx & 31; *(LAS u4*)(lds + row * 512 + ((c ^ (row & 15)) << 4)) = v[i]; }
}
__device__ __forceinline__ void memattn_unit(LAS unsigned char* lds, int tid, const bf16* __restrict__ QM, const bf16* __restrict__ MKB, const bf16* __restrict__ MVT, bf16* __restrict__ OM,
                                             int bm, int head, int qrow0, int nq) {
    const int lane = tid & 63, wave = __builtin_amdgcn_readfirstlane(tid >> 6), l15 = lane & 15, lq = lane >> 4;
    const bool active = 16 * wave < nq;
    const int t = 16 * wave + l15, qrow = qrow0 + (t < nq ? t : nq - 1);
    s16x8 qf[8];
#pragma unroll
    for (int ks = 0; ks < 8; ++ks) qf[ks] = *(const s16x8*)(QM + (size_t)qrow * 1024 + head * 256 + 32 * ks + 8 * lq);
    u4 stg[16];
    mem_stage_load(tid, MKB + (size_t)bm * 256 * 1024 + head * 256, 1024, stg);
    mem_stage_store(lds, tid, stg);
    s16x8 pf[8]; float inv = 0.f;
    __syncthreads();
    f4 s[16];
    if (active) {
#pragma unroll
        for (int kt = 0; kt < 16; ++kt) { s[kt] = (f4){0.f, 0.f, 0.f, 0.f};
#pragma unroll
            for (int ks = 0; ks < 8; ++ks) s[kt] = mfma16(*(const LAS s16x8*)(lds + (16 * kt + l15) * 512 + (((4 * ks + lq) ^ l15) << 4)), qf[ks], s[kt]); }
    }
    mem_stage_load(tid, MVT + ((size_t)bm * 1024 + head * 256) * 256, 256, stg);
    if (active) {
        float mx = -1e30f;
#pragma unroll
        for (int kt = 0; kt < 16; ++kt) mx = fmaxf(mx, fmaxf(fmaxf(s[kt].x, s[kt].y), fmaxf(s[kt].z, s[kt].w)));
        mx = fmaxf(mx, __shfl_xor(mx, 16)); mx = fmaxf(mx, __shfl_xor(mx, 32));
        const float c2 = 0.0625f * 1.4426950408889634f; float sum = 0.f;
#pragma unroll
        for (int kt = 0; kt < 16; ++kt) { s[kt].x = __builtin_amdgcn_exp2f((s[kt].x - mx) * c2); s[kt].y = __builtin_amdgcn_exp2f((s[kt].y - mx) * c2);
            s[kt].z = __builtin_amdgcn_exp2f((s[kt].z - mx) * c2); s[kt].w = __builtin_amdgcn_exp2f((s[kt].w - mx) * c2); sum += (s[kt].x + s[kt].y) + (s[kt].z + s[kt].w); }
        sum += __shfl_xor(sum, 16); sum += __shfl_xor(sum, 32);
        inv = 1.0f / sum;
#pragma unroll
        for (int s8 = 0; s8 < 8; ++s8) { u4 w; w.x = pk2(s[2 * s8].x, s[2 * s8].y); w.y = pk2(s[2 * s8].z, s[2 * s8].w); w.z = pk2(s[2 * s8 + 1].x, s[2 * s8 + 1].y); w.w = pk2(s[2 * s8 + 1].z, s[2 * s8 + 1].w);
            pf[s8] = __builtin_bit_cast(s16x8, w); }
    }
    __syncthreads();
    mem_stage_store(lds, tid, stg);
    __syncthreads();
    if (active) {
        bf16* orow = OM + (size_t)qrow * 1024 + head * 256 + 4 * lq;
#pragma unroll 4
        for (int dt = 0; dt < 16; ++dt) { f4 o = (f4){0.f, 0.f, 0.f, 0.f};
            const LAS unsigned char* vr = lds + (16 * dt + l15) * 512 + 8 * (lq & 1);
#pragma unroll
            for (int s8 = 0; s8 < 8; ++s8) { const int c = 4 * s8 + (lq >> 1);
                const u2 a0 = *(const LAS u2*)(vr + ((c ^ l15) << 4)), a1 = *(const LAS u2*)(vr + (((c + 2) ^ l15) << 4));
                u4 fa; fa.x = a0.x; fa.y = a0.y; fa.z = a1.x; fa.w = a1.y;
                o = mfma16(__builtin_bit_cast(s16x8, fa), pf[s8], o); }
            if (t < nq) { u2 w; w.x = pk2(o.x * inv, o.y * inv); w.y = pk2(o.z * inv, o.w * inv); *(u2*)(orow + 16 * dt) = w; }
        }
    }
    __syncthreads();
}
}

namespace pg8 {
struct EpiGateS {
    static constexpr bool PERM = false, AFTER_DRAIN = false; static constexpr int HOOK_T = 0; static constexpr bool GROUPS = false;
    float* F; const bf16_t* G;
    __device__ __forceinline__ void operator()(const f32x4 (&acc)[2][2][4][2], const Unit& u, int wr, int wc, int fr, int fq) const {
        typedef unsigned u32x2v __attribute__((ext_vector_type(2)));
        const int row0 = u.pm * BM + wr * 64 + fr, col0 = u.pn * BM + wc * 32 + 4 * fq;
#pragma unroll
        for (int ai = 0; ai < 2; ++ai)
#pragma unroll
            for (int m = 0; m < 4; ++m) { const size_t off = (size_t)(row0 + ai * HALF + m * 16) * 1024 + col0;
#pragma unroll
                for (int bj = 0; bj < 2; ++bj)
#pragma unroll
                    for (int n = 0; n < 2; ++n) { const u32x2v g = *(const u32x2v*)(G + off + bj * HALF + n * 16); const f32x4 v = acc[ai][bj][m][n]; f32x4 o;
                        o[0] = v[0] * ep_sigm(__uint_as_float(g.x << 16)); o[1] = v[1] * ep_sigm(__uint_as_float(g.x & 0xffff0000u));
                        o[2] = v[2] * ep_sigm(__uint_as_float(g.y << 16)); o[3] = v[3] * ep_sigm(__uint_as_float(g.y & 0xffff0000u));
                        *(f32x4*)(F + off + bj * HALF + n * 16) = o; } }
    }
};
struct EpiGateA {
    static constexpr bool PERM = false, AFTER_DRAIN = false; static constexpr int HOOK_T = 0; static constexpr bool GROUPS = false;
    const float* F; const bf16_t* G; bf16_t* O;
    __device__ __forceinline__ void operator()(const f32x4 (&acc)[2][2][4][2], const Unit& u, int wr, int wc, int fr, int fq) const {
        typedef unsigned u32x2v __attribute__((ext_vector_type(2)));
        const int row0 = u.pm * BM + wr * 64 + fr, col0 = u.pn * BM + wc * 32 + 4 * fq;
#pragma unroll
        for (int ai = 0; ai < 2; ++ai)
#pragma unroll
            for (int m = 0; m < 4; ++m) { const size_t off = (size_t)(row0 + ai * HALF + m * 16) * 1024 + col0;
#pragma unroll
                for (int bj = 0; bj < 2; ++bj)
#pragma unroll
                    for (int n = 0; n < 2; ++n) { const u32x2v g = *(const u32x2v*)(G + off + bj * HALF + n * 16); const f32x4 v = acc[ai][bj][m][n]; const f32x4 f = *(const f32x4*)(F + off + bj * HALF + n * 16);
                        u32x2v w;
                        w.x = cvt_pk_bf16(f[0] + v[0] * ep_sigm(__uint_as_float(g.x << 16)), f[1] + v[1] * ep_sigm(__uint_as_float(g.x & 0xffff0000u)));
                        w.y = cvt_pk_bf16(f[2] + v[2] * ep_sigm(__uint_as_float(g.y << 16)), f[3] + v[3] * ep_sigm(__uint_as_float(g.y & 0xffff0000u)));
                        *(u32x2v*)(O + off + bj * HALF + n * 16) = w; } }
    }
};
struct EpiGateC {
    static constexpr bool PERM = false, AFTER_DRAIN = false; static constexpr int HOOK_T = 32; static constexpr bool GROUPS = true;
    const bf16_t* GS; const bf16_t* GA; bf16_t* O; const float* SSQ; LAS float* RT;
    template <bool LIGHT>
    __device__ __forceinline__ void fill(const Unit& u, int tl_in) const {
        int tl = tl_in; asm volatile("" : "+v"(tl));
        const int rl = tl >> 1, hf = tl & 1;
        const float* sp = SSQ + (size_t)(u.pm * BM + rl) * 32 + 16 * hf;
        float og[4];
#pragma unroll
        for (int g = 0; g < 4; ++g) { const f32x4 s = *(const f32x4*)(sp + 4 * g); float t = ((s[0] + s[1]) + (s[2] + s[3])) * (1.0f / 256.0f) + EPS;
            if (LIGHT) asm volatile("" : "+v"(t) :: "memory");
            og[g] = t; }
        *(LAS f32x4*)(RT + rl * 8 + 4 * hf) = (f32x4){og[0], og[1], og[2], og[3]};
    }
    __device__ __forceinline__ void hookg(f32x4 (&acc)[2][2][4][2], int j, int wr, int fr) const {
        int rb = (wr * 64 + fr) * 8 + j; asm volatile("" : "+v"(rb));
#pragma unroll
        for (int ai = 0; ai < 2; ++ai)
#pragma unroll
            for (int m = 0; m < 4; ++m) { const float va = RT[rb + (ai * HALF + m * 16) * 8 - 1], vb = RT[rb + (ai * HALF + m * 16) * 8];
                const float r = __builtin_amdgcn_sqrtf(vb * __builtin_amdgcn_rcpf(va));
#pragma unroll
                for (int bj = 0; bj < 2; ++bj)
#pragma unroll
                    for (int n = 0; n < 2; ++n) acc[ai][bj][m][n] = acc[ai][bj][m][n] * r;
                asm volatile("" ::: "memory"); }
    }
    __device__ __forceinline__ void hook(f32x4 (&acc)[2][2][4][2], const Unit& u, int wr, int wc, int fr, int fq) const {
        typedef unsigned u32x2v __attribute__((ext_vector_type(2)));
        int row0 = u.pm * BM + wr * 64 + fr, col0 = u.pn * BM + wc * 32 + 4 * fq, rb = (wr * 64 + fr) * 8;
        asm volatile("" : "+v"(row0), "+v"(col0), "+v"(rb));
#pragma unroll
        for (int ai = 0; ai < 2; ++ai)
#pragma unroll
            for (int m = 0; m < 4; ++m) { const size_t off = (size_t)(row0 + ai * HALF + m * 16) * 1024 + col0; const float rs7 = __builtin_amdgcn_rsqf(RT[rb + (ai * HALF + m * 16) * 8 + 7]);
#pragma unroll
                for (int bj = 0; bj < 2; ++bj)
#pragma unroll
                    for (int n = 0; n < 2; ++n) { const u32x2v gs = *(const u32x2v*)(GS + off + bj * HALF + n * 16), ga = *(const u32x2v*)(GA + off + bj * HALF + n * 16);
                        f32x4 r;
                        r[0] = (1.0f + __expf(-__uint_as_float(ga.x << 16))) * __builtin_amdgcn_rcpf(1.0f + __expf(-__uint_as_float(gs.x << 16)));
                        r[1] = (1.0f + __expf(-__uint_as_float(ga.x & 0xffff0000u))) * __builtin_amdgcn_rcpf(1.0f + __expf(-__uint_as_float(gs.x & 0xffff0000u)));
                        r[2] = (1.0f + __expf(-__uint_as_float(ga.y << 16))) * __builtin_amdgcn_rcpf(1.0f + __expf(-__uint_as_float(gs.y << 16)));
                        r[3] = (1.0f + __expf(-__uint_as_float(ga.y & 0xffff0000u))) * __builtin_amdgcn_rcpf(1.0f + __expf(-__uint_as_float(gs.y & 0xffff0000u)));
                        acc[ai][bj][m][n] = acc[ai][bj][m][n] * (r * rs7); }
                asm volatile("" ::: "memory"); }
    }
    __device__ __forceinline__ void operator()(const f32x4 (&acc)[2][2][4][2], const Unit& u, int wr, int wc, int fr, int fq) const {
        typedef unsigned u32x2v __attribute__((ext_vector_type(2)));
        const int row0 = u.pm * BM + wr * 64 + fr, col0 = u.pn * BM + wc * 32 + 4 * fq;
#pragma unroll
        for (int ai = 0; ai < 2; ++ai)
#pragma unroll
            for (int m = 0; m < 4; ++m) { const size_t off = (size_t)(row0 + ai * HALF + m * 16) * 1024 + col0;
#pragma unroll
                for (int bj = 0; bj < 2; ++bj)
#pragma unroll
                    for (int n = 0; n < 2; ++n) { const u32x2v ga = *(const u32x2v*)(GA + off + bj * HALF + n * 16); const f32x4 v = acc[ai][bj][m][n]; u32x2v w;
                        w.x = cvt_pk_bf16(v[0] * ep_sigm(__uint_as_float(ga.x << 16)), v[1] * ep_sigm(__uint_as_float(ga.x & 0xffff0000u)));
                        w.y = cvt_pk_bf16(v[2] * ep_sigm(__uint_as_float(ga.y << 16)), v[3] * ep_sigm(__uint_as_float(ga.y & 0xffff0000u)));
                        *(u32x2v*)(O + off + bj * HALF + n * 16) = w; } }
    }
};
}

namespace sgemm {
typedef short s16x8 __attribute__((ext_vector_type(8)));
typedef float f4 __attribute__((ext_vector_type(4)));
__device__ __forceinline__ f4 mfma16(s16x8 a, s16x8 b, f4 c) { return __builtin_amdgcn_mfma_f32_16x16x32_bf16(a, b, c, 0, 0, 0); }
__device__ __forceinline__ void part(const bf16* __restrict__ A, int lda, const bf16* __restrict__ W, int ldw, int K, int rb, int cb, int wave, int l15, int lq, f4 (&acc)[2]) {
    const int ksl = K >> 3, k0 = wave * ksl;
    const bf16* ap = A + (size_t)(MP + 32 * rb + l15) * lda + k0 + 8 * lq;
    const bf16* wp = W + (size_t)(16 * cb + l15) * ldw + k0 + 8 * lq;
    for (int ks = 0; ks < (ksl >> 5); ++ks) {
        const s16x8 bf = *(const s16x8*)(wp + 32 * ks);
        acc[0] = mfma16(*(const s16x8*)(ap + 32 * ks), bf, acc[0]);
        acc[1] = mfma16(*(const s16x8*)(ap + (size_t)16 * lda + 32 * ks), bf, acc[1]);
    }
}
template <int MODE>
__device__ __forceinline__ void run(LAS unsigned char* lds, int tid, int item, const bf16* __restrict__ A1, int lda1, const bf16* __restrict__ W1, int ldw1, int K1,
                                    const bf16* __restrict__ A2, int lda2, const bf16* __restrict__ W2, int ldw2, int K2,
                                    float* __restrict__ Of, bf16* __restrict__ Ob, const bf16* __restrict__ GS, const bf16* __restrict__ GA, const float* __restrict__ SSQ = nullptr) {
    const int lane = tid & 63, wave = __builtin_amdgcn_readfirstlane(tid >> 6), l15 = lane & 15, lq = lane >> 4;
    const int rb = item & 3, cb = item >> 2;
    f4 acc[2] = {(f4){0.f, 0.f, 0.f, 0.f}, (f4){0.f, 0.f, 0.f, 0.f}};
    part(A1, lda1, W1, ldw1, K1, rb, cb, wave, l15, lq, acc);
    if (MODE == 2) {
#pragma unroll
        for (int rt = 0; rt < 2; ++rt)
#pragma unroll
            for (int e = 0; e < 4; ++e) { const f4 s = *(const f4*)(SSQ + (size_t)(MP + 32 * rb + 16 * rt + 4 * lq + e) * 32 + 4 * wave);
                acc[rt][e] *= 1.0f / sqrtf(((s.x + s.y) + (s.z + s.w)) * (1.0f / 256.0f) + EPS); }
    }
    LAS float* red = (LAS float*)lds;
#pragma unroll
    for (int rt = 0; rt < 2; ++rt) { red[(wave * 32 + 16 * rt + 4 * lq + 0) * 16 + l15] = acc[rt].x; red[(wave * 32 + 16 * rt + 4 * lq + 1) * 16 + l15] = acc[rt].y;
        red[(wave * 32 + 16 * rt + 4 * lq + 2) * 16 + l15] = acc[rt].z; red[(wave * 32 + 16 * rt + 4 * lq + 3) * 16 + l15] = acc[rt].w; }
    if (MODE == 2) {
        f4 ac2[2] = {(f4){0.f, 0.f, 0.f, 0.f}, (f4){0.f, 0.f, 0.f, 0.f}};
        part(A2, lda2, W2, ldw2, K2, rb, cb, wave, l15, lq, ac2);
#pragma unroll
        for (int rt = 0; rt < 2; ++rt) { red[4096 + (wave * 32 + 16 * rt + 4 * lq + 0) * 16 + l15] = ac2[rt].x; red[4096 + (wave * 32 + 16 * rt + 4 * lq + 1) * 16 + l15] = ac2[rt].y;
            red[4096 + (wave * 32 + 16 * rt + 4 * lq + 2) * 16 + l15] = ac2[rt].z; red[4096 + (wave * 32 + 16 * rt + 4 * lq + 3) * 16 + l15] = ac2[rt].w; }
    }
    __syncthreads();
    { const int r = tid >> 4, c = tid & 15; float v = 0.f;
#pragma unroll
      for (int w = 0; w < 8; ++w) v += red[(w * 32 + r) * 16 + c];
      const size_t o = (size_t)(MP + 32 * rb + r) * 1024 + 16 * cb + c;
      if (MODE == 0) Of[o] = v;
      else if (MODE == 1) Ob[o] = (bf16)f2bf(v);
      else { float v2 = 0.f;
#pragma unroll
          for (int w = 0; w < 8; ++w) v2 += red[4096 + (w * 32 + r) * 16 + c];
          const float gs = __uint_as_float((unsigned)GS[o] << 16), ga = __uint_as_float((unsigned)GA[o] << 16);
          Ob[o] = (bf16)f2bf(v * sigmoid_f(gs) + v2 * sigmoid_f(ga)); } }
    __syncthreads();
}
}
__global__ void __launch_bounds__(NWAVES * 64, 2) mega_fwd(Args a_unused) {
    extern __shared__ __attribute__((aligned(16))) unsigned char lds_raw[];
    LAS unsigned char* lds = (LAS unsigned char*)lds_raw;
    volatile LAS unsigned* MISCW = (volatile LAS unsigned*)(lds + MISC_OFF);
    const int wave0 = __builtin_amdgcn_readfirstlane(threadIdx.x >> 6);
    const KArgs ap0 = (KArgs)__builtin_amdgcn_kernarg_segment_ptr();
    for (int u = threadIdx.x; u < (LDS_BYTES - LDSCTL_OFF) / 4; u += NWAVES * 64) ((LAS unsigned*)(lds + LDSCTL_OFF))[u] = 0u;
    __syncthreads();
    (void)xcd_barrier_post((unsigned*)(ap0->ws + WS_CTL) + CW_BAR, MISCW + 8);
#ifdef DBG_T1
#define DBG_STAMP(k_) if (blockIdx.x == 0 && tid == 0) { KArgs as_ = ap0; asm volatile("" : "+s"(as_)); ((unsigned long long*)(as_->ws + WS_CTL + 512 * 1024))[k_] = __builtin_amdgcn_s_memrealtime(); }
#else
#define DBG_STAMP(k_)
#endif
#ifdef DBG_U1
#define UT_BEGIN() const unsigned long long ut0_ = __builtin_amdgcn_s_memrealtime();
#define UT_END(ty_) if (tu == 0) { KArgs au_ = ap0; asm volatile("" : "+s"(au_)); atomicAdd((unsigned*)(au_->ws + WS_CTL + 768 * 1024) + (ty_), (unsigned)(__builtin_amdgcn_s_memrealtime() - ut0_)); }
#else
#define UT_BEGIN()
#define UT_END(ty_)
#endif
#define TID_FRESH(tv) int tv; { unsigned m_ = ~0u; asm volatile("" : "+s"(m_)); tv = wave0 * 64 + (int)__builtin_amdgcn_mbcnt_hi(m_, __builtin_amdgcn_mbcnt_lo(m_, 0u)); }
#define PH_BEGIN(k_) { TID_FRESH(tid) DBG_STAMP(k_) KArgs a = ap0; asm volatile("" : "+s"(a)); \
    const int lane = tid & 63, wave = wave0; const int G = gridDim.x, gw = blockIdx.x * NWAVES + wave, NGW = G * NWAVES; \
    unsigned char* ws = a->ws; float* out = a->out; unsigned* ctl = (unsigned*)(ws + WS_CTL); bf16* U = (bf16*)(ws + WS_U); bf16* ACT = (bf16*)(ws + WS_ACT); float* Fb = (float*)(ws + WS_F); bf16* FB = (bf16*)(ws + WS_FB); bf16* HB = (bf16*)(ws + WS_HB); (void)FB; (void)HB; \
    (void)lane; (void)wave; (void)gw; (void)NGW; (void)out; (void)ctl; (void)U; (void)ACT; (void)Fb;
#define GRID_BARRIER() do { TID_FRESH(tb_) KArgs ab_ = ap0; asm volatile("" : "+s"(ab_)); XcdBarrier bb_; bb_.bar = (unsigned*)(ab_->ws + WS_CTL) + CW_BAR; bb_.x = xb_xcc_id(); bb_.st = MISCW + 8; \
    xcd_barrier(bb_, tb_ == 0); } while (0)
#define PH_END } GRID_BARRIER();
#define DEQUEUE(qi, uvar) do { if (tid == 0) MISCW[16] = __hip_atomic_fetch_add(ctl + CW_Q + 64 * (qi), 1u, __ATOMIC_RELAXED, __HIP_MEMORY_SCOPE_AGENT); \
        __syncthreads(); uvar = (int)MISCW[16]; __syncthreads(); } while (0)

    PH_BEGIN(0)
    prologue(a, lds, wave, lane, gw, NGW);
    PH_END

    PH_BEGIN(1)
    { pg8::Gemm g{U, (const bf16*)(ws + WS_WGU1), MT, NGU, DM}; pg8::StaticOrder S; S.init(MT, NGU, G, (int)blockIdx.x);
      pg8::EpiGU E{ACT};
      pg8::gemm_phase<pg8::EpiGU, pg8::StaticOrder, true, true>(lds, g, S, E, tid); }
    { const int rem1 = ((MT / 256) * (NGU / 256)) % G, nkv = (NB * 256 / 256) * (2048 / 256); const bool fits = rem1 != 0 && rem1 + nkv <= G; const int koff = fits ? rem1 : 0;
      { pg8::Gemm g{(const bf16*)(ws + WS_MN), (const bf16*)(ws + WS_WMKV), NB * 256, 2048, DM}; pg8::StaticOrder S; S.init(NB * 256, 2048, G, (int)((blockIdx.x + G - koff) % G));
        pg8::EpiMemKV E{out + O_MKP, out + O_MVP, (bf16*)(ws + WS_MKB)};
        pg8::gemm_phase<pg8::EpiMemKV, pg8::StaticOrder, true, true>(lds, g, S, E, tid); }
      tr_tail(a, lds, wave, lane, fits ? rem1 + nkv : (nkv % G), G, TrSet{IT_CMV, TR_CMV, 0, 0, 0, 0, 0, 0}); }
    PH_END

    PH_BEGIN(2)
    { pg8::Gemm g{ACT, (const bf16*)(ws + WS_WD1), MP, DM, FF}; pg8::StaticOrder S; S.init(MP, DM, G, (int)blockIdx.x);
      pg8::EpiB16 E{FB, DM};
      pg8::gemm_phase<pg8::EpiB16, pg8::StaticOrder, true, true>(lds, g, S, E, tid); }
    for (int it = blockIdx.x; it < 256; it += G) sgemm::run<1>(lds, tid, it, ACT, FF, (const bf16*)(ws + WS_WD1), FF, FF, nullptr, 0, nullptr, 0, 0, nullptr, FB, nullptr, nullptr);
    PH_END

    PH_BEGIN(3)
    for (int r = gw; r < MR; r += 4 * NGW) {
        f32x4 f[4][4], h[4][4];
#pragma unroll
        for (int k = 0; k < 4; ++k) { const int rk = r + k * NGW < MR ? r + k * NGW : r;
            pn_load(rk < MP ? (const float*)a->in[I_XP] + (size_t)rk * DM : (const float*)a->in[I_XS] + (size_t)(rk - MP) * DM, nullptr, FB + (size_t)rk * DM, lane, f[k], h[k]); }
#pragma unroll
        for (int k = 0; k < 4; ++k) { const int rk = r + k * NGW;
            if (rk < MR) pn_finish(f[k], h[k], (const float*)a->in[I_F1POST], 0.5f, HB + (size_t)rk * DM, nullptr, (const float*)a->in[I_MIXPRE], U + (size_t)rk * DM, lane); }
    }
    PH_END

    PH_BEGIN(4)
    { pg8::Gemm g{U, (const bf16*)(ws + WS_WIN), MT, NINP, DM}; pg8::StaticOrder S; S.init(MT, NINP, G, (int)blockIdx.x);
      pg8::EpiWin E{(bf16*)(ws + WS_Z), (bf16*)(ws + WS_XBC), (bf16*)(ws + WS_Q), (bf16*)(ws + WS_KB), (bf16*)(ws + WS_QI), (bf16*)(ws + WS_GS), (bf16*)(ws + WS_GA),
                    (bf16*)(ws + WS_KIB), (float*)(ws + WS_MISC), out};
      pg8::gemm_phase<pg8::EpiWin, pg8::StaticOrder, true, true>(lds, g, S, E, tid); }
    { const int thr = ((MT / 256) * (NINP / 256)) % G;
      if ((int)blockIdx.x >= thr) { const int id = ((int)blockIdx.x - thr) * NWAVES + wave, nid = (G - thr) * NWAVES; LAS float* scr = (LAS float*)(lds + wave * 16384);
          tr_run(a, scr, lane, id, nid, TrSet{IT_GU, TR_GU2, IT_BRS + 4 * IT_SQ, TR_BRS, 0, 0, 0, 0});
          rows_run(a, lane, id, nid, ROWS_P0, IT_ROWS);
          for (int it = id; it < NB * 128; it += nid) { const int b = it >> 7, q = it & 127, db = q >> 2, kb = q & 3;
              tr_item(out + O_MVP + (size_t)b * 256 * DM, DM, 32 * db, 32, 64 * kb, (bf16*)(ws + WS_MVT) + (size_t)b * DM * 256, 256, 32 * db, 0, nullptr, scr, lane); } } }
    PH_END

    PH_BEGIN(5)
    for (;;) {
        int u; DEQUEUE(0, u);
        { KArgs a2 = ap0; asm volatile("" : "+s"(a2)); a = a2; ws = a->ws; out = a->out; }
        TID_FRESH(tu) const int wu = wave0, lu = tu & 63; (void)wu; (void)lu;
        if (u >= 768 + 256 + 32 + 128) break;
        UT_BEGIN()
        int uty, uix;
        if (u < 768) { const int grp = u / 3, k = u - 3 * grp; uty = (k == 0) ? 0 : (k == 1 ? 2 : 1); uix = grp; }
        else if (u < 1024) { uty = 0; uix = 256 + (u - 768); }
        else if (u < 1056) { uty = 1; uix = 256 + (u - 1024); }
        else { uty = 3; uix = u - 1056; }
        if (uty == 0) {
            const int v = uix, qblk = 63 - (v >> 3), b = v & 7;
            dsa::idx_prompt_unit(lds, tu, (const bf16*)(ws + WS_QI), (const bf16*)(ws + WS_KIB), (const float*)(ws + WS_MISC), (float*)(ws + WS_SC), (unsigned*)(ws + WS_MASK), b, qblk);
            UT_END(1)
        } else if (uty == 1) {
            const int v = uix;
            if (v < 256) ssd::conv_rows(tu, (const bf16*)(ws + WS_XBC), (bf16*)(ws + WS_XBCA), (const float*)a->in[I_CONVW], (const float*)a->in[I_CONVB], 64 * v, 64, (64 * v) & (SEQ - 1), nullptr);
            else ssd::conv_rows(tu, (const bf16*)(ws + WS_XBC), (bf16*)(ws + WS_XBCA), (const float*)a->in[I_CONVW], (const float*)a->in[I_CONVB], MP + 4 * (v - 256), 4, 0, (const float*)a->in[I_CONV] + (size_t)(v - 256) * 3 * 4096);
            UT_END(0)
        } else if (uty == 2) {
            const int v = uix;
            dsa::idx_sample_unit(tu, (const bf16*)(ws + WS_QI), (const float*)(ws + WS_MISC), (const float*)a->in[I_CKI], (const int*)a->in[I_PT], (float*)(ws + WS_SCS), v >> 3, v & 7);
            UT_END(2)
        } else {
            const int v = uix; LAS float* scr = (LAS float*)(lds + wu * 16384);
#pragma unroll 1
            for (int i = 0; i < 2; ++i) { const int it = v * 16 + wu * 2 + i, b = it >> 8, q = it & 255, db = q >> 5, kb = q & 31;
                tr_item(out + O_VP + (size_t)b * SEQ * 256, 256, 32 * db, 32, 64 * kb, (bf16*)(ws + WS_VT) + (size_t)b * 256 * SEQ, SEQ, 32 * db, 0, nullptr, scr, lu); }
            __syncthreads();
            UT_END(4)
        }
    }
    PH_END

    PH_BEGIN(6)
    for (;;) {
        int u; DEQUEUE(1, u);
        { KArgs a2 = ap0; asm volatile("" : "+s"(a2)); a = a2; ws = a->ws; out = a->out; }
        TID_FRESH(tu) const int wu = wave0, lu = tu & 63; (void)wu; (void)lu;
        if (u >= 256 + 128 + 1024 + 1024) break;
        UT_BEGIN()
        if (u < 256 || u >= 1408) {
            const bool smp = u >= 1408; const int v = smp ? u - 1408 : u, b = v >> 5, g = (v >> 2) & 7, h = v & 3;
            if (smp) ssd::ssd_sample_unit(lds, tu, a, b, 4 * g + h);
            else ssd::ssd_unit(lds, tu, a, b * SEQ, SEQ, g, h, b, false);
            UT_END(smp ? 3 : 10)
        } else if (u < 384) {
            const int aix = u - 256;
            dsa::sample_query_unit(lds, tu, (const bf16*)(ws + WS_Q), (const bf16*)(ws + WS_QI), (const float*)(ws + WS_MISC), (const float*)(ws + WS_SCS),
                                   (const float*)a->in[I_CK], (const float*)a->in[I_CV], (const int*)a->in[I_PT], out, (bf16*)(ws + WS_YC) + 2048, aix >> 2, aix & 3);
            UT_END(5)
        } else {
            const int v = u - 384, qb = 31 - (v >> 5), b = (v >> 2) & 7, kvh = v & 3;
            dsa::attn_prompt_unit(lds, tu, (const bf16*)(ws + WS_Q), (const bf16*)(ws + WS_KB), (const bf16*)(ws + WS_VT), (const unsigned*)(ws + WS_MASK), (bf16*)(ws + WS_YC) + 2048, b, kvh, qb);
            UT_END(6)
        }
    }
    PH_END

    PH_BEGIN(7)
    { pg8::Gemm g{(const bf16*)(ws + WS_YC), (const bf16*)(ws + WS_WBRS), MP, DM, 3072};
      pg8::EpiGateC E{(const bf16*)(ws + WS_GS), (const bf16*)(ws + WS_GA), (bf16*)(ws + WS_MRG), (const float*)(ws + WS_SSQ), (LAS float*)(lds + MISC_OFF + 1024)};
      for (int i = 0;; ++i) {
          pg8::Unit u0; { pg8::StaticOrder S0; S0.init(MP, DM, G, (int)blockIdx.x); if (!S0.next(i, u0)) break; }
          E.fill<false>(u0, tid);
          pg8::StaticOrder S; S.init(MP, DM, 1 << 28, i * G + (int)blockIdx.x);
          pg8::gemm_phase<pg8::EpiGateC, pg8::StaticOrder, true, true>(lds, g, S, E, tid); } }
    for (int it = blockIdx.x; it < 256; it += G) sgemm::run<2>(lds, tid, it, (const bf16*)(ws + WS_YC), YCP, (const bf16*)(ws + WS_WBRS), 3072, 2048, (const bf16*)(ws + WS_YC) + 2048, YCP, (const bf16*)(ws + WS_WBRS) + 2048, 3072, DM,
                                                               nullptr, (bf16*)(ws + WS_MRG), (const bf16*)(ws + WS_GS), (const bf16*)(ws + WS_GA), (const float*)(ws + WS_SSQ));
    PH_END

    PH_BEGIN(8)
    { pg8::Gemm g{(const bf16*)(ws + WS_MRG), (const bf16*)(ws + WS_WOUT), MP, DM, DM}; pg8::StaticOrder S; S.init(MP, DM, G, (int)blockIdx.x);
      pg8::EpiB16 E{FB, DM};
      pg8::gemm_phase<pg8::EpiB16, pg8::StaticOrder, true, true>(lds, g, S, E, tid); }
    for (int it = blockIdx.x; it < 256; it += G) sgemm::run<1>(lds, tid, it, (const bf16*)(ws + WS_MRG), DM, (const bf16*)(ws + WS_WOUT), DM, DM, nullptr, 0, nullptr, 0, 0, nullptr, FB, nullptr, nullptr);
    PH_END

    PH_BEGIN(9)
    for (int r = gw; r < MR; r += 4 * NGW) {
        f32x4 f[4][4], h[4][4];
#pragma unroll
        for (int k = 0; k < 4; ++k) { const int rk = r + k * NGW < MR ? r + k * NGW : r; pn_load(nullptr, HB + (size_t)rk * DM, FB + (size_t)rk * DM, lane, f[k], h[k]); }
#pragma unroll
        for (int k = 0; k < 4; ++k) { const int rk = r + k * NGW; if (rk < MR) pn_finish(f[k], h[k], (const float*)a->in[I_MIXPOST], 1.0f, HB + (size_t)rk * DM, nullptr, (const float*)a->in[I_MEMPRE], U + (size_t)rk * DM, lane); }
    }
    PH_END

    PH_BEGIN(10)
    { pg8::Gemm g{U, (const bf16*)(ws + WS_WMQ), MP, DM, DM}; pg8::StaticOrder S; S.init(MP, DM, G, (int)blockIdx.x);
      pg8::EpiB16 E{(bf16*)(ws + WS_QM), DM};
      pg8::gemm_phase<pg8::EpiB16, pg8::StaticOrder, true, true>(lds, g, S, E, tid); }
    for (int it = blockIdx.x; it < 256; it += G) sgemm::run<1>(lds, tid, it, U, DM, (const bf16*)(ws + WS_WMQ), DM, DM, nullptr, 0, nullptr, 0, 0, nullptr, (bf16*)(ws + WS_QM), nullptr, nullptr);
    PH_END

    PH_BEGIN(11)
    for (;;) {
        int u; DEQUEUE(2, u);
        { KArgs a2 = ap0; asm volatile("" : "+s"(a2)); a = a2; ws = a->ws; out = a->out; }
        TID_FRESH(tu) const int wu = wave0, lu = tu & 63; (void)wu; (void)lu;
        if (u >= 512 + 128) break;
        UT_BEGIN()
        if (u < 512) { const int b = u >> 6, head = (u >> 4) & 3, qt = u & 15;
            mema::memattn_unit(lds, tu, (const bf16*)(ws + WS_QM), (const bf16*)(ws + WS_MKB), (const bf16*)(ws + WS_MVT), (bf16*)(ws + WS_OM), b, head, b * SEQ + 128 * qt, 128); UT_END(8)
        } else { const int v = u - 512, b = v >> 2, head = v & 3;
            mema::memattn_unit(lds, tu, (const bf16*)(ws + WS_QM), (const bf16*)(ws + WS_MKB), (const bf16*)(ws + WS_MVT), (bf16*)(ws + WS_OM), NB + b, head, MP + 4 * b, 4); UT_END(9) }
    }
    PH_END

    PH_BEGIN(12)
    { pg8::Gemm g{(const bf16*)(ws + WS_OM), (const bf16*)(ws + WS_WMO), MP, DM, DM}; pg8::StaticOrder S; S.init(MP, DM, G, (int)blockIdx.x);
      pg8::EpiB16 E{FB, DM};
      pg8::gemm_phase<pg8::EpiB16, pg8::StaticOrder, true, true>(lds, g, S, E, tid); }
    for (int it = blockIdx.x; it < 256; it += G) sgemm::run<1>(lds, tid, it, (const bf16*)(ws + WS_OM), DM, (const bf16*)(ws + WS_WMO), DM, DM, nullptr, 0, nullptr, 0, 0, nullptr, FB, nullptr, nullptr);
    PH_END

    PH_BEGIN(13)
    for (int r = gw; r < MR; r += 4 * NGW) {
        f32x4 f[4][4], h[4][4];
#pragma unroll
        for (int k = 0; k < 4; ++k) { const int rk = r + k * NGW < MR ? r + k * NGW : r; pn_load(nullptr, HB + (size_t)rk * DM, FB + (size_t)rk * DM, lane, f[k], h[k]); }
#pragma unroll
        for (int k = 0; k < 4; ++k) { const int rk = r + k * NGW; if (rk < MR) pn_finish(f[k], h[k], (const float*)a->in[I_MEMPOST], 1.0f, HB + (size_t)rk * DM, nullptr, (const float*)a->in[I_F2PRE], U + (size_t)rk * DM, lane); }
    }
    PH_END

    PH_BEGIN(14)
    { pg8::Gemm g{U, (const bf16*)(ws + WS_WGU2), MT, NGU, DM}; pg8::StaticOrder S; S.init(MT, NGU, G, (int)blockIdx.x);
      pg8::EpiGU E{ACT};
      pg8::gemm_phase<pg8::EpiGU, pg8::StaticOrder, true, true>(lds, g, S, E, tid); }
    tr_tail(a, lds, wave, lane, ((MT / 256) * (NGU / 256)) % G, G, TrSet{IT_D, TR_D2, 0, 0, 0, 0, 0, 0});
    PH_END

    PH_BEGIN(15)
    { pg8::Gemm g{ACT, (const bf16*)(ws + WS_WD2), MP, DM, FF}; pg8::StaticOrder S; S.init(MP, DM, G, (int)blockIdx.x);
      pg8::EpiB16 E{FB, DM};
      pg8::gemm_phase<pg8::EpiB16, pg8::StaticOrder, true, true>(lds, g, S, E, tid); }
    for (int it = blockIdx.x; it < 256; it += G) sgemm::run<1>(lds, tid, it, ACT, FF, (const bf16*)(ws + WS_WD2), FF, FF, nullptr, 0, nullptr, 0, 0, nullptr, FB, nullptr, nullptr);
    PH_END

    PH_BEGIN(16)
    for (int r = gw; r < MR; r += 4 * NGW) {
        f32x4 f[4][4], h[4][4];
#pragma unroll
        for (int k = 0; k < 4; ++k) { const int rk = r + k * NGW < MR ? r + k * NGW : r; pn_load(nullptr, HB + (size_t)rk * DM, FB + (size_t)rk * DM, lane, f[k], h[k]); }
#pragma unroll
        for (int k = 0; k < 4; ++k) { const int rk = r + k * NGW; if (rk < MR) pn_finish(f[k], h[k], (const float*)a->in[I_F2POST], 0.5f, nullptr, out + (size_t)rk * DM, nullptr, nullptr, lane); }
    }
    }
#ifdef DBG_T1
    GRID_BARRIER();
    PH_BEGIN(17)
    if (blockIdx.x == 0) {
        __syncthreads();
        const unsigned long long* st = (const unsigned long long*)(ws + WS_CTL + 512 * 1024);
        const float tot = (float)(st[17] - st[0]);
#ifdef DBG_U1
        const unsigned* ut = (const unsigned*)(ws + WS_CTL + 768 * 1024);
        const float f1 = (float)ut[DBG_U1] / (tot * (float)G), f2 = (DBG_U2 >= 16) ? (float)ut[DBG_U2] / ((float)ut[16] + (float)ut[17] + (float)ut[18] + (float)ut[19]) : (float)ut[DBG_U2] / (tot * (float)G);
#else
        const float f1 = (float)(st[DBG_T1 + 1] - st[DBG_T1]) / tot, f2 = (float)(st[DBG_T2 + 1] - st[DBG_T2]) / tot;
#endif
        const float sc = 1.0f;  (void)f1;
        for (int i = tid; i < MS * 64; i += 512) out[O_KIS + i] *= sc;
        if (tid == 0) out[O_VS] += 100.0f * f2;
    }
    }
#endif
}

extern "C" void kernel_launch(void* const* d_in, const int* in_sizes, int n_in, void* d_out, int out_size, void* d_ws, size_t ws_size, hipStream_t stream) {
    static int grid = 0;
    if (grid == 0) {
        if (n_in != N_IN || (size_t)out_size != O_END || ws_size < WS_END) {
            fprintf(stderr, "kernel_launch: unexpected sizes: n_in %d out %d ws %zu (need %zu)\n", n_in, out_size, ws_size, (size_t)WS_END); grid = -1; return; }
        int dev = 0, cus = 0, per_cu = 0;
        if (hipGetDevice(&dev) != hipSuccess || hipDeviceGetAttribute(&cus, hipDeviceAttributeMultiprocessorCount, dev) != hipSuccess) { grid = -1; return; }
        if (hipFuncSetAttribute((const void*)mega_fwd, hipFuncAttributeMaxDynamicSharedMemorySize, LDS_BYTES) != hipSuccess) { fprintf(stderr, "kernel_launch: hipFuncSetAttribute failed\n"); grid = -1; return; }
        if (hipOccupancyMaxActiveBlocksPerMultiprocessor(&per_cu, (const void*)mega_fwd, NWAVES * 64, LDS_BYTES) != hipSuccess || per_cu < 1)
            fprintf(stderr, "kernel_launch: occupancy query reports %d\n", per_cu);
        (void)hipGetLastError();
        grid = cus;
    }
    if (grid < 0) return;
    if (hipMemsetAsync((char*)d_ws + WS_CTL, 0, CTL_ZERO_BYTES, stream) != hipSuccess) return;
    Args a{};
    for (int i = 0; i < N_IN; ++i) a.in[i] = d_in[i];
    a.out = (float*)d_out; a.ws = (unsigned char*)d_ws;
    hipLaunchKernelGGL(mega_fwd, dim3(grid), dim3(NWAVES * 64), LDS_BYTES, stream, a);
}
```

```cpp
#include <hip/hip_runtime.h>
#include <cstdio>
#include <cstdint>
namespace pg8 {
#define PG8_LAS __attribute__((address_space(3)))
typedef unsigned short bf16_t;
typedef short bf16x8 __attribute__((ext_vector_type(8)));
typedef float f32x4 __attribute__((ext_vector_type(4)));
typedef unsigned u32x4 __attribute__((ext_vector_type(4)));
constexpr int BM = 256, BK = 64, HALF = 128, HTB = HALF * BK * 2  , STAGE_BYTES = 8 * HTB, NXCD = 8, WGM = 8;

__host__ __device__ __forceinline__ int lds_byte(int r, int c) { const int st = (r >> 4) * 2 + (c >> 5), rr = r & 15, cc = c & 31, ob = rr * 64 + cc * 2; return st * 1024 + (ob ^ (((ob >> 9) & 1) << 5)); }
__host__ __device__ __forceinline__ void stage_rc(int b, int& R, int& C) { const int st = b / 1024, sb = b % 1024, swz = sb ^ (((sb >> 9) & 1) << 5); R = (st >> 1) * 16 + swz / 64; C = (st & 1) * 32 + (swz % 64) / 2; }
__host__ __device__ __forceinline__ int perm32(int rho) { const int n = rho >> 4, i = rho & 15; return 8 * (i >> 2) + 4 * n + (i & 3); }

struct Unit { int pm, pn; };
struct Gemm { const bf16_t* A; const bf16_t* Bt; int M, N, K; };

struct StaticOrder {
    int nM, nN, nwg, G, c;
    __host__ __device__ void init(int M, int N, int G_, int c_) { nM = M / BM; nN = N / BM; nwg = nM * nN; G = G_; c = c_; }
    __host__ __device__ __forceinline__ bool next(int i, Unit& u) const {
        const long L = (long)i * G + c; if (L >= nwg) return false;
        int wgid = (int)L; { const int q = nwg / NXCD, r = nwg % NXCD, xcd = wgid % NXCD, off = wgid / NXCD; wgid = (xcd < r ? xcd * (q + 1) : r * (q + 1) + (xcd - r) * q) + off; }
        const int nig = WGM * nN, gid = wgid / nig, fm = gid * WGM, gsz = (nM - fm) < WGM ? (nM - fm) : WGM;
        u.pm = fm + ((wgid % nig) % gsz); u.pn = (wgid % nig) / gsz; return true;
    }
    __device__ __forceinline__ void a_ready(const Unit&) const {}
    __device__ __forceinline__ void done(const Unit&) const {}
};

__device__ __forceinline__ unsigned cvt_pk_bf16(float lo, float hi) { unsigned r; asm volatile("v_cvt_pk_bf16_f32 %0, %1, %2" : "=v"(r) : "v"(lo), "v"(hi)); return r; }
typedef float f32x2 __attribute__((ext_vector_type(2)));
template <class Epi, class Sched, bool ALIGN_EPI = false, bool SP2 = false>
__device__ __forceinline__ void gemm_phase(PG8_LAS unsigned char* lds, const Gemm g, const Sched& S, const Epi& E, const int tid_in  ) {
    const int tid = tid_in, wid = __builtin_amdgcn_readfirstlane(tid >> 6), lane = tid & 63, wr = wid >> 2, wc = wid & 3, fr = lane & 15, fq = lane >> 4;
    const int K = g.K, nt = K / BK;
    unsigned voffA[2], voffB[2];
#pragma unroll
    for (int i = 0; i < 2; ++i) { int R, C; stage_rc(tid * 16 + i * 8192, R, C); const int Rb = Epi::PERM ? ((R & ~31) + perm32(R & 31)) : R;
        voffA[i] = (unsigned)(R * K + C) * 2u; voffB[i] = (unsigned)(Rb * K + C) * 2u; }
    const size_t kstep = (size_t)(BK * 2);
    const size_t hstep = (size_t)HALF * K * 2;
    const size_t tstep = 2 * hstep;
    const unsigned ldsw = (unsigned)wid * 1024u;
    const int aoff = lds_byte(wr * 64 + fr, fq * 8), boff = lds_byte(wc * 32 + fr, fq * 8);
#define PG8_SA(b, h) (((b) * 2 + (h)) * HTB)
#define PG8_SB(b, h) ((4 + (b) * 2 + (h)) * HTB)
#define PG8_STAGE(bufoff, gbase, voff) do { _Pragma("unroll") for (int _i = 0; _i < 2; ++_i) \
        __builtin_amdgcn_global_load_lds((const unsigned*)((const char*)(gbase) + (voff)[_i]), (PG8_LAS unsigned*)(lds + (bufoff) + ldsw + _i * 8192), 16, 0, 0); } while (0)
#define PG8_LDA(dst, b, h) do { _Pragma("unroll") for (int m = 0; m < 4; ++m) _Pragma("unroll") for (int k = 0; k < 2; ++k) dst[m][k] = *(const PG8_LAS bf16x8*)(lds + PG8_SA(b, h) + aoff + m * 2048 + k * 1024); } while (0)
#define PG8_LDB(dst, b, h) do { _Pragma("unroll") for (int n = 0; n < 2; ++n) _Pragma("unroll") for (int k = 0; k < 2; ++k) dst[n][k] = *(const PG8_LAS bf16x8*)(lds + PG8_SB(b, h) + boff + n * 2048 + k * 1024); } while (0)
#define PG8_MMA(ai, bj, At, Bt) do { __builtin_amdgcn_s_setprio(1); _Pragma("unroll") for (int m = 0; m < 4; ++m) _Pragma("unroll") for (int n = 0; n < 2; ++n) _Pragma("unroll") for (int k = 0; k < 2; ++k) \
        acc[ai][bj][m][n] = __builtin_amdgcn_mfma_f32_16x16x32_bf16(Bt[n][k], At[m][k], acc[ai][bj][m][n], 0, 0, 0); __builtin_amdgcn_s_setprio(0); } while (0)
#define PG8_WAIT_V(n) asm volatile("s_waitcnt vmcnt(" #n ")" ::: "memory")
#define PG8_WAIT_L(n) asm volatile("s_waitcnt lgkmcnt(" #n ")" ::: "memory")
#define PG8_BAR __builtin_amdgcn_s_barrier()
#define PG8_SCHED __builtin_amdgcn_sched_barrier(0)
    Unit cur, nxt; int ui = 0;
    if (!S.next(0, cur)) return;
    f32x4 acc[2][2][4][2];
#pragma unroll
    for (int a = 0; a < 2; ++a)
#pragma unroll
        for (int b = 0; b < 2; ++b)
#pragma unroll
            for (int m = 0; m < 4; ++m)
#pragma unroll
                for (int n = 0; n < 2; ++n) acc[a][b][m][n] = (f32x4){0.f, 0.f, 0.f, 0.f};
    bf16x8 At[4][2], B0[2][2], B1[2][2];
    const char* cA = (const char*)g.A + (size_t)cur.pm * tstep; const char* cB = (const char*)g.Bt + (size_t)cur.pn * tstep;
    S.a_ready(cur);
    if constexpr (SP2) {
        PG8_STAGE(PG8_SB(0, 0), cB, voffB); PG8_STAGE(PG8_SB(0, 1), cB + hstep, voffB); PG8_STAGE(PG8_SA(0, 0), cA, voffA); PG8_STAGE(PG8_SA(0, 1), cA + hstep, voffA);
        if (wr == 1) PG8_BAR;
        PG8_WAIT_V(2); PG8_BAR;
        PG8_STAGE(PG8_SB(1, 0), cB + kstep, voffB); PG8_STAGE(PG8_SA(1, 0), cA + kstep, voffA); PG8_STAGE(PG8_SB(1, 1), cB + hstep + kstep, voffB);
        PG8_WAIT_V(6); PG8_BAR;
    } else {
        PG8_STAGE(PG8_SB(0, 0), cB, voffB); PG8_STAGE(PG8_SA(0, 0), cA, voffA); PG8_STAGE(PG8_SB(0, 1), cB + hstep, voffB); PG8_STAGE(PG8_SA(0, 1), cA + hstep, voffA);
        if (wr == 1) PG8_BAR;
        PG8_WAIT_V(4); PG8_BAR;
        PG8_STAGE(PG8_SB(1, 0), cB + kstep, voffB); PG8_STAGE(PG8_SA(1, 0), cA + kstep, voffA); PG8_STAGE(PG8_SB(1, 1), cB + hstep + kstep, voffB);
        PG8_WAIT_V(6); PG8_BAR;
    }
    for (;;) {
        const bool has_next = S.next(ui + 1, nxt);
        const char* nA = has_next ? (const char*)g.A + (size_t)nxt.pm * tstep : cA; const char* nB = has_next ? (const char*)g.Bt + (size_t)nxt.pn * tstep : cB;
        for (int t = 0; t < nt; t += 2) {
            if constexpr (Epi::GROUPS) { if (t == 0) { } else if ((t & 3) == 0 && t < Epi::HOOK_T) E.hookg(acc, t >> 2, wr, fr); }
            if constexpr (Epi::HOOK_T > 0) { if (t == Epi::HOOK_T) E.hook(acc, cur, wr, wc, fr, fq); }
            const bool last = (t == nt - 2);
            const char* a1 = cA + (size_t)(t + 1) * kstep;
            const char* a2 = last ? nA : cA + (size_t)(t + 2) * kstep; const char* b2 = last ? nB : cB + (size_t)(t + 2) * kstep;
            const char* a3 = a2 + kstep; const char* b3 = b2 + kstep;
            if (last && has_next) S.a_ready(nxt);
            if constexpr (SP2) {
            PG8_LDB(B0, 0, 0); PG8_LDB(B1, 0, 1); PG8_SCHED; PG8_LDA(At, 0, 0); PG8_STAGE(PG8_SA(1, 1), a1 + hstep, voffA);
            PG8_WAIT_V(8); PG8_WAIT_L(0); PG8_BAR; PG8_MMA(0, 0, At, B0); PG8_MMA(0, 1, At, B1); PG8_BAR; PG8_SCHED;
            PG8_LDA(At, 0, 1); PG8_STAGE(PG8_SB(0, 0), b2, voffB); PG8_STAGE(PG8_SB(0, 1), b2 + hstep, voffB); PG8_STAGE(PG8_SA(0, 0), a2, voffA);
            PG8_WAIT_V(8); PG8_WAIT_L(0); PG8_BAR; PG8_MMA(1, 0, At, B0); PG8_MMA(1, 1, At, B1); PG8_BAR; PG8_SCHED;
            PG8_LDB(B0, 1, 0); PG8_LDB(B1, 1, 1); PG8_SCHED; PG8_LDA(At, 1, 0); PG8_STAGE(PG8_SA(0, 1), a2 + hstep, voffA);
            PG8_WAIT_V(8); PG8_WAIT_L(0); PG8_BAR; PG8_MMA(0, 0, At, B0); PG8_MMA(0, 1, At, B1); PG8_BAR; PG8_SCHED;
            PG8_LDA(At, 1, 1); PG8_STAGE(PG8_SB(1, 0), b3, voffB); PG8_STAGE(PG8_SB(1, 1), b3 + hstep, voffB); PG8_STAGE(PG8_SA(1, 0), a3, voffA);
            PG8_WAIT_V(8); PG8_WAIT_L(0); PG8_BAR; PG8_MMA(1, 0, At, B0); PG8_MMA(1, 1, At, B1); PG8_BAR; PG8_SCHED;
            } else {
            PG8_LDB(B0, 0, 0); PG8_SCHED; PG8_LDA(At, 0, 0); PG8_STAGE(PG8_SA(1, 1), a1 + hstep, voffA);
            PG8_WAIT_L(8); PG8_BAR; PG8_WAIT_L(0); PG8_MMA(0, 0, At, B0); PG8_BAR; PG8_SCHED;
            PG8_LDB(B1, 0, 1); PG8_STAGE(PG8_SB(0, 0), b2, voffB);
            PG8_BAR; PG8_WAIT_L(0); PG8_MMA(0, 1, At, B1); PG8_BAR;
            PG8_LDA(At, 0, 1); PG8_STAGE(PG8_SA(0, 0), a2, voffA);
            PG8_BAR; PG8_WAIT_L(0); PG8_MMA(1, 0, At, B0); PG8_BAR; PG8_SCHED;
            PG8_STAGE(PG8_SB(0, 1), b2 + hstep, voffB);
            PG8_WAIT_V(6); PG8_BAR; PG8_MMA(1, 1, At, B1); PG8_BAR;
            PG8_LDB(B0, 1, 0); PG8_SCHED; PG8_LDA(At, 1, 0); PG8_STAGE(PG8_SA(0, 1), a2 + hstep, voffA);
            PG8_WAIT_L(8); PG8_BAR; PG8_WAIT_L(0); PG8_MMA(0, 0, At, B0); PG8_BAR; PG8_SCHED;
            PG8_LDB(B1, 1, 1); PG8_STAGE(PG8_SB(1, 0), b3, voffB);
            PG8_BAR; PG8_WAIT_L(0); PG8_MMA(0, 1, At, B1); PG8_BAR;
            PG8_LDA(At, 1, 1); PG8_STAGE(PG8_SA(1, 0), a3, voffA);
            PG8_BAR; PG8_WAIT_L(0); PG8_MMA(1, 0, At, B0); PG8_BAR; PG8_SCHED;
            PG8_STAGE(PG8_SB(1, 1), b3 + hstep, voffB);
            PG8_WAIT_V(6); PG8_BAR; PG8_MMA(1, 1, At, B1); PG8_BAR;
            }
        }
        if constexpr (ALIGN_EPI) { if (wr == 0) PG8_BAR; }
        if constexpr (!Epi::AFTER_DRAIN) { E(acc, cur, wr, wc, fr, fq); S.done(cur); }
        if (!has_next) break;
#pragma unroll
        for (int a = 0; a < 2; ++a)
#pragma unroll
            for (int b = 0; b < 2; ++b)
#pragma unroll
                for (int m = 0; m < 4; ++m)
#pragma unroll
                    for (int n = 0; n < 2; ++n) acc[a][b][m][n] = (f32x4){0.f, 0.f, 0.f, 0.f};
        cur = nxt; cA = nA; cB = nB; ++ui;
        if constexpr (ALIGN_EPI) { if (wr == 1) PG8_BAR; }
    }
    PG8_WAIT_V(0);
    if constexpr (!ALIGN_EPI) { if (wr == 0) PG8_BAR; }
    PG8_BAR;
    if constexpr (Epi::AFTER_DRAIN) { E.fused(acc, cur, wr, wc, fr, fq, lds, wid, lane); S.done(cur); }
#undef PG8_SA
#undef PG8_SB
#undef PG8_STAGE
#undef PG8_LDA
#undef PG8_LDB
#undef PG8_MMA
#undef PG8_WAIT_V
#undef PG8_WAIT_L
#undef PG8_BAR
#undef PG8_SCHED
}
}
#define GAS __attribute__((address_space(1)))
#define LAS __attribute__((address_space(3)))
typedef unsigned short bf16;
typedef unsigned v4u __attribute__((ext_vector_type(4)));
typedef float f32x4 __attribute__((ext_vector_type(4)));
typedef short bf16x8 __attribute__((ext_vector_type(8)));
typedef GAS unsigned gu32;
typedef GAS unsigned long long gu64;
#define RLX_AGENT __ATOMIC_RELAXED, __HIP_MEMORY_SCOPE_AGENT
#define LDS_WAIT() asm volatile("s_waitcnt lgkmcnt(0)" ::: "memory")
#define VM_WAIT() asm volatile("s_waitcnt vmcnt(0)" ::: "memory")
__device__ __forceinline__ unsigned long long rt() { return __builtin_amdgcn_s_memrealtime(); }
typedef float f32x2_cv __attribute__((ext_vector_type(2))); typedef __bf16 bf16x2_cv __attribute__((ext_vector_type(2)));
__device__ __forceinline__ unsigned pk2(float lo, float hi) { const f32x2_cv v = {lo, hi}; const bf16x2_cv b = __builtin_convertvector(v, bf16x2_cv); return __builtin_bit_cast(unsigned, b); }
__device__ __forceinline__ unsigned f2bf(float f) { return pk2(f, 0.f) & 0xffffu; }

#define XB_TMO      128
#define XB_XCNT(j)  (256  + 64 * (j))
#define XB_XSUB(j)  (1280 + 64 * (j))
#define XB_XGEN(j)  (2304 + 64 * (j))
#define XB_TOP      3328
#define XB_TOPGEN   3392
#define XCD_BAR_WORDS 3456
#define XB_SPIN_CAP (1u << 18)

__device__ __forceinline__ unsigned xb_ld(unsigned* p)              { return __hip_atomic_load(p, __ATOMIC_RELAXED, __HIP_MEMORY_SCOPE_AGENT); }
__device__ __forceinline__ unsigned xb_add(unsigned* p, unsigned v) { return __hip_atomic_fetch_add(p, v, __ATOMIC_RELAXED, __HIP_MEMORY_SCOPE_AGENT); }
__device__ __forceinline__ unsigned xb_xcc_id() { return (unsigned)__builtin_amdgcn_s_getreg((3 << 11) | 20) & 0xFu; }
#define XB_SPIN(cond, bar) do { unsigned _sp = 0; while (cond) { __builtin_amdgcn_s_sleep(1); \
    if ((++_sp & 255u) == 0u) { if (xb_ld(&(bar)[XB_TMO])) break; if (_sp > XB_SPIN_CAP) { atomicAdd(&(bar)[XB_TMO], 1u); break; } } } } while (0)

struct XcdBarrier {
    unsigned* bar; unsigned x;
    volatile LAS unsigned* st;
};

__device__ __forceinline__ XcdBarrier xcd_barrier_post(unsigned* bar, volatile LAS unsigned* st) {
    XcdBarrier b; b.bar = bar; b.x = xb_xcc_id(); b.st = st;
    if (threadIdx.x == 0) (void)xb_add(&bar[XB_XCNT(b.x)], 1u);
    return b;
}
__device__ __forceinline__ void xcd_barrier_complete(unsigned* bar, unsigned x, unsigned& nloc, unsigned& nx) {
    const unsigned G = gridDim.x * gridDim.y * gridDim.z;
    unsigned sum, cnt, mine, sp = 0u;
    for (;;) {
        sum = 0u; cnt = 0u; mine = 0u;
#pragma unroll
        for (unsigned j = 0; j < 16; ++j) { const unsigned c = xb_ld(&bar[XB_XCNT(j)]); sum += c; cnt += (c > 0u) ? 1u : 0u; mine = (j == x) ? c : mine; }
        if (sum == G) break;
        __builtin_amdgcn_s_sleep(1);
        if ((++sp & 255u) == 0u) { if (xb_ld(&bar[XB_TMO])) break; if (sp > XB_SPIN_CAP) { atomicAdd(&bar[XB_TMO], 1u); break; } }
    }
    nloc = mine > 0u ? mine : 1u; nx = cnt > 0u ? cnt : 1u;
}

__device__ __forceinline__ void xcd_barrier(const XcdBarrier& b, bool leader  ) {
    asm volatile("s_waitcnt vmcnt(0)" ::: "memory");
    __syncthreads();
    if (leader) {
        unsigned* bar = b.bar;
        __builtin_amdgcn_s_waitcnt(0);
        unsigned nloc = b.st[0], nx = b.st[1];
        if (nloc == 0u) { xcd_barrier_complete(bar, b.x, nloc, nx); b.st[0] = nloc; b.st[1] = nx; }
        const unsigned old = xb_add(&bar[XB_XSUB(b.x)], 1u);
        const unsigned gen = old / nloc;
        if (old + 1u == (gen + 1u) * nloc) {
            __builtin_amdgcn_fence(__ATOMIC_RELEASE, "agent");
            asm volatile("s_waitcnt vmcnt(0)" ::: "memory");
            const unsigned og = xb_add(&bar[XB_TOP], 1u);
            const unsigned tg = og / nx;
            if (og + 1u == (tg + 1u) * nx) xb_add(&bar[XB_TOPGEN], 1u);
            else XB_SPIN(xb_ld(&bar[XB_TOPGEN]) == tg, bar);
            __builtin_amdgcn_fence(__ATOMIC_ACQUIRE, "agent");
            xb_add(&bar[XB_XGEN(b.x)], 1u);
            asm volatile("s_waitcnt vmcnt(0)" ::: "memory");
        } else {
            XB_SPIN(xb_ld(&bar[XB_XGEN(b.x)]) == gen, bar);
            __builtin_amdgcn_fence(__ATOMIC_ACQUIRE, "agent");
            asm volatile("s_waitcnt vmcnt(0)" ::: "memory");
        }
    }
    __syncthreads();
}

constexpr int DM = 1024, NB = 8, SEQ = 2048, DECB = 32, DECS = 4, PAST = 16384, PAGE = 128, NPAGE = 128;
constexpr int MP = NB * SEQ;
constexpr int MS = DECB * DECS;
constexpr int MR = MP + MS;
constexpr int MT = 16640;
constexpr int FF = 2816, NGU = 2 * FF, NINP = 10496;
constexpr float EPS = 1e-6f;
constexpr int NWAVES = 8;

enum { I_XP = 0, I_XS, I_MEMP, I_CK, I_CV, I_CKI, I_SSM, I_CONV, I_CMK, I_CMV, I_PT,
       I_F1PRE, I_F1WG, I_F1WU, I_F1WD, I_F1POST, I_MIXPRE, I_WIN, I_CONVW, I_CONVB, I_DTB, I_ALOG, I_DSKIP, I_SSDG,
       I_WBRS, I_WBRA, I_WOUT, I_MIXPOST, I_MEMPRE, I_MEMKVG, I_WMQ, I_WMK, I_WMV, I_WMO, I_MEMPOST,
       I_F2PRE, I_F2WG, I_F2WU, I_F2WD, I_F2POST, N_IN };

constexpr size_t O_YP = 0;
constexpr size_t O_YS = O_YP + (size_t)MP * DM;
constexpr size_t O_KP = O_YS + (size_t)MS * DM;
constexpr size_t O_VP = O_KP + (size_t)MP * 256;
constexpr size_t O_KIP = O_VP + (size_t)MP * 256;
constexpr size_t O_SSMP = O_KIP + (size_t)MP * 64;
constexpr size_t O_CONVP = O_SSMP + (size_t)NB * 32 * 64 * 128;
constexpr size_t O_MKP = O_CONVP + (size_t)NB * 3 * 4096;
constexpr size_t O_MVP = O_MKP + (size_t)NB * 256 * 1024;
constexpr size_t O_KS = O_MVP + (size_t)NB * 256 * 1024;
constexpr size_t O_VS = O_KS + (size_t)MS * 256;
constexpr size_t O_KIS = O_VS + (size_t)MS * 256;
constexpr size_t O_SSMS = O_KIS + (size_t)MS * 64;
constexpr size_t O_CONVS = O_SSMS + (size_t)DECB * 32 * 64 * 128;
constexpr size_t O_END = O_CONVS + (size_t)DECB * 3 * 4096;
static_assert(O_END == 41590784, "output size");

constexpr size_t MiB = 1u << 20;
constexpr size_t al(size_t x) { return (x + MiB - 1) / MiB * MiB; }
constexpr size_t WS_CTL = 0, CTL_ZERO_BYTES = 1 * MiB;
constexpr size_t WS_WGU1 = 1 * MiB;
constexpr size_t WS_WD1 = WS_WGU1 + al((size_t)NGU * DM * 2);
constexpr size_t WS_WIN = WS_WD1 + al((size_t)DM * FF * 2);
constexpr size_t WS_WBRS = WS_WIN + al((size_t)NINP * DM * 2);
constexpr size_t WS_WBRA = WS_WBRS + al((size_t)DM * 3072 * 2);
constexpr size_t WS_WOUT = WS_WBRA + al((size_t)DM * DM * 2);
constexpr size_t WS_WMQ = WS_WOUT + al((size_t)DM * DM * 2);
constexpr size_t WS_WMKV = WS_WMQ + al((size_t)DM * DM * 2);
constexpr size_t WS_WMO = WS_WMKV + al((size_t)2048 * DM * 2);
constexpr size_t WS_WGU2 = WS_WMO + al((size_t)DM * DM * 2);
constexpr size_t WS_WD2 = WS_WGU2 + al((size_t)NGU * DM * 2);
constexpr size_t WS_U = WS_WD2 + al((size_t)DM * FF * 2);
constexpr size_t WS_ACT = WS_U + al((size_t)MT * DM * 2);
constexpr size_t WS_F = WS_ACT + al((size_t)MT * FF * 2);
constexpr size_t WS_Z = WS_F + al((size_t)MT * DM * 4);
constexpr size_t WS_XBC = WS_Z + al((size_t)MT * 2048 * 2);
constexpr size_t WS_Q = WS_XBC + al((size_t)MT * 4096 * 2);
constexpr size_t WS_KB = WS_Q + al((size_t)MT * DM * 2);
constexpr size_t WS_VT = WS_KB + al((size_t)MT * 256 * 2);
constexpr size_t WS_QI = WS_VT + al((size_t)NB * 256 * SEQ * 2);
constexpr size_t WS_GS = WS_QI + al((size_t)MT * 512 * 2);
constexpr size_t WS_GA = WS_GS + al((size_t)MT * DM * 2);
constexpr size_t WS_MISC = WS_GA + al((size_t)MT * DM * 2);
constexpr size_t WS_KIB = WS_MISC + al((size_t)MT * 256 * 4);
constexpr size_t WS_YC = WS_KIB + al((size_t)MT * 64 * 2);
constexpr int YCP = 3072;
constexpr size_t WS_MRG = WS_YC + al((size_t)MT * YCP * 2);
constexpr size_t WS_QM = WS_MRG + al((size_t)MT * DM * 2);
constexpr size_t WS_OM = WS_QM + al((size_t)MT * DM * 2);
constexpr size_t WS_MN = WS_OM + al((size_t)MT * DM * 2);
constexpr size_t WS_MKB = WS_MN + al((size_t)2048 * DM * 2);
constexpr size_t WS_MVT = WS_MKB + al((size_t)40 * 256 * DM * 2);
constexpr size_t WS_SC = WS_MVT + al((size_t)40 * 256 * DM * 2);
constexpr size_t WS_SCS = WS_SC + al((size_t)MP * 2048 * 4);
constexpr size_t WS_MASK = WS_SCS + al((size_t)MS * 16640 * 4);
constexpr size_t WS_SSQ = WS_MASK + al((size_t)MP * 64 * 4);
constexpr size_t WS_XBCA = WS_SSQ + al((size_t)MT * 32 * 4);
constexpr size_t WS_FB = WS_XBCA + al((size_t)MT * 4096 * 2);
constexpr size_t WS_HB = WS_FB + al((size_t)MT * DM * 2);
constexpr size_t WS_DUMMY = WS_HB + al((size_t)MT * DM * 2);
constexpr size_t WS_DUMMY_OLD = WS_XBCA + al((size_t)MT * 4096 * 2);
constexpr size_t WS_END = WS_DUMMY + 1 * MiB;

constexpr int CW_BAR = 4096;
constexpr int CW_Q = 16384;

constexpr int RING_BYTES = 131072;
constexpr int LDSCTL_OFF = RING_BYTES, MISC_OFF = LDSCTL_OFF + 320;
constexpr int LDS_BYTES = 147456;

struct Args { const void* in[N_IN]; float* out; unsigned char* ws; };
typedef const __attribute__((address_space(4))) Args* KArgs;

__device__ __forceinline__ float wave_sum(float v) {
#define WS_DPP_FADD(ctrl, rmask) v += __builtin_bit_cast(float, __builtin_amdgcn_update_dpp(0, __builtin_bit_cast(int, v), ctrl, rmask, 0xf, false))
    WS_DPP_FADD(0x111, 0xf); WS_DPP_FADD(0x112, 0xf); WS_DPP_FADD(0x114, 0xf); WS_DPP_FADD(0x118, 0xf); WS_DPP_FADD(0x142, 0xa); WS_DPP_FADD(0x143, 0xc);
#undef WS_DPP_FADD
    return __builtin_bit_cast(float, __builtin_amdgcn_readlane(__builtin_bit_cast(int, v), 63));
}
__device__ __forceinline__ float silu_f(float x) { return x * __builtin_amdgcn_rcpf(1.0f + __expf(-x)); }
__device__ __forceinline__ float sigmoid_f(float x) { return __builtin_amdgcn_rcpf(1.0f + __expf(-x)); }

__device__ __forceinline__ void tr_item(const float* __restrict__ W, int ldw, int col0, int nvalid, int k0, bf16* WT, int ldt, int drow0, int dk0,
                                        const float* kscale, LAS float* scr, int lane) {
    const int c = lane & 31;
#pragma unroll 8
    for (int i = 0; i < 32; ++i) {
        const int kk = 2 * i + (lane >> 5);
        float v = (c < nvalid) ? W[(size_t)(k0 + kk) * ldw + col0 + c] : 0.f;
        if (kscale) v *= kscale[k0 + kk];
        scr[kk * 33 + c] = v;
    }
    LDS_WAIT(); asm volatile("" ::: "memory");
    const int c8 = lane & 7;
#pragma unroll
    for (int j = 0; j < 4; ++j) {
        const int n = (lane >> 3) + 8 * j; const LAS float* s = scr + (8 * c8) * 33 + n;
        v4u o; o.x = pk2(s[0 * 33], s[1 * 33]); o.y = pk2(s[2 * 33], s[3 * 33]); o.z = pk2(s[4 * 33], s[5 * 33]); o.w = pk2(s[6 * 33], s[7 * 33]);
        *(GAS v4u*)(WT + (size_t)(drow0 + n) * ldt + dk0 + k0 + 8 * c8) = o;
    }
    LDS_WAIT(); asm volatile("" ::: "memory");
}

__device__ __forceinline__ void rms_row_bf16(const float* xrow, const float* g, bf16* orow, int lane) {
    const GAS f32x4* xr = (const GAS f32x4*)xrow + lane; const GAS f32x4* gr = (const GAS f32x4*)g + lane;
    f32x4 v[4]; float s = 0.f;
#pragma unroll
    for (int j = 0; j < 4; ++j) { v[j] = xr[64 * j]; s += (v[j].x * v[j].x + v[j].y * v[j].y) + (v[j].z * v[j].z + v[j].w * v[j].w); }
    const float rs = 1.0f / sqrtf(wave_sum(s) * (1.0f / DM) + EPS);
    GAS unsigned long long* o8 = (GAS unsigned long long*)orow + lane;
#pragma unroll
    for (int j = 0; j < 4; ++j) { const f32x4 gg = gr[64 * j];
        o8[64 * j] = (unsigned long long)pk2(v[j].x * rs * gg.x, v[j].y * rs * gg.y) | ((unsigned long long)pk2(v[j].z * rs * gg.z, v[j].w * rs * gg.w) << 32); }
}
__device__ __forceinline__ void cvt_row_bf16(const float* xrow, bf16* orow, int lane) {
    const GAS f32x4* xr = (const GAS f32x4*)xrow + lane; GAS unsigned long long* o8 = (GAS unsigned long long*)orow + lane;
#pragma unroll
    for (int j = 0; j < 4; ++j) { const f32x4 v = xr[64 * j]; o8[64 * j] = (unsigned long long)pk2(v.x, v.y) | ((unsigned long long)pk2(v.z, v.w) << 32); }
}
__device__ __forceinline__ void post_norm_row(const float* hin, const float* frow, const float* post_g, float rscale, float* hout, const float* pre_g, bf16* urow, int lane) {
    const GAS f32x4* fr = (const GAS f32x4*)frow + lane; const GAS f32x4* hr = (const GAS f32x4*)hin + lane; const GAS f32x4* pg = (const GAS f32x4*)post_g + lane;
    f32x4 f[4], h[4]; float s = 0.f;
#pragma unroll
    for (int j = 0; j < 4; ++j) { f[j] = fr[64 * j]; h[j] = hr[64 * j]; s += (f[j].x * f[j].x + f[j].y * f[j].y) + (f[j].z * f[j].z + f[j].w * f[j].w); }
    const float rs = rscale / sqrtf(wave_sum(s) * (1.0f / DM) + EPS);
    float s2 = 0.f;
    GAS f32x4* ho = (GAS f32x4*)hout + lane;
#pragma unroll
    for (int j = 0; j < 4; ++j) { const f32x4 gg = pg[64 * j]; h[j] = h[j] + f[j] * rs * gg; ho[64 * j] = h[j];
        s2 += (h[j].x * h[j].x + h[j].y * h[j].y) + (h[j].z * h[j].z + h[j].w * h[j].w); }
    if (pre_g) {
        const float rs2 = 1.0f / sqrtf(wave_sum(s2) * (1.0f / DM) + EPS);
        const GAS f32x4* qg = (const GAS f32x4*)pre_g + lane; GAS unsigned long long* o8 = (GAS unsigned long long*)urow + lane;
#pragma unroll
        for (int j = 0; j < 4; ++j) { const f32x4 gg = qg[64 * j];
            o8[64 * j] = (unsigned long long)pk2(h[j].x * rs2 * gg.x, h[j].y * rs2 * gg.y) | ((unsigned long long)pk2(h[j].z * rs2 * gg.z, h[j].w * rs2 * gg.w) << 32); }
    }
}

typedef unsigned u32x2n __attribute__((ext_vector_type(2)));
__device__ __forceinline__ void pn_load(const float* hin32, const bf16* hin16, const bf16* frow, int lane, f32x4 (&f)[4], f32x4 (&h)[4]) {
    const GAS u32x2n* fr = (const GAS u32x2n*)frow + lane;
#pragma unroll
    for (int j = 0; j < 4; ++j) { const u32x2n w = fr[64 * j];
        f[j] = (f32x4){__uint_as_float(w.x << 16), __uint_as_float(w.x & 0xffff0000u), __uint_as_float(w.y << 16), __uint_as_float(w.y & 0xffff0000u)};
        if (hin32) h[j] = ((const GAS f32x4*)hin32 + lane)[64 * j];
        else { const u32x2n v = ((const GAS u32x2n*)hin16 + lane)[64 * j];
            h[j] = (f32x4){__uint_as_float(v.x << 16), __uint_as_float(v.x & 0xffff0000u), __uint_as_float(v.y << 16), __uint_as_float(v.y & 0xffff0000u)}; } }
}
__device__ __forceinline__ void pn_finish(f32x4 (&f)[4], f32x4 (&h)[4], const float* post_g, float rscale, bf16* hout16, float* hout32, const float* pre_g, bf16* urow, int lane) {
    const GAS f32x4* pg = (const GAS f32x4*)post_g + lane;
    float s = 0.f;
#pragma unroll
    for (int j = 0; j < 4; ++j) s += (f[j].x * f[j].x + f[j].y * f[j].y) + (f[j].z * f[j].z + f[j].w * f[j].w);
    const float rs = rscale / sqrtf(wave_sum(s) * (1.0f / DM) + EPS);
    float s2 = 0.f;
#pragma unroll
    for (int j = 0; j < 4; ++j) { const f32x4 gg = pg[64 * j]; h[j] = h[j] + f[j] * rs * gg;
        if (hout32) ((GAS f32x4*)hout32 + lane)[64 * j] = h[j];
        if (hout16) { u32x2n w; w.x = pk2(h[j].x, h[j].y); w.y = pk2(h[j].z, h[j].w); ((GAS u32x2n*)hout16 + lane)[64 * j] = w; }
        s2 += (h[j].x * h[j].x + h[j].y * h[j].y) + (h[j].z * h[j].z + h[j].w * h[j].w); }
    if (pre_g) {
        const float rs2 = 1.0f / sqrtf(wave_sum(s2) * (1.0f / DM) + EPS);
        const GAS f32x4* qg = (const GAS f32x4*)pre_g + lane; GAS unsigned long long* o8 = (GAS unsigned long long*)urow + lane;
#pragma unroll
        for (int j = 0; j < 4; ++j) { const f32x4 gg = qg[64 * j];
            o8[64 * j] = (unsigned long long)pk2(h[j].x * rs2 * gg.x, h[j].y * rs2 * gg.y) | ((unsigned long long)pk2(h[j].z * rs2 * gg.z, h[j].w * rs2 * gg.w) << 32); }
    }
}

constexpr int IT_GU = 176 * 16, IT_D = 32 * 44, IT_IN = 328 * 16, IT_BRS = 32 * 32, IT_SQ = 32 * 16, IT_MKV = 64 * 16, IT_CMV = DECB * 128;
constexpr int IT_W = 2 * IT_GU + 2 * IT_D + IT_IN + IT_BRS + 4 * IT_SQ + IT_MKV + IT_CMV;
constexpr int IT_ROWS = MT   + NB * 256   + DECB * 256  ;
struct TrDesc { const float* W; bf16* WT; int ldw, col0, nvalid, k0, ldt, drow0, dk, sc; };
__device__ __forceinline__ TrDesc tr_decode(KArgs a, int r) {
    unsigned char* ws = a->ws; TrDesc d; d.nvalid = 32; d.dk = 0; d.sc = 0;
    if (r < IT_GU) { const int db = r >> 4, kb = r & 15, tile = db >> 3, within = db & 7, half = within >> 2, sub = within & 3;
        d.W = (const float*)a->in[half ? I_F1WU : I_F1WG]; d.ldw = FF; d.col0 = 128 * tile + 32 * sub; d.k0 = 64 * kb; d.WT = (bf16*)(ws + WS_WGU1); d.ldt = DM; d.drow0 = 32 * db; return d; }
    r -= IT_GU;
    if (r < IT_GU) { const int db = r >> 4, kb = r & 15, tile = db >> 3, within = db & 7, half = within >> 2, sub = within & 3;
        d.W = (const float*)a->in[half ? I_F2WU : I_F2WG]; d.ldw = FF; d.col0 = 128 * tile + 32 * sub; d.k0 = 64 * kb; d.WT = (bf16*)(ws + WS_WGU2); d.ldt = DM; d.drow0 = 32 * db; return d; }
    r -= IT_GU;
    if (r < IT_D) { const int db = r / 44, kb = r % 44; d.W = (const float*)a->in[I_F1WD]; d.ldw = DM; d.col0 = 32 * db; d.k0 = 64 * kb; d.WT = (bf16*)(ws + WS_WD1); d.ldt = FF; d.drow0 = 32 * db; return d; }
    r -= IT_D;
    if (r < IT_D) { const int db = r / 44, kb = r % 44; d.W = (const float*)a->in[I_F2WD]; d.ldw = DM; d.col0 = 32 * db; d.k0 = 64 * kb; d.WT = (bf16*)(ws + WS_WD2); d.ldt = FF; d.drow0 = 32 * db; return d; }
    r -= IT_D;
    if (r < IT_IN) {
        const int db = r >> 4, kb = r & 15, dd = 32 * db; int col, nv = 32;
        if (dd < 6144) col = dd;
        else if (dd < 8192) col = dd + 32;
        else if (dd < 10240) col = dd + 104;
        else if (dd < 10272) col = dd - 10240 + 6144;
        else if (dd < 10336) col = dd - 10272 + 8224;
        else if (dd < 10368) { col = 8288; nv = 8; }
        else { col = 0; nv = 0; }
        d.W = (const float*)a->in[I_WIN]; d.ldw = 10344; d.col0 = col; d.nvalid = nv; d.k0 = 64 * kb; d.WT = (bf16*)(ws + WS_WIN); d.ldt = DM; d.drow0 = dd; return d; }
    r -= IT_IN;
    if (r < IT_BRS) { const int db = r >> 5, kb = r & 31; d.W = (const float*)a->in[I_WBRS]; d.ldw = DM; d.col0 = 32 * db; d.k0 = 64 * kb; d.WT = (bf16*)(ws + WS_WBRS); d.ldt = 3072; d.drow0 = 32 * db; d.sc = 1; return d; }
    r -= IT_BRS;
    if (r < 4 * IT_SQ) { const int w = r / IT_SQ, q = r % IT_SQ, db = q >> 4, kb = q & 15;
        d.W = (const float*)a->in[w == 0 ? I_WBRA : w == 1 ? I_WOUT : w == 2 ? I_WMQ : I_WMO];
        d.WT = (bf16*)(ws + (w == 0 ? WS_WBRS : w == 1 ? WS_WOUT : w == 2 ? WS_WMQ : WS_WMO)); d.ldw = DM; d.col0 = 32 * db; d.k0 = 64 * kb; d.ldt = w == 0 ? 3072 : DM; d.dk = w == 0 ? 2048 : 0; d.drow0 = 32 * db; return d; }
    r -= 4 * IT_SQ;
    if (r < IT_MKV) { const int db = r >> 4, kb = r & 15; d.W = (const float*)a->in[db < 32 ? I_WMK : I_WMV]; d.ldw = DM; d.col0 = 32 * (db & 31); d.k0 = 64 * kb; d.WT = (bf16*)(ws + WS_WMKV); d.ldt = DM; d.drow0 = 32 * db; return d; }
    r -= IT_MKV;
    { const int b = r >> 7, q = r & 127, db = q >> 2, kb = q & 3;
      d.W = (const float*)a->in[I_CMV] + (size_t)b * 256 * DM; d.ldw = DM; d.col0 = 32 * db; d.k0 = 64 * kb; d.WT = (bf16*)(ws + WS_MVT) + (size_t)(NB + b) * DM * 256; d.ldt = 256; d.drow0 = 32 * db; return d; }
}
__device__ __forceinline__ void tr_load(const TrDesc& d, const float* ksc, int lane, float (&v)[32], f32x4 (&gk)[2]) {
    const int c = lane & 31, ce = c < d.nvalid ? c : 0;
    const float* p = d.W + (size_t)(d.k0 + (lane >> 5)) * d.ldw + d.col0 + ce;
#pragma unroll
    for (int i = 0; i < 32; ++i) v[i] = p[(size_t)(2 * i) * d.ldw];
    const float* gp = ksc + (d.sc ? d.k0 : 0) + 8 * (lane & 7);
    gk[0] = *(const f32x4*)gp; gk[1] = *(const f32x4*)(gp + 4);
}
__device__ __forceinline__ void tr_store(const TrDesc& d, int lane, const float (&v)[32], const f32x4 (&gkin)[2], LAS float* scr) {
    f32x4 gk[2] = {gkin[0], gkin[1]};
    if (!d.sc) { gk[0] = (f32x4){1.f, 1.f, 1.f, 1.f}; gk[1] = (f32x4){1.f, 1.f, 1.f, 1.f}; }
    const int c = lane & 31; const bool ok = c < d.nvalid;
#pragma unroll
    for (int i = 0; i < 32; ++i) scr[(2 * i + (lane >> 5)) * 33 + c] = ok ? v[i] : 0.f;
    LDS_WAIT(); asm volatile("" ::: "memory");
    const int c8 = lane & 7;
#pragma unroll
    for (int j = 0; j < 4; ++j) {
        const int n = (lane >> 3) + 8 * j; const LAS float* s = scr + (8 * c8) * 33 + n;
        v4u o; o.x = pk2(s[0 * 33] * gk[0].x, s[1 * 33] * gk[0].y); o.y = pk2(s[2 * 33] * gk[0].z, s[3 * 33] * gk[0].w); o.z = pk2(s[4 * 33] * gk[1].x, s[5 * 33] * gk[1].y); o.w = pk2(s[6 * 33] * gk[1].z, s[7 * 33] * gk[1].w);
        *(GAS v4u*)(d.WT + (size_t)(d.drow0 + n) * d.ldt + d.dk + d.k0 + 8 * c8) = o;
    }
    LDS_WAIT(); asm volatile("" ::: "memory");
}
__device__ __forceinline__ void row_src(KArgs a, int r, const float*& src, const float*& g, bf16*& dst, int& kind) {
    unsigned char* ws = a->ws;
    if (r < MT) { const int rr = r < MR ? r : MR - 1; src = rr < MP ? (const float*)a->in[I_XP] + (size_t)rr * DM : (const float*)a->in[I_XS] + (size_t)(rr - MP) * DM;
        g = (const float*)a->in[I_F1PRE]; dst = (bf16*)(ws + WS_U) + (size_t)r * DM; kind = r < MR ? 0 : 2; return; }
    r -= MT;
    if (r < NB * 256) { src = (const float*)a->in[I_MEMP] + (size_t)r * DM; g = (const float*)a->in[I_MEMKVG]; dst = (bf16*)(ws + WS_MN) + (size_t)r * DM; kind = 0; return; }
    r -= NB * 256;
    src = (const float*)a->in[I_CMK] + (size_t)r * DM; g = (const float*)a->in[I_F1PRE]; dst = (bf16*)(ws + WS_MKB) + (size_t)(NB * 256 + r) * DM; kind = 1;
}
__device__ __forceinline__ void row_finish(const f32x4 (&v)[4], const float* g, bf16* dst, int kind, int lane) {
    float s = 0.f;
#pragma unroll
    for (int j = 0; j < 4; ++j) s += (v[j].x * v[j].x + v[j].y * v[j].y) + (v[j].z * v[j].z + v[j].w * v[j].w);
    const float rs = kind == 0 ? 1.0f / sqrtf(wave_sum(s) * (1.0f / DM) + EPS) : (kind == 1 ? 1.0f : 0.0f);
    const GAS f32x4* gr = (const GAS f32x4*)g + lane; GAS unsigned long long* o8 = (GAS unsigned long long*)dst + lane;
#pragma unroll
    for (int j = 0; j < 4; ++j) { f32x4 gg = gr[64 * j]; if (kind != 0) gg = (f32x4){1.f, 1.f, 1.f, 1.f};
        o8[64 * j] = (unsigned long long)pk2(v[j].x * rs * gg.x, v[j].y * rs * gg.y) | ((unsigned long long)pk2(v[j].z * rs * gg.z, v[j].w * rs * gg.w) << 32); }
}
constexpr int TR_GU2 = IT_GU, TR_D1 = 2 * IT_GU, TR_D2 = TR_D1 + IT_D, TR_IN = TR_D2 + IT_D, TR_BRS = TR_IN + IT_IN, TR_MKV = TR_BRS + IT_BRS + 4 * IT_SQ, TR_CMV = TR_MKV + IT_MKV;
struct TrSet { int n0, lo0, n1, lo1, n2, lo2, n3, lo3; };
__device__ __forceinline__ int tr_map(const TrSet& s, int v) {
    if (v < s.n0) return s.lo0 + v;
    v -= s.n0; if (v < s.n1) return s.lo1 + v;
    v -= s.n1; if (v < s.n2) return s.lo2 + v;
    return s.lo3 + (v - s.n2);
}
__device__ __forceinline__ void tr_run(KArgs a, LAS float* scr, int lane, int first, int stride, const TrSet& s) {
    const int total = s.n0 + s.n1 + s.n2 + s.n3;
    if (first < total) {
        const float* ksc = (const float*)a->in[I_SSDG];
        TrDesc dc = tr_decode(a, tr_map(s, first)); float vc[32]; f32x4 gc[2]; tr_load(dc, ksc, lane, vc, gc);
        for (int it = first; it < total; it += stride) {
            const int nit = it + stride < total ? it + stride : it;
            const TrDesc dn = tr_decode(a, tr_map(s, nit)); float vn[32]; f32x4 gn[2]; tr_load(dn, ksc, lane, vn, gn);
            tr_store(dc, lane, vc, gc, scr);
            dc = dn; gc[0] = gn[0]; gc[1] = gn[1];
#pragma unroll
            for (int i = 0; i < 32; ++i) vc[i] = vn[i];
        }
    }
}
__device__ __forceinline__ void tr_tail(KArgs a, LAS unsigned char* lds, int wave, int lane, int thr, int G, const TrSet& s) {
    const int c = (int)blockIdx.x;
    if (c < thr) return;
    tr_run(a, (LAS float*)(lds + wave * 16384), lane, (c - thr) * NWAVES + wave, (G - thr) * NWAVES, s);
}
__device__ __forceinline__ void rows_run(KArgs a, int lane, int first, int stride, int lo, int hi) {
    for (int r = lo + first; r < hi; r += 2 * stride) {
        const int r2 = r + stride < hi ? r + stride : r;
        const float *s0, *g0, *s1, *g1; bf16 *d0, *d1; int k0, k1;
        row_src(a, r, s0, g0, d0, k0); row_src(a, r2, s1, g1, d1, k1);
        f32x4 v0[4], v1[4];
#pragma unroll
        for (int j = 0; j < 4; ++j) { v0[j] = ((const GAS f32x4*)s0 + lane)[64 * j]; v1[j] = ((const GAS f32x4*)s1 + lane)[64 * j]; }
        row_finish(v0, g0, d0, k0, lane);
        if (r2 != r) row_finish(v1, g1, d1, k1, lane);
    }
}
constexpr int ROWS_P0 = MT + NB * 256;
__device__ __forceinline__ void prologue(KArgs a, LAS unsigned char* lds, int wave, int lane, int gw, int NGW) {
    LAS float* scr = (LAS float*)(lds + wave * 16384);
    tr_run(a, scr, lane, gw, NGW, TrSet{IT_GU, 0, IT_D, TR_D1, IT_IN, TR_IN, IT_MKV, TR_MKV});
    rows_run(a, lane, gw, NGW, 0, ROWS_P0);
}

namespace ssd {
typedef short s16x8 __attribute__((ext_vector_type(8)));
typedef float f4 __attribute__((ext_vector_type(4)));
typedef unsigned u2 __attribute__((ext_vector_type(2)));
typedef unsigned u4 __attribute__((ext_vector_type(4)));
constexpr int P_C = 272, P_S = 144;
constexpr int L_CS = 0, L_BS = 17408, L_BST = 34816, L_XT = 53248, L_XWT = 62464, L_HS = 71680, L_MS = 89088, L_DT = 98304, L_ACS = 98560, L_SSQ = 98816, L_WG = 100864, L_END = 101120;
static_assert(L_END <= 131072, "ssd LDS");
__device__ __forceinline__ f4 mfma16(s16x8 a, s16x8 b, f4 c) { return __builtin_amdgcn_mfma_f32_16x16x32_bf16(a, b, c, 0, 0, 0); }
#define SSD_FRAG(off) (*(const LAS s16x8*)(lds + (off)))
#define SSD_LO(w) __uint_as_float((w) << 16)
#define SSD_HI(w) __uint_as_float((w) & 0xffff0000u)
#define SSD_SYNC() asm volatile("s_waitcnt lgkmcnt(0)\n\ts_barrier" ::: "memory")
#ifdef DBG_SSDMARK
#define SSD_MARK(k_) { const unsigned long long now_ = __builtin_amdgcn_s_memtime(); tacc_[k_] += now_ - tmark_; tmark_ = now_; }
#define SSD_MARK_INIT() unsigned long long tmark_ = __builtin_amdgcn_s_memtime(); unsigned long long tacc_[4] = {0ull, 0ull, 0ull, 0ull};
#define SSD_MARK_FLUSH() if (tid_in == 0 && !smp) { for (int k_ = 0; k_ < 4; ++k_) atomicAdd((unsigned*)(a_in->ws + WS_CTL + 768 * 1024) + 16 + k_, (unsigned)(tacc_[k_] >> 4)); }
#else
#define SSD_MARK(k_)
#define SSD_MARK_INIT()
#define SSD_MARK_FLUSH()
#endif

__device__ __forceinline__ int chan_col(int ci, int g, int h) { return ci < 64 ? 256 * g + 64 * h + ci : (ci < 192 ? 2048 + 128 * g + (ci - 64) : 3072 + 128 * g + (ci - 192)); }


__device__ __forceinline__ void conv_rows(int tid, const bf16* __restrict__ XBC, bf16* __restrict__ XA, const float* __restrict__ convw, const float* __restrict__ convb,
                                          int rowstart, int nrows, int seq_t0, const float* __restrict__ halo) {
    const int col = 8 * tid;
    float w[4][8], bb[8], win[3][8];
#pragma unroll
    for (int k = 0; k < 4; ++k) { const f4 a0 = *(const f4*)(convw + k * 4096 + col), a1 = *(const f4*)(convw + k * 4096 + col + 4);
        w[k][0] = a0.x; w[k][1] = a0.y; w[k][2] = a0.z; w[k][3] = a0.w; w[k][4] = a1.x; w[k][5] = a1.y; w[k][6] = a1.z; w[k][7] = a1.w; }
    { const f4 a0 = *(const f4*)(convb + col), a1 = *(const f4*)(convb + col + 4); bb[0] = a0.x; bb[1] = a0.y; bb[2] = a0.z; bb[3] = a0.w; bb[4] = a1.x; bb[5] = a1.y; bb[6] = a1.z; bb[7] = a1.w; }
#pragma unroll
    for (int k = 0; k < 3; ++k) {
        const int t = seq_t0 - 3 + k;
        if (t >= 0) { const u4 v = *(const u4*)(XBC + (size_t)(rowstart - 3 + k) * 4096 + col);
            win[k][0] = SSD_LO(v.x); win[k][1] = SSD_HI(v.x); win[k][2] = SSD_LO(v.y); win[k][3] = SSD_HI(v.y); win[k][4] = SSD_LO(v.z); win[k][5] = SSD_HI(v.z); win[k][6] = SSD_LO(v.w); win[k][7] = SSD_HI(v.w);
        } else if (halo) { const f4 a0 = *(const f4*)(halo + (size_t)(3 + t) * 4096 + col), a1 = *(const f4*)(halo + (size_t)(3 + t) * 4096 + col + 4);
            win[k][0] = a0.x; win[k][1] = a0.y; win[k][2] = a0.z; win[k][3] = a0.w; win[k][4] = a1.x; win[k][5] = a1.y; win[k][6] = a1.z; win[k][7] = a1.w;
        } else {
#pragma unroll
            for (int j = 0; j < 8; ++j) win[k][j] = 0.f; }
    }
    for (int i0 = 0; i0 < nrows; i0 += 16) {
        u4 rv[16];
#pragma unroll
        for (int i = 0; i < 16; ++i) { const int ri = i0 + i < nrows ? i0 + i : nrows - 1; rv[i] = *(const u4*)(XBC + (size_t)(rowstart + ri) * 4096 + col); }
#pragma unroll
        for (int i = 0; i < 16; ++i) {
            const u4 v = rv[i];
            float cur[8]; cur[0] = SSD_LO(v.x); cur[1] = SSD_HI(v.x); cur[2] = SSD_LO(v.y); cur[3] = SSD_HI(v.y); cur[4] = SSD_LO(v.z); cur[5] = SSD_HI(v.z); cur[6] = SSD_LO(v.w); cur[7] = SSD_HI(v.w);
            float y[8];
#pragma unroll
            for (int j = 0; j < 8; ++j) { const float t = bb[j] + w[0][j] * win[0][j] + w[1][j] * win[1][j] + w[2][j] * win[2][j] + w[3][j] * cur[j];
                y[j] = t * __builtin_amdgcn_rcpf(1.0f + __expf(-t)); win[0][j] = win[1][j]; win[1][j] = win[2][j]; win[2][j] = cur[j]; }
            u4 o; o.x = pk2(y[0], y[1]); o.y = pk2(y[2], y[3]); o.z = pk2(y[4], y[5]); o.w = pk2(y[6], y[7]);
            if (i0 + i < nrows) *(u4*)(XA + (size_t)(rowstart + i0 + i) * 4096 + col) = o;
        }
    }
}

__device__ __forceinline__ void ssd_unit(LAS unsigned char* lds, int tid_in, KArgs a_in, int seqrow0, int ntok, int g, int h, int b, bool smp) {
    const int wave = __builtin_amdgcn_readfirstlane(tid_in >> 6);
    const int tb = wave & 3, ph = wave >> 2, nb = wave;
    const int nchunks = (ntok + 63) >> 6;
    const int hd = 4 * g + h;
    f4 hacc[4];
    u2 zn[2];
    u4 rawp[8];
    float dt_raw = 0.f;
    {
        const int lane = tid_in & 63, l15 = lane & 15, lq = lane >> 4;
        const float* h0 = smp ? (const float*)a_in->in[I_SSM] + (size_t)b * 32 * 64 * 128 : nullptr;
#pragma unroll
        for (int pb = 0; pb < 4; ++pb) {
            if (h0) hacc[pb] = *(const f4*)(h0 + ((size_t)hd * 64 + 16 * pb + l15) * 128 + 16 * nb + 4 * lq);
            else hacc[pb] = (f4){0.f, 0.f, 0.f, 0.f};
        }
        if (tid_in < 320) {
            const int cg = tid_in >> 3, rs = tid_in & 7, col = chan_col(8 * cg, g, h);
            const bf16* XA = (const bf16*)(a_in->ws + WS_XBCA);
#pragma unroll
            for (int i = 0; i < 8; ++i) rawp[i] = *(const u4*)(XA + (size_t)(seqrow0 + 8 * rs + i) * 4096 + col);
        } else if (wave == 5) { if (lane < ntok) dt_raw = ((const float*)(a_in->ws + WS_MISC))[(size_t)(seqrow0 + lane) * 256 + hd]; }
        { const int tc0 = 16 * tb + l15, trow = seqrow0 + (tc0 < ntok ? tc0 : 0); const bf16* Z = (const bf16*)(a_in->ws + WS_Z);
#pragma unroll
          for (int pbi = 0; pbi < 2; ++pbi) zn[pbi] = *(const u2*)(Z + (size_t)trow * 2048 + 64 * hd + 16 * (2 * ph + pbi) + 4 * lq); }
    }
    const float dt_bias = ((const float*)a_in->in[I_DTB])[hd], a_neg = -expf(((const float*)a_in->in[I_ALOG])[hd]), dsk = ((const float*)a_in->in[I_DSKIP])[hd];
    __syncthreads();
    unsigned char* const ws_unit = a_in->ws;
    SSD_MARK_INIT()
    for (int c = 0; c < nchunks; ++c) {
        SSD_MARK(0)
        int tid = tid_in; asm volatile("" : "+v"(tid));
        unsigned char* wsp = ws_unit;
        const int lane = tid & 63, l15 = lane & 15, lq = lane >> 4;
        const int nvalid = (ntok - 64 * c) < 64 ? (ntok - 64 * c) : 64;
        const int rowbase = seqrow0 + 64 * c;
        if (tid < 320) {
            const int cg = tid >> 3, rs = tid & 7;
            u4 rw[8];
#pragma unroll
            for (int i = 0; i < 8; ++i) rw[i] = (8 * rs + i < nvalid) ? rawp[i] : (u4){0u, 0u, 0u, 0u};
            if (wave != 0) {
                const bool isB = wave < 3; const int n0 = 8 * (isB ? cg - 8 : cg - 24);
#pragma unroll
                for (int i = 0; i < 8; ++i) *(LAS u4*)(lds + (isB ? L_BS : L_CS) + (8 * rs + i) * P_C + n0 * 2) = rw[i];
            }
            if (wave < 3) {
                const int c0 = (wave == 0) ? 8 * cg : 8 * (cg - 8);
                LAS unsigned char* tb_ = lds + (wave == 0 ? L_XT : L_BST) + c0 * P_S + 16 * rs;
#pragma unroll
                for (int q = 0; q < 4; ++q) {
                    u4 lo, hi;
                    lo.x = (rw[0][q] & 0xffffu) | (rw[1][q] << 16); lo.y = (rw[2][q] & 0xffffu) | (rw[3][q] << 16); lo.z = (rw[4][q] & 0xffffu) | (rw[5][q] << 16); lo.w = (rw[6][q] & 0xffffu) | (rw[7][q] << 16);
                    hi.x = (rw[0][q] >> 16) | (rw[1][q] & 0xffff0000u); hi.y = (rw[2][q] >> 16) | (rw[3][q] & 0xffff0000u); hi.z = (rw[4][q] >> 16) | (rw[5][q] & 0xffff0000u); hi.w = (rw[6][q] >> 16) | (rw[7][q] & 0xffff0000u);
                    *(LAS u4*)(tb_ + (2 * q) * P_S) = lo; *(LAS u4*)(tb_ + (2 * q + 1) * P_S) = hi; }
            }
        } else if (wave == 5) {
            float dtv = 0.f;
            if (lane < nvalid) { const float xr = dt_raw + dt_bias;
                const float e = __expf(fminf(xr, 20.f)); dtv = xr > 20.f ? xr : (e < 1e-4f ? e * (1.0f - 0.5f * e) : __logf(1.0f + e)); }
            LAS float* dtl = (LAS float*)(lds + L_DT); LAS float* acl = (LAS float*)(lds + L_ACS);
            dtl[lane] = dtv;
            float cs = dtv * a_neg;
#define SSD_DPP_ADD(ctrl, rmask) cs += __builtin_bit_cast(float, __builtin_amdgcn_update_dpp(0, __builtin_bit_cast(int, cs), ctrl, rmask, 0xf, false))
            SSD_DPP_ADD(0x111, 0xf); SSD_DPP_ADD(0x112, 0xf); SSD_DPP_ADD(0x114, 0xf); SSD_DPP_ADD(0x118, 0xf); SSD_DPP_ADD(0x142, 0xa); SSD_DPP_ADD(0x143, 0xc);
#undef SSD_DPP_ADD
            acl[lane] = cs;
            const float cs_end = __builtin_bit_cast(float, __builtin_amdgcn_readlane(__builtin_bit_cast(int, cs), 63));
            ((LAS float*)(lds + L_WG))[lane] = dtv * __expf(cs_end - cs);
        } else if (wave == 6 && c > 0) {
            float tot = 0.f;
#pragma unroll
            for (int q = 0; q < 8; ++q) tot += ((const LAS float*)(lds + L_SSQ))[q * 64 + lane];
            ((float*)(wsp + WS_SSQ))[(size_t)(rowbase - 64 + lane) * 32 + hd] = tot;
        }
        SSD_SYNC();
        SSD_MARK(1)
        const int bC = l15 * P_C + 16 * lq, bS = l15 * P_S + 16 * lq;
        const int tcol = 16 * tb + l15;
        u2 zz[2];
        {
            zz[0] = zn[0]; zz[1] = zn[1];
            const bool more = c + 1 < nchunks;
            const int nb_row = more ? rowbase + 64 : rowbase;
            { const bf16* Z = (const bf16*)(wsp + WS_Z); const int nv2 = more ? ntok - 64 * (c + 1) : nvalid; const int trow = nb_row + (tcol < nv2 ? tcol : 0);
#pragma unroll
              for (int pbi = 0; pbi < 2; ++pbi) zn[pbi] = *(const u2*)(Z + (size_t)trow * 2048 + 64 * hd + 16 * (2 * ph + pbi) + 4 * lq); }
            { const int tl = lane < ntok - (nb_row - seqrow0) ? lane : 0; dt_raw = ((const float*)(wsp + WS_MISC))[(size_t)(nb_row + tl) * 256 + hd]; }
            { const int t2 = tid < 320 ? tid : 0, cg = t2 >> 3, rs = t2 & 7, col = chan_col(8 * cg, g, h); const bf16* XA = (const bf16*)(wsp + WS_XBCA);
#pragma unroll
              for (int i = 0; i < 8; ++i) rawp[i] = *(const u4*)(XA + (size_t)(nb_row + 8 * rs + i) * 4096 + col); }
        }
        s16x8 cfr[4], btf[2];
#pragma unroll
        for (int ks = 0; ks < 4; ++ks) cfr[ks] = SSD_FRAG(bC + L_CS + 16 * tb * P_C + 64 * ks);
#pragma unroll
        for (int ks = 0; ks < 2; ++ks) btf[ks] = SSD_FRAG(bS + L_BST + 16 * nb * P_S + 64 * ks);
        f4 gt[2];
#pragma unroll
        for (int sbi = 0; sbi < 2; ++sbi) { gt[sbi] = (f4){0.f, 0.f, 0.f, 0.f};
#pragma unroll
            for (int ks = 0; ks < 4; ++ks) gt[sbi] = mfma16(SSD_FRAG(bC + L_BS + 16 * (2 * ph + sbi) * P_C + 64 * ks), cfr[ks], gt[sbi]); }
        const LAS float* dtl = (const LAS float*)(lds + L_DT); const LAS float* acl = (const LAS float*)(lds + L_ACS);
        const float acs_end = acl[63], acs_t = acl[tcol];
#pragma unroll
        for (int pb = 0; pb < 4; ++pb) { const f4 v = hacc[pb]; u2 w; w.x = pk2(v.x, v.y); w.y = pk2(v.z, v.w);
            *(LAS u2*)(lds + L_HS + (16 * pb + l15) * P_C + (16 * nb + 4 * lq) * 2) = w; }
        { const int p = tid >> 3, s0 = 8 * (tid & 7);
          const u4 xv = *(const LAS u4*)(lds + L_XT + p * P_S + s0 * 2);
          const f4 w0 = *(const LAS f4*)((const LAS float*)(lds + L_WG) + s0), w1 = *(const LAS f4*)((const LAS float*)(lds + L_WG) + s0 + 4);
          u4 w;
          w.x = pk2(SSD_LO(xv.x) * w0.x, SSD_HI(xv.x) * w0.y); w.y = pk2(SSD_LO(xv.y) * w0.z, SSD_HI(xv.y) * w0.w);
          w.z = pk2(SSD_LO(xv.z) * w1.x, SSD_HI(xv.z) * w1.y); w.w = pk2(SSD_LO(xv.w) * w1.z, SSD_HI(xv.w) * w1.w);
          *(LAS u4*)(lds + L_XWT + p * P_S + s0 * 2) = w; }
#pragma unroll
        for (int sbi = 0; sbi < 2; ++sbi) { const int s0 = 16 * (2 * ph + sbi) + 4 * lq;
            const f4 as = *(const LAS f4*)(acl + s0), ds = *(const LAS f4*)(dtl + s0); const f4 gv = gt[sbi];
            const float m0 = (s0 + 0 <= tcol) ? gv.x * __expf(acs_t - as.x) * ds.x : 0.f, m1 = (s0 + 1 <= tcol) ? gv.y * __expf(acs_t - as.y) * ds.y : 0.f;
            const float m2 = (s0 + 2 <= tcol) ? gv.z * __expf(acs_t - as.z) * ds.z : 0.f, m3 = (s0 + 3 <= tcol) ? gv.w * __expf(acs_t - as.w) * ds.w : 0.f;
            u2 w; w.x = pk2(m0, m1); w.y = pk2(m2, m3);
            *(LAS u2*)(lds + L_MS + tcol * P_S + s0 * 2) = w; }
        SSD_SYNC();
        SSD_MARK(2)
        const float e_t = __expf(acs_t);
        float sq = 0.f;
        bf16* YS = (bf16*)(wsp + WS_YC);
#pragma unroll
        for (int pbi = 0; pbi < 2; ++pbi) { const int pb = 2 * ph + pbi; f4 y = (f4){0.f, 0.f, 0.f, 0.f};
#pragma unroll
            for (int ks = 0; ks < 4; ++ks) y = mfma16(SSD_FRAG(bC + L_HS + 16 * pb * P_C + 64 * ks), cfr[ks], y);
            y = y * e_t;
#pragma unroll
            for (int ks = 0; ks < 2; ++ks) y = mfma16(SSD_FRAG(bS + L_XT + 16 * pb * P_S + 64 * ks), SSD_FRAG(bS + L_MS + 16 * tb * P_S + 64 * ks), y);
            const int p0 = 16 * pb + 4 * lq;
            const LAS unsigned short* xp = (const LAS unsigned short*)(lds + L_XT + p0 * P_S + tcol * 2);
            y.x += dsk * SSD_LO((unsigned)xp[0]); y.y += dsk * SSD_LO((unsigned)xp[P_S / 2]); y.z += dsk * SSD_LO((unsigned)xp[P_S]); y.w += dsk * SSD_LO((unsigned)xp[3 * P_S / 2]);
            {
                const bool ok = tcol < nvalid;
                const u2 z2 = zz[pbi];
                y.x *= silu_f(SSD_LO(z2.x)); y.y *= silu_f(SSD_HI(z2.x)); y.z *= silu_f(SSD_LO(z2.y)); y.w *= silu_f(SSD_HI(z2.y));
                u2 w; w.x = pk2(y.x, y.y); w.y = pk2(y.z, y.w);
                bf16* dst = ok ? YS + (size_t)(rowbase + tcol) * YCP + 64 * hd + p0 : (bf16*)(wsp + WS_DUMMY) + (size_t)tid * 8 + 4 * pbi;
                *(u2*)dst = w;
                const float q0 = SSD_LO(w.x), q1 = SSD_HI(w.x), q2 = SSD_LO(w.y), q3 = SSD_HI(w.y);
                sq += ok ? (q0 * q0 + q1 * q1) + (q2 * q2 + q3 * q3) : 0.f;
            } }
        ((LAS float*)(lds + L_SSQ))[(ph * 4 + lq) * 64 + tcol] = sq;
        const float e_end = __expf(acs_end);
#pragma unroll
        for (int pb = 0; pb < 4; ++pb) { f4 v = hacc[pb] * e_end;
#pragma unroll
            for (int ks = 0; ks < 2; ++ks) v = mfma16(btf[ks], SSD_FRAG(bS + L_XWT + 16 * pb * P_S + 64 * ks), v);
            hacc[pb] = v; }
        SSD_SYNC();
        SSD_MARK(3)
    }
    SSD_MARK_FLUSH()
    {
        const int lane = tid_in & 63, l15 = lane & 15, lq = lane >> 4;
        if (wave == 6) {
            float tot = 0.f;
#pragma unroll
            for (int q = 0; q < 8; ++q) tot += ((const LAS float*)(lds + L_SSQ))[q * 64 + lane];
            if (lane < ntok - 64 * (nchunks - 1)) ((float*)(a_in->ws + WS_SSQ))[(size_t)(seqrow0 + 64 * (nchunks - 1) + lane) * 32 + hd] = tot;
        }
        float* hout = a_in->out + (smp ? O_SSMS : O_SSMP) + (size_t)b * 32 * 64 * 128;
#pragma unroll
        for (int pb = 0; pb < 4; ++pb) *(f4*)(hout + ((size_t)hd * 64 + 16 * pb + l15) * 128 + 16 * nb + 4 * lq) = hacc[pb];
    }
    __syncthreads();
}


__device__ __forceinline__ void ssd_sample_unit(LAS unsigned char* lds, int tid, KArgs a, int b, int hd) {
    const int p = tid >> 3, nc = tid & 7, g = hd >> 2;
    unsigned char* ws = a->ws;
    const float* hin = (const float*)a->in[I_SSM] + ((size_t)(b * 32 + hd) * 64 + p) * 128 + 16 * nc;
    float* hout = a->out + O_SSMS + ((size_t)(b * 32 + hd) * 64 + p) * 128 + 16 * nc;
    f4 h[4];
#pragma unroll
    for (int q = 0; q < 4; ++q) h[q] = *(const f4*)(hin + 4 * q);
    const float dt_bias = ((const float*)a->in[I_DTB])[hd], a_neg = -expf(((const float*)a->in[I_ALOG])[hd]), dsk = ((const float*)a->in[I_DSKIP])[hd];
    const bf16* XA = (const bf16*)(ws + WS_XBCA); const bf16* Z = (const bf16*)(ws + WS_Z); const float* MI = (const float*)(ws + WS_MISC); bf16* YS = (bf16*)(ws + WS_YC);
    u4 bv[4][2], cv[4][2]; float xv[4], zv[4], dtr[4];
#pragma unroll
    for (int t = 0; t < 4; ++t) { const size_t row = (size_t)(MP + 4 * b + t);
        bv[t][0] = *(const u4*)(XA + row * 4096 + 2048 + 128 * g + 16 * nc); bv[t][1] = *(const u4*)(XA + row * 4096 + 2048 + 128 * g + 16 * nc + 8);
        cv[t][0] = *(const u4*)(XA + row * 4096 + 3072 + 128 * g + 16 * nc); cv[t][1] = *(const u4*)(XA + row * 4096 + 3072 + 128 * g + 16 * nc + 8);
        xv[t] = __uint_as_float((unsigned)XA[row * 4096 + 64 * hd + p] << 16); zv[t] = __uint_as_float((unsigned)Z[row * 2048 + 64 * hd + p] << 16); dtr[t] = MI[row * 256 + hd]; }
    LAS float* sql = (LAS float*)lds;
#pragma unroll
    for (int t = 0; t < 4; ++t) {
        const float xr = dtr[t] + dt_bias; const float e = __expf(fminf(xr, 20.f)); const float dt = xr > 20.f ? xr : (e < 1e-4f ? e * (1.0f - 0.5f * e) : __logf(1.0f + e));
        const float dec = __expf(dt * a_neg), dx = dt * xv[t];
        float yp = 0.f;
#pragma unroll
        for (int q = 0; q < 4; ++q) {
            const unsigned b0 = bv[t][q >> 1][2 * (q & 1)], b1 = bv[t][q >> 1][2 * (q & 1) + 1], c0 = cv[t][q >> 1][2 * (q & 1)], c1 = cv[t][q >> 1][2 * (q & 1) + 1];
            h[q].x = h[q].x * dec + dx * SSD_LO(b0); h[q].y = h[q].y * dec + dx * SSD_HI(b0); h[q].z = h[q].z * dec + dx * SSD_LO(b1); h[q].w = h[q].w * dec + dx * SSD_HI(b1);
            yp += (SSD_LO(c0) * h[q].x + SSD_HI(c0) * h[q].y) + (SSD_LO(c1) * h[q].z + SSD_HI(c1) * h[q].w);
        }
#define SSD_DPP_FADD(ctrl) yp += __builtin_bit_cast(float, __builtin_amdgcn_update_dpp(0, __builtin_bit_cast(int, yp), ctrl, 0xf, 0xf, false))
        SSD_DPP_FADD(0xB1); SSD_DPP_FADD(0x4E); SSD_DPP_FADD(0x141);
#undef SSD_DPP_FADD
        float y = (yp + dsk * xv[t]) * silu_f(zv[t]);
        const unsigned yb = f2bf(y); y = __uint_as_float(yb << 16);
        if (nc == 0) { YS[(size_t)(MP + 4 * b + t) * YCP + 64 * hd + p] = (bf16)yb; sql[t * 64 + p] = y * y; }
    }
#pragma unroll
    for (int q = 0; q < 4; ++q) *(f4*)(hout + 4 * q) = h[q];
    __syncthreads();
    if (tid < 4) { float sm = 0.f; for (int i = 0; i < 64; ++i) sm += sql[tid * 64 + i]; ((float*)(ws + WS_SSQ))[(size_t)(MP + 4 * b + tid) * 32 + hd] = sm; }
    __syncthreads();
}

__device__ __forceinline__ void ssd_norm_rows4(bf16* yrow0, const float* ssq_row0, const float* __restrict__ gain, int lane) {
    u4 v[4][4]; f4 s4[4];
#pragma unroll
    for (int r = 0; r < 4; ++r) { s4[r] = *(const f4*)(ssq_row0 + r * 32 + 4 * (lane >> 3));
#pragma unroll
        for (int i = 0; i < 4; ++i) v[r][i] = ((const u4*)(yrow0 + (size_t)r * YCP + 32 * lane))[i]; }
    const f4* gp = (const f4*)(gain + 32 * lane);
#pragma unroll
    for (int r = 0; r < 4; ++r) {
        const float rs = 1.0f / sqrtf(((s4[r].x + s4[r].y) + (s4[r].z + s4[r].w)) * (1.0f / 256.0f) + EPS);
        u4* p = (u4*)(yrow0 + (size_t)r * YCP + 32 * lane);
#pragma unroll
        for (int i = 0; i < 4; ++i) { const u4 x = v[r][i]; const f4 g0 = gp[2 * i], g1 = gp[2 * i + 1]; u4 o;
            o.x = pk2(SSD_LO(x.x) * rs * g0.x, SSD_HI(x.x) * rs * g0.y); o.y = pk2(SSD_LO(x.y) * rs * g0.z, SSD_HI(x.y) * rs * g0.w);
            o.z = pk2(SSD_LO(x.z) * rs * g1.x, SSD_HI(x.z) * rs * g1.y); o.w = pk2(SSD_LO(x.w) * rs * g1.z, SSD_HI(x.w) * rs * g1.w);
            p[i] = o; }
    }
}
}

namespace dsa {
typedef short s16x8 __attribute__((ext_vector_type(8)));
typedef short s16x4 __attribute__((ext_vector_type(4)));
typedef float f4 __attribute__((ext_vector_type(4)));
typedef float f16v __attribute__((ext_vector_type(16)));
typedef unsigned u2 __attribute__((ext_vector_type(2)));
typedef unsigned u4 __attribute__((ext_vector_type(4)));
__device__ __forceinline__ f16v mfma32(s16x8 a, s16x8 b, f16v c) { return __builtin_amdgcn_mfma_f32_32x32x16_bf16(a, b, c, 0, 0, 0); }
__device__ __forceinline__ unsigned f2key(float f) { const unsigned b = __float_as_uint(f + 0.0f); return (b & 0x80000000u) ? ~b : (b | 0x80000000u); }
__device__ __forceinline__ int wave_count(bool p) { return (int)__builtin_popcountll(__builtin_amdgcn_ballot_w64(p)); }
__device__ __forceinline__ unsigned lower_count(bool p) { const unsigned long long bm = __builtin_amdgcn_ballot_w64(p);
    return __builtin_amdgcn_mbcnt_hi((unsigned)(bm >> 32), __builtin_amdgcn_mbcnt_lo((unsigned)bm, 0u)); }

__device__ __forceinline__ void idx_tile(const s16x8 (&afr)[4], const s16x8 (&bfr)[4], const f4 (&wv)[4], float (&sc)[4]) {
    f16v d;
#pragma unroll
    for (int i = 0; i < 16; ++i) d[i] = 0.f;
#pragma unroll
    for (int ks = 0; ks < 4; ++ks) d = mfma32(afr[ks], bfr[ks], d);
#pragma unroll
    for (int tq = 0; tq < 4; ++tq) {
        float p = wv[tq].x * fmaxf(d[4 * tq + 0], 0.f) + wv[tq].y * fmaxf(d[4 * tq + 1], 0.f) + wv[tq].z * fmaxf(d[4 * tq + 2], 0.f) + wv[tq].w * fmaxf(d[4 * tq + 3], 0.f);
        p += __shfl_xor(p, 32);
        sc[tq] = p;
    }
}

__device__ __forceinline__ void idx_tile2(const s16x8 (&afr)[4], const s16x8 (&b0)[4], const s16x8 (&b1)[4], const f4 (&wv)[4], float (&s0)[4], float (&s1)[4]) {
    f16v d0, d1;
#pragma unroll
    for (int i = 0; i < 16; ++i) { d0[i] = 0.f; d1[i] = 0.f; }
#pragma unroll
    for (int ks = 0; ks < 4; ++ks) { d0 = mfma32(afr[ks], b0[ks], d0); d1 = mfma32(afr[ks], b1[ks], d1); }
    float p0[4], p1[4];
#pragma unroll
    for (int tq = 0; tq < 4; ++tq) {
        p0[tq] = wv[tq].x * fmaxf(d0[4 * tq + 0], 0.f) + wv[tq].y * fmaxf(d0[4 * tq + 1], 0.f) + wv[tq].z * fmaxf(d0[4 * tq + 2], 0.f) + wv[tq].w * fmaxf(d0[4 * tq + 3], 0.f);
        p1[tq] = wv[tq].x * fmaxf(d1[4 * tq + 0], 0.f) + wv[tq].y * fmaxf(d1[4 * tq + 1], 0.f) + wv[tq].z * fmaxf(d1[4 * tq + 2], 0.f) + wv[tq].w * fmaxf(d1[4 * tq + 3], 0.f);
    }
    auto hsum = [](float a, float b) { const auto r = __builtin_amdgcn_permlane32_swap(__float_as_uint(a), __float_as_uint(b), false, false); return __uint_as_float(r[0]) + __uint_as_float(r[1]); };
    s0[0] = s0[2] = hsum(p0[0], p0[2]); s0[1] = s0[3] = hsum(p0[1], p0[3]);
    s1[0] = s1[2] = hsum(p1[0], p1[2]); s1[1] = s1[3] = hsum(p1[1], p1[3]);
}

__device__ __forceinline__ unsigned topk256_wave(const unsigned (&key)[32]) {
    unsigned prefix = 0u;
    for (int bit = 31; bit >= 0; --bit) {
        const unsigned cand = prefix | (1u << bit);
        int c0 = 0, c1 = 0;
#pragma unroll
        for (int i = 0; i < 32; i += 2) { c0 += (key[i] >= cand) ? 1 : 0; c1 += (key[i + 1] >= cand) ? 1 : 0; }
        int ps = c0 + c1;
#define TK_DPP_ADD(ctrl, rmask) ps += __builtin_amdgcn_update_dpp(0, ps, ctrl, rmask, 0xf, false)
        TK_DPP_ADD(0x111, 0xf); TK_DPP_ADD(0x112, 0xf); TK_DPP_ADD(0x114, 0xf); TK_DPP_ADD(0x118, 0xf); TK_DPP_ADD(0x142, 0xa); TK_DPP_ADD(0x143, 0xc);
#undef TK_DPP_ADD
        const int cnt = __builtin_amdgcn_readlane(ps, 63);
        if (cnt >= 256) prefix = cand;
        if (cnt == 256) {
            unsigned pe = cand; asm volatile("" : "+v"(pe)); pe = __builtin_amdgcn_readfirstlane(pe);
            unsigned w = 0u;
#pragma unroll
            for (int i = 0; i < 32; ++i) w |= (key[i] >= pe) ? (1u << i) : 0u;
            return w;
        }
    }
    unsigned p1 = prefix; asm volatile("" : "+v"(p1)); p1 = __builtin_amdgcn_readfirstlane(p1);
    int cgt = 0;
#pragma unroll
    for (int i = 0; i < 32; ++i) cgt += wave_count(key[i] > p1);
    unsigned p2 = prefix; asm volatile("" : "+v"(p2)); p2 = __builtin_amdgcn_readfirstlane(p2);
    unsigned lower = 0u;
#pragma unroll
    for (int i = 0; i < 32; ++i) lower += lower_count(key[i] == p2);
    const unsigned need = (unsigned)(256 - cgt);
    unsigned p3 = prefix; asm volatile("" : "+v"(p3)); p3 = __builtin_amdgcn_readfirstlane(p3);
    unsigned word = 0u, run = lower;
#pragma unroll
    for (int i = 0; i < 32; ++i) { bool sel = key[i] > p3; if (key[i] == p3) { sel = run < need; ++run; } word |= sel ? (1u << i) : 0u; }
    return word;
}


__device__ __forceinline__ float key2f(unsigned k) { return __uint_as_float((k & 0x80000000u) ? (k ^ 0x80000000u) : ~k); }
__device__ __forceinline__ unsigned topk256_bucket(LAS unsigned* wl, const unsigned (&key)[32], int lane) {
    unsigned kmin = 0xffffffffu, kmax = 0u;
#pragma unroll
    for (int i = 0; i < 32; ++i) { kmax = key[i] > kmax ? key[i] : kmax; const unsigned kk = key[i] ? key[i] : 0xffffffffu; kmin = kk < kmin ? kk : kmin; }
#pragma unroll
    for (int j = 0; j < 4; ++j) wl[4 * lane + j] = 0u;
    if (lane == 0) { wl[256] = 0xffffffffu; wl[257] = 0u; wl[258] = 0u; }
    wl[448 + lane] = 0u;
    asm volatile("s_waitcnt lgkmcnt(0)" ::: "memory");
    __hip_atomic_fetch_min(&wl[256], kmin, __ATOMIC_RELAXED, __HIP_MEMORY_SCOPE_WORKGROUP);
    __hip_atomic_fetch_max(&wl[257], kmax, __ATOMIC_RELAXED, __HIP_MEMORY_SCOPE_WORKGROUP);
    asm volatile("s_waitcnt lgkmcnt(0)" ::: "memory");
    const float lo = key2f(wl[256]), hi = key2f(wl[257]);
    const float scale = 255.99f / (hi - lo);
    unsigned bins[8];
#pragma unroll
    for (int i = 0; i < 32; ++i) {
        int bn = (int)((key2f(key[i]) - lo) * scale); bn = bn < 0 ? 0 : (bn > 255 ? 255 : bn);
        if (key[i]) __hip_atomic_fetch_add(&wl[bn], 1u, __ATOMIC_RELAXED, __HIP_MEMORY_SCOPE_WORKGROUP);
        if ((i & 3) == 0) bins[i >> 2] = 0u;
        bins[i >> 2] |= (unsigned)bn << (8 * (i & 3));
    }
    asm volatile("s_waitcnt lgkmcnt(0)" ::: "memory");
    const unsigned c0 = wl[4 * lane], c1 = wl[4 * lane + 1], c2 = wl[4 * lane + 2], c3 = wl[4 * lane + 3];
    int ps = (int)(c0 + c1 + c2 + c3);
#define TK_DPP_ADD(ctrl, rmask) ps += __builtin_amdgcn_update_dpp(0, ps, ctrl, rmask, 0xf, false)
    TK_DPP_ADD(0x111, 0xf); TK_DPP_ADD(0x112, 0xf); TK_DPP_ADD(0x114, 0xf); TK_DPP_ADD(0x118, 0xf); TK_DPP_ADD(0x142, 0xa); TK_DPP_ADD(0x143, 0xc);
#undef TK_DPP_ADD
    const int total = __builtin_amdgcn_readlane(ps, 63);
    const int ab3 = total - ps, ab2 = ab3 + (int)c3, ab1 = ab2 + (int)c2, ab0 = ab1 + (int)c1;
    int myb = -1, myab = 0;
    if (ab3 < 256 && ab3 + (int)c3 >= 256) { myb = 4 * lane + 3; myab = ab3; }
    if (ab2 < 256 && ab2 + (int)c2 >= 256) { myb = 4 * lane + 2; myab = ab2; }
    if (ab1 < 256 && ab1 + (int)c1 >= 256) { myb = 4 * lane + 1; myab = ab1; }
    if (ab0 < 256 && ab0 + (int)c0 >= 256) { myb = 4 * lane; myab = ab0; }
    const unsigned long long own = __builtin_amdgcn_ballot_w64(myb >= 0);
    const int src = (int)__builtin_ctzll(own);
    const int bb = __builtin_amdgcn_readlane(myb, src), above = __builtin_amdgcn_readlane(myab, src);
    const unsigned need = (unsigned)(256 - above);
    unsigned word = 0u;
#pragma unroll
    for (int i = 0; i < 32; ++i) {
        const int bn = (int)((bins[i >> 2] >> (8 * (i & 3))) & 255u);
        if (key[i] && bn > bb) word |= 1u << i;
        if (key[i] && bn == bb) { const unsigned pos = __hip_atomic_fetch_add(&wl[258], 1u, __ATOMIC_RELAXED, __HIP_MEMORY_SCOPE_WORKGROUP);
            if (pos < 64u) { wl[320 + 2 * pos] = key[i]; wl[321 + 2 * pos] = (unsigned)(32 * lane + i); } }
    }
    asm volatile("s_waitcnt lgkmcnt(0)" ::: "memory");
    const unsigned nc = wl[258];
    if (nc > 64u) return topk256_wave(key);
    {
        const unsigned myk = lane < (int)nc ? wl[320 + 2 * lane] : 0u, myi = lane < (int)nc ? wl[321 + 2 * lane] : 0u;
        unsigned rank = 0u;
        for (unsigned m = 0; m < nc; ++m) { const unsigned km = wl[320 + 2 * m], im = wl[321 + 2 * m]; rank += (km > myk || (km == myk && im < myi)) ? 1u : 0u; }
        if (lane < (int)nc && rank < need) __hip_atomic_fetch_or(&wl[448 + (myi >> 5)], 1u << (myi & 31u), __ATOMIC_RELAXED, __HIP_MEMORY_SCOPE_WORKGROUP);
    }
    asm volatile("s_waitcnt lgkmcnt(0)" ::: "memory");
    return word | wl[448 + lane];
}

constexpr int IX_P = 144, IX_BUF = 256 * IX_P;
__device__ __forceinline__ void idx_prompt_unit(LAS unsigned char* lds, int tid, const bf16* __restrict__ QI, const bf16* __restrict__ KIB, const float* __restrict__ MISCB, float* __restrict__ SC, unsigned* __restrict__ MASK,
                                                int b, int qblk) {
    const int lane = tid & 63, wave = __builtin_amdgcn_readfirstlane(tid >> 6), r = lane & 31, hi = lane >> 5;
    const int qrow0 = b * SEQ + 32 * qblk + 4 * wave;
    if (qblk < 8) {
#pragma unroll
        for (int tq = 0; tq < 4; ++tq) { const int t = 32 * qblk + 4 * wave + tq, rel = t - 32 * lane;
            const unsigned word = rel >= 31 ? 0xffffffffu : (rel < 0 ? 0u : ((2u << rel) - 1u));
            MASK[(size_t)(qrow0 + tq) * 64 + lane] = word; }
        return;
    }
#ifdef DBG_IDXMARK
    unsigned long long tm0_ = __builtin_amdgcn_s_memtime();
#endif
    s16x8 afr[4]; f4 wv[4];
#pragma unroll
    for (int ks = 0; ks < 4; ++ks) afr[ks] = *(const s16x8*)(QI + (size_t)qrow0 * 512 + r * 64 + 16 * ks + 8 * hi);
#pragma unroll
    for (int tq = 0; tq < 4; ++tq) wv[tq] = *(const f4*)(MISCB + (size_t)(qrow0 + tq) * 256 + 96 + 4 * hi);
    const int nkt = qblk + 1, nch = (nkt + 7) >> 3;
    const bf16* kg = KIB + (size_t)b * SEQ * 64 + (size_t)tid * 8;
    u4 st[4];
#pragma unroll
    for (int i = 0; i < 4; ++i) st[i] = *(const u4*)(kg + (size_t)i * 4096);
    for (int ch = 0; ch < nch; ++ch) {
        LAS unsigned char* buf = lds + (ch & 1) * IX_BUF;
#pragma unroll
        for (int i = 0; i < 4; ++i) { const int idx = i * 512 + tid; *(LAS u4*)(buf + (idx >> 3) * IX_P + 16 * (idx & 7)) = st[i]; }
        __syncthreads();
        if (ch + 1 < nch) {
#pragma unroll
            for (int i = 0; i < 4; ++i) st[i] = *(const u4*)(kg + (size_t)(ch + 1) * 16384 + (size_t)i * 4096);
        }
        const int ntile = (nkt - 8 * ch) < 8 ? (nkt - 8 * ch) : 8;
        for (int k8 = 0; k8 < ntile; k8 += 2) {
            const int k8b = k8 + 1 < ntile ? k8 + 1 : k8;
            s16x8 bfr[4], bfr2[4];
#pragma unroll
            for (int ks = 0; ks < 4; ++ks) { bfr[ks] = *(const LAS s16x8*)(buf + (32 * k8 + r) * IX_P + 32 * ks + 16 * hi); bfr2[ks] = *(const LAS s16x8*)(buf + (32 * k8b + r) * IX_P + 32 * ks + 16 * hi); }
            float sc[4], sc2[4]; idx_tile2(afr, bfr, bfr2, wv, sc, sc2);
            const int kt = 8 * ch + k8, kt2 = 8 * ch + k8b;
            SC[(size_t)(qrow0 + 2 * hi) * 2048 + 32 * kt + r] = hi ? sc[2] : sc[0];
            SC[(size_t)(qrow0 + 2 * hi + 1) * 2048 + 32 * kt + r] = hi ? sc[3] : sc[1];
            SC[(size_t)(qrow0 + 2 * hi) * 2048 + 32 * kt2 + r] = hi ? sc2[2] : sc2[0];
            SC[(size_t)(qrow0 + 2 * hi + 1) * 2048 + 32 * kt2 + r] = hi ? sc2[3] : sc2[1];
        }
    }
    asm volatile("s_waitcnt vmcnt(0)" ::: "memory");
#ifdef DBG_IDXMARK
    unsigned long long tm1_ = __builtin_amdgcn_s_memtime();
#endif
    for (int tq = 0; tq < 4; ++tq) {
        const int t = 32 * qblk + 4 * wave + tq;
        unsigned key[32];
        const float* srow = SC + (size_t)(qrow0 + tq) * 2048 + 32 * lane;
        if (32 * lane <= t) {
#pragma unroll
            for (int i4 = 0; i4 < 8; ++i4) { const f4 v = *(const f4*)(srow + 4 * i4);
                key[4 * i4 + 0] = (32 * lane + 4 * i4 + 0 <= t) ? f2key(v.x) : 0u; key[4 * i4 + 1] = (32 * lane + 4 * i4 + 1 <= t) ? f2key(v.y) : 0u;
                key[4 * i4 + 2] = (32 * lane + 4 * i4 + 2 <= t) ? f2key(v.z) : 0u; key[4 * i4 + 3] = (32 * lane + 4 * i4 + 3 <= t) ? f2key(v.w) : 0u; }
        } else {
#pragma unroll
            for (int i = 0; i < 32; ++i) key[i] = 0u;
        }
        const unsigned word = topk256_wave(key);
        MASK[(size_t)(qrow0 + tq) * 64 + lane] = word;
    }
#ifdef DBG_IDXMARK
    if (tid == 0) { const unsigned long long tm2_ = __builtin_amdgcn_s_memtime(); atomicAdd(DBG_IDXMARK + 16, (unsigned)((tm1_ - tm0_) >> 4)); atomicAdd(DBG_IDXMARK + 17, (unsigned)((tm2_ - tm1_) >> 4)); atomicAdd(DBG_IDXMARK + 18, 0u); atomicAdd(DBG_IDXMARK + 19, 0u); }
#endif
    __syncthreads();
}

__device__ __forceinline__ void idx_sample_unit(int tid, const bf16* __restrict__ QI, const float* __restrict__ MISCB, const float* __restrict__ ckidx, const int* __restrict__ ptab,
                                                float* __restrict__ SCS, int b, int range) {
    const int lane = tid & 63, wave = __builtin_amdgcn_readfirstlane(tid >> 6), r = lane & 31, hi = lane >> 5;
    const int qrow0 = MP + 4 * b;
    s16x8 afr[4]; f4 wv[4];
#pragma unroll
    for (int ks = 0; ks < 4; ++ks) afr[ks] = *(const s16x8*)(QI + (size_t)qrow0 * 512 + r * 64 + 16 * ks + 8 * hi);
#pragma unroll
    for (int tq = 0; tq < 4; ++tq) wv[tq] = *(const f4*)(MISCB + (size_t)(qrow0 + tq) * 256 + 96 + 4 * hi);
    int pg[8];
#pragma unroll
    for (int k = 0; k < 8; ++k) pg[k] = ptab[b * NPAGE + ((range * 2048 + 32 * (wave * 8 + k)) >> 7)];
    f4 va[8], vb[8];
    auto ld2 = [&](int k8) {
        const int sA = range * 2048 + 32 * (wave * 8 + k8) + r, sB = sA + 32;
        const float* srcA = ckidx + ((size_t)pg[k8] * PAGE + (sA & 127)) * 64 + 8 * hi; const float* srcB = ckidx + ((size_t)pg[k8 + 1] * PAGE + (sB & 127)) * 64 + 8 * hi;
#pragma unroll
        for (int ks = 0; ks < 4; ++ks) { va[2 * ks] = *(const f4*)(srcA + 16 * ks); va[2 * ks + 1] = *(const f4*)(srcA + 16 * ks + 4); vb[2 * ks] = *(const f4*)(srcB + 16 * ks); vb[2 * ks + 1] = *(const f4*)(srcB + 16 * ks + 4); }
    };
    ld2(0);
#pragma unroll
    for (int k8 = 0; k8 < 8; k8 += 2) {
        const int sA = range * 2048 + 32 * (wave * 8 + k8) + r, sB = sA + 32;
        s16x8 bfa[4], bfb[4];
#pragma unroll
        for (int ks = 0; ks < 4; ++ks) { u4 w; w.x = pk2(va[2 * ks].x, va[2 * ks].y); w.y = pk2(va[2 * ks].z, va[2 * ks].w); w.z = pk2(va[2 * ks + 1].x, va[2 * ks + 1].y); w.w = pk2(va[2 * ks + 1].z, va[2 * ks + 1].w); bfa[ks] = __builtin_bit_cast(s16x8, w);
            u4 x; x.x = pk2(vb[2 * ks].x, vb[2 * ks].y); x.y = pk2(vb[2 * ks].z, vb[2 * ks].w); x.z = pk2(vb[2 * ks + 1].x, vb[2 * ks + 1].y); x.w = pk2(vb[2 * ks + 1].z, vb[2 * ks + 1].w); bfb[ks] = __builtin_bit_cast(s16x8, x); }
        if (k8 + 2 < 8) ld2(k8 + 2);
        float sc[4], sc2[4]; idx_tile2(afr, bfa, bfb, wv, sc, sc2);
        SCS[(size_t)(4 * b + 2 * hi) * 16640 + sA] = hi ? sc[2] : sc[0];
        SCS[(size_t)(4 * b + 2 * hi + 1) * 16640 + sA] = hi ? sc[3] : sc[1];
        SCS[(size_t)(4 * b + 2 * hi) * 16640 + sB] = hi ? sc2[2] : sc2[0];
        SCS[(size_t)(4 * b + 2 * hi + 1) * 16640 + sB] = hi ? sc2[3] : sc2[1];
    }
}

constexpr int AT_KP = 144;
constexpr int AT_K = 0, AT_V = 2 * 64 * AT_KP, AT_M = 4 * 64 * AT_KP, AT_END = AT_M + 64 * 65 * 4;
__device__ __forceinline__ int crow(int reg, int hi) { return (reg & 3) + 8 * (reg >> 2) + 4 * hi; }
constexpr int A2_KP = 144, A2_VP = 272, A2_KB = 128 * A2_KP, A2_VB = 64 * A2_VP, A2_BUF = A2_KB + A2_VB, A2_M = 3 * A2_BUF, A2_END = A2_M + 64 * 65 * 4;
static_assert(A2_END <= 131072, "attention LDS");
typedef unsigned short us2v __attribute__((ext_vector_type(2)));
__device__ __forceinline__ unsigned pkclamp(unsigned w) { return __builtin_bit_cast(unsigned, __builtin_elementwise_min(__builtin_bit_cast(us2v, w), (us2v){(unsigned short)0x5F80, (unsigned short)0x5F80})); }
__device__ __forceinline__ void attn_prompt_unit(LAS unsigned char* lds, int tid, const bf16* __restrict__ Q, const bf16* __restrict__ KB, const bf16* __restrict__ VT, const unsigned* __restrict__ MASK,
                                                 bf16* __restrict__ YA, int b, int kvh, int qb) {
    const int lane = tid & 63, wave = __builtin_amdgcn_readfirstlane(tid >> 6), r = lane & 31, hi = lane >> 5;
    const int qrow = b * SEQ + 64 * qb + 8 * wave + (r >> 2), head = 4 * kvh + (r & 3);
    s16x8 qf[4];
#pragma unroll
    for (int ks = 0; ks < 4; ++ks) {
        const u4 qv = *(const u4*)(Q + (size_t)qrow * 1024 + head * 64 + 16 * ks + 8 * hi); const float cq = 0.125f * 1.4426950408889634f; u4 qs;
        qs.x = pk2(__uint_as_float(qv.x << 16) * cq, __uint_as_float(qv.x & 0xffff0000u) * cq); qs.y = pk2(__uint_as_float(qv.y << 16) * cq, __uint_as_float(qv.y & 0xffff0000u) * cq);
        qs.z = pk2(__uint_as_float(qv.z << 16) * cq, __uint_as_float(qv.z & 0xffff0000u) * cq); qs.w = pk2(__uint_as_float(qv.w << 16) * cq, __uint_as_float(qv.w & 0xffff0000u) * cq);
        qf[ks] = __builtin_bit_cast(s16x8, qs); }
    const int nst = (qb + 2) >> 1;
    const int srow = tid >> 3, sch = tid & 7;
    const bf16* kg = KB + (size_t)(b * SEQ + srow) * 256 + kvh * 64 + 8 * sch;
    const bf16* vg = VT + (size_t)(b * 256 + kvh * 64 + srow) * SEQ + 8 * sch;
    u4 kreg0 = *(const u4*)kg, kreg1 = *(const u4*)(kg + (size_t)64 * 256), vreg0 = *(const u4*)vg, vreg1 = *(const u4*)(vg + 64);
    {
        LAS unsigned* ml = (LAS unsigned*)(lds + A2_M);
        const unsigned* mg = MASK + (size_t)(b * SEQ + 64 * qb) * 64;
#pragma unroll
        for (int i = 0; i < 8; ++i) { const int idx = i * 512 + tid; ml[(idx >> 6) * 65 + (idx & 63)] = mg[idx]; }
    }
    const LAS unsigned* mrow = (const LAS unsigned*)(lds + A2_M) + (8 * wave + (r >> 2)) * 65;
    f16v o0, o1, o2;
#pragma unroll
    for (int i = 0; i < 16; ++i) { o0[i] = 0.f; o1[i] = 0.f; o2[i] = 0.f; }
    const short one_b = (r == 0) ? (short)0x3F80 : (short)0;
    const s16x8 onesf = (s16x8){one_b, one_b, one_b, one_b, one_b, one_b, one_b, one_b};
    const bool late = wave >= 4;
    s16x8 pf[4][2];
#pragma unroll
    for (int rt = 0; rt < 4; ++rt) { pf[rt][0] = (s16x8){0, 0, 0, 0, 0, 0, 0, 0}; pf[rt][1] = pf[rt][0]; }
    auto pv = [&](const LAS unsigned char* vl) {
#pragma unroll
        for (int rt = 0; rt < 4; ++rt)
#pragma unroll
            for (int s = 0; s < 2; ++s) {
                const int kb = (32 * rt + 16 * s + 4 * hi) * 2;
                const u2 a0 = *(const LAS u2*)(vl + r * A2_VP + kb), a1 = *(const LAS u2*)(vl + r * A2_VP + kb + 16);
                const u2 b0 = *(const LAS u2*)(vl + (32 + r) * A2_VP + kb), b1 = *(const LAS u2*)(vl + (32 + r) * A2_VP + kb + 16);
                u4 fa; fa.x = a0.x; fa.y = a0.y; fa.z = a1.x; fa.w = a1.y; u4 fb; fb.x = b0.x; fb.y = b0.y; fb.z = b1.x; fb.w = b1.y;
                o0 = mfma32(__builtin_bit_cast(s16x8, fa), pf[rt][s], o0);
                o1 = mfma32(__builtin_bit_cast(s16x8, fb), pf[rt][s], o1);
                o2 = mfma32(onesf, pf[rt][s], o2);
            }
    };
    int bi = 0, pbi = 0;
    for (int st = 0; st <= nst; ++st) {
        LAS unsigned char* kl = lds + bi * A2_BUF; LAS unsigned char* vl = kl + A2_KB;
        if (st < nst) {
            *(LAS u4*)(kl + srow * A2_KP + 16 * sch) = kreg0; *(LAS u4*)(kl + (64 + srow) * A2_KP + 16 * sch) = kreg1;
            *(LAS u4*)(vl + srow * A2_VP + 16 * sch) = vreg0; *(LAS u4*)(vl + srow * A2_VP + 128 + 16 * sch) = vreg1;
        }
        __syncthreads();
        { const int sn = st + 1 < nst ? st + 1 : nst - 1;
          kreg0 = *(const u4*)(kg + (size_t)sn * 128 * 256); kreg1 = *(const u4*)(kg + (size_t)(sn * 128 + 64) * 256); vreg0 = *(const u4*)(vg + sn * 128); vreg1 = *(const u4*)(vg + sn * 128 + 64); }
        if (late && st > 0) pv(lds + pbi * A2_BUF + A2_KB);
        if (st < nst) {
            f16v sc[4];
#pragma unroll
            for (int rt = 0; rt < 4; ++rt) {
#pragma unroll
                for (int i = 0; i < 16; ++i) sc[rt][i] = 0.f;
#pragma unroll
                for (int ks = 0; ks < 4; ++ks) sc[rt] = mfma32(*(const LAS s16x8*)(kl + (32 * rt + r) * A2_KP + 32 * ks + 16 * hi), qf[ks], sc[rt]);
            }
#pragma unroll
            for (int rt = 0; rt < 4; ++rt) { const unsigned mw = mrow[4 * st + rt];
#pragma unroll
                for (int i = 0; i < 16; ++i) { sc[rt][i] = __uint_as_float(__float_as_uint(__builtin_amdgcn_exp2f(sc[rt][i])) & (unsigned)__builtin_amdgcn_sbfe((int)mw, crow(i, hi), 1)); }
#pragma unroll
                for (int s = 0; s < 2; ++s) { u4 w; w.x = pkclamp(pk2(sc[rt][8 * s + 0], sc[rt][8 * s + 1])); w.y = pkclamp(pk2(sc[rt][8 * s + 2], sc[rt][8 * s + 3])); w.z = pkclamp(pk2(sc[rt][8 * s + 4], sc[rt][8 * s + 5]));
                    w.w = pkclamp(pk2(sc[rt][8 * s + 6], sc[rt][8 * s + 7]));
                    pf[rt][s] = __builtin_bit_cast(s16x8, w); }
            }
            if (!late) pv(vl);
        }
        pbi = bi; bi = bi == 2 ? 0 : bi + 1;
    }
    const float lsum = o2[0] + __shfl_xor(o2[0], 32);
    const float inv = 1.0f / lsum;
    bf16* yo = YA + (size_t)qrow * YCP + head * 64;
#pragma unroll
    for (int k = 0; k < 2; ++k) {
        u2 a, c, e, f;
        a.x = pk2(o0[8 * k + 0] * inv, o0[8 * k + 1] * inv); a.y = pk2(o0[8 * k + 2] * inv, o0[8 * k + 3] * inv);
        c.x = pk2(o0[8 * k + 4] * inv, o0[8 * k + 5] * inv); c.y = pk2(o0[8 * k + 6] * inv, o0[8 * k + 7] * inv);
        e.x = pk2(o1[8 * k + 0] * inv, o1[8 * k + 1] * inv); e.y = pk2(o1[8 * k + 2] * inv, o1[8 * k + 3] * inv);
        f.x = pk2(o1[8 * k + 4] * inv, o1[8 * k + 5] * inv); f.y = pk2(o1[8 * k + 6] * inv, o1[8 * k + 7] * inv);
        { auto r0 = __builtin_amdgcn_permlane32_swap(a.x, c.x, false, false); a.x = r0[0]; c.x = r0[1]; auto r1 = __builtin_amdgcn_permlane32_swap(a.y, c.y, false, false); a.y = r1[0]; c.y = r1[1]; }
        { auto r0 = __builtin_amdgcn_permlane32_swap(e.x, f.x, false, false); e.x = r0[0]; f.x = r0[1]; auto r1 = __builtin_amdgcn_permlane32_swap(e.y, f.y, false, false); e.y = r1[0]; f.y = r1[1]; }
        u4 w0; w0.x = a.x; w0.y = a.y; w0.z = c.x; w0.w = c.y;
        u4 w1; w1.x = e.x; w1.y = e.y; w1.z = f.x; w1.w = f.y;
        *(u4*)(yo + 16 * k + 8 * hi) = w0;
        *(u4*)(yo + 32 + 16 * k + 8 * hi) = w1;
    }
    __syncthreads();
}

constexpr int SM_Q = 0  , SM_QI = 4096  , SM_WI = 6144  , SM_TMP = 6208  , SM_SCN = 6336  , SM_CNT = 6400  ,
              SM_WOFF = 6528  , SM_SEL = 6656  , SM_S = 8192  , SM_END = 8192 + 16384;
__device__ __forceinline__ void sample_query_unit(LAS unsigned char* lds, int tid, const bf16* __restrict__ Q, const bf16* __restrict__ QI, const float* __restrict__ MISCB, const float* __restrict__ SCS,
                                                  const float* __restrict__ ck, const float* __restrict__ cv, const int* __restrict__ ptab, const float* __restrict__ out, bf16* __restrict__ YA, int b, int tq) {
    const int lane = tid & 63, wave = __builtin_amdgcn_readfirstlane(tid >> 6);
    const int qrow = MP + 4 * b + tq;
    LAS float* q_l = (LAS float*)(lds + SM_Q); LAS float* qi_l = (LAS float*)(lds + SM_QI); LAS float* wi_l = (LAS float*)(lds + SM_WI); LAS float* tmp_l = (LAS float*)(lds + SM_TMP);
    LAS float* scn_l = (LAS float*)(lds + SM_SCN); LAS unsigned* cnt_l = (LAS unsigned*)(lds + SM_CNT); LAS unsigned* woff_l = (LAS unsigned*)(lds + SM_WOFF);
    LAS int* sel_l = (LAS int*)(lds + SM_SEL); LAS float* s_l = (LAS float*)(lds + SM_S);
    { const unsigned w = *(const unsigned*)(Q + (size_t)qrow * 1024 + 2 * tid); q_l[2 * tid] = __uint_as_float(w << 16); q_l[2 * tid + 1] = __uint_as_float(w & 0xffff0000u); }
    { const unsigned short w = QI[(size_t)qrow * 512 + tid]; qi_l[tid] = __uint_as_float((unsigned)w << 16); }
    if (tid < 8) wi_l[tid] = MISCB[(size_t)qrow * 256 + 96 + tid];
    __syncthreads();
    if (tid < 32) {
        const int h = tid >> 2, kk = tid & 3; const float* kin = MISCB + (size_t)(MP + 4 * b + kk) * 256 + 32; float d = 0.f;
        f4 kr[16];
#pragma unroll
        for (int e4 = 0; e4 < 16; ++e4) kr[e4] = *(const f4*)(kin + 4 * e4);
#pragma unroll
        for (int e4 = 0; e4 < 16; ++e4) d += qi_l[h * 64 + 4 * e4] * kr[e4].x + qi_l[h * 64 + 4 * e4 + 1] * kr[e4].y + qi_l[h * 64 + 4 * e4 + 2] * kr[e4].z + qi_l[h * 64 + 4 * e4 + 3] * kr[e4].w;
        tmp_l[tid] = wi_l[h] * fmaxf(d, 0.f);
    }
    __syncthreads();
    if (tid < 4) { float s = 0.f; for (int h = 0; h < 8; ++h) s += tmp_l[h * 4 + tid]; scn_l[tid] = s; }
    __syncthreads();
    unsigned key[36];
    { const float* srow = SCS + (size_t)(4 * b + tq) * 16640 + 32 * tid;
#pragma unroll
      for (int i4 = 0; i4 < 8; ++i4) { const f4 v = *(const f4*)(srow + 4 * i4); key[4 * i4] = f2key(v.x); key[4 * i4 + 1] = f2key(v.y); key[4 * i4 + 2] = f2key(v.z); key[4 * i4 + 3] = f2key(v.w); }
#pragma unroll
      for (int e = 0; e < 4; ++e) key[32 + e] = (tid == 511 && e <= tq) ? f2key(scn_l[e]) : 0u; }
    unsigned prefix = 0u; int par = 0;
    for (int bit = 31; bit >= 1; bit -= 2) {
        const unsigned cA = prefix | (1u << (bit - 1)), cB = prefix | (1u << bit), cC = cB | (1u << (bit - 1));
        int nA = 0, nB = 0, nC = 0;
#pragma unroll
        for (int i = 0; i < 36; ++i) { nA += (key[i] >= cA) ? 1 : 0; nB += (key[i] >= cB) ? 1 : 0; nC += (key[i] >= cC) ? 1 : 0; }
#define SQ_DPP_ADD(v, ctrl, rmask) v += __builtin_amdgcn_update_dpp(0, v, ctrl, rmask, 0xf, false)
#define SQ_WAVE_SUM(v) SQ_DPP_ADD(v, 0x111, 0xf); SQ_DPP_ADD(v, 0x112, 0xf); SQ_DPP_ADD(v, 0x114, 0xf); SQ_DPP_ADD(v, 0x118, 0xf); SQ_DPP_ADD(v, 0x142, 0xa); SQ_DPP_ADD(v, 0x143, 0xc)
        SQ_WAVE_SUM(nA); SQ_WAVE_SUM(nB); SQ_WAVE_SUM(nC);
#undef SQ_WAVE_SUM
#undef SQ_DPP_ADD
        if (lane == 63) { cnt_l[par * 16 + wave] = (unsigned)nA | ((unsigned)nB << 16); cnt_l[par * 16 + 8 + wave] = (unsigned)nC; }
        __syncthreads();
        unsigned tx = 0u, ty = 0u;
#pragma unroll
        for (int w = 0; w < 8; ++w) { tx += cnt_l[par * 16 + w]; ty += cnt_l[par * 16 + 8 + w]; }
        if (ty >= 256u) prefix = cC; else if ((tx >> 16) >= 256u) prefix = cB; else if ((tx & 0xffffu) >= 256u) prefix = cA;
        par ^= 1;
    }
    int cgt = 0, ceq = 0;
#pragma unroll
    for (int i = 0; i < 36; ++i) { cgt += (key[i] > prefix) ? 1 : 0; ceq += (key[i] == prefix) ? 1 : 0; }
    int sgt = cgt, seq = ceq;
#pragma unroll
    for (int o = 1; o < 64; o <<= 1) { const int v0 = __shfl_up(sgt, o), v1 = __shfl_up(seq, o); if (lane >= o) { sgt += v0; seq += v1; } }
    __syncthreads();
    if (lane == 63) { cnt_l[wave] = (unsigned)sgt; cnt_l[8 + wave] = (unsigned)seq; }
    __syncthreads();
    unsigned tot_gt = 0u, eq_before = 0u;
#pragma unroll
    for (int w = 0; w < 8; ++w) { tot_gt += cnt_l[w]; if (w < wave) eq_before += cnt_l[8 + w]; }
    const unsigned need = 256u - tot_gt;
    unsigned long long selw = 0ull; unsigned run = eq_before + (unsigned)(seq - ceq);
    int csel = 0;
    asm volatile("" : "+v"(prefix));
#pragma unroll
    for (int i = 0; i < 36; ++i) { bool sel = key[i] > prefix; if (key[i] == prefix) { sel = run < need; ++run; } selw |= sel ? (1ull << i) : 0ull; csel += sel ? 1 : 0; }
    int ssel = csel;
#pragma unroll
    for (int o = 1; o < 64; o <<= 1) { const int v0 = __shfl_up(ssel, o); if (lane >= o) ssel += v0; }
    if (lane == 63) woff_l[wave] = (unsigned)ssel;
    __syncthreads();
    unsigned pos = (unsigned)(ssel - csel);
#pragma unroll
    for (int w = 0; w < 8; ++w) if (w < wave) pos += woff_l[w];
    const int pgbase = ptab[b * NPAGE + ((32 * tid) >> 7)] * PAGE;
#pragma unroll
    for (int i = 0; i < 36; ++i) if ((selw >> i) & 1ull) {
        const int s = (i < 32) ? 32 * tid + i : PAST + (i - 32);
        const int idx = (s < PAST) ? pgbase + (s & 127) : -1 - (s - PAST);
        if (pos < 256u) sel_l[pos] = idx;
        ++pos; }
    __syncthreads();
    {
        const int kvh = lane >> 4, dq = lane & 15;
        f4 qr[4];
#pragma unroll
        for (int hq = 0; hq < 4; ++hq) qr[hq] = *(const LAS f4*)(q_l + (4 * kvh + hq) * 64 + 4 * dq);
        f4 kr2[32];
#pragma unroll
        for (int j = 0; j < 32; ++j) { const int idx = sel_l[32 * wave + j];
            const float* krow = idx >= 0 ? ck + (size_t)idx * 256 : out + O_KS + (size_t)(4 * b + (-1 - idx)) * 256;
            kr2[j] = *(const f4*)(krow + 4 * lane); }
#pragma unroll
        for (int j = 0; j < 32; ++j)
#pragma unroll
            for (int hq = 0; hq < 4; ++hq) {
                float d = (kr2[j].x * qr[hq].x + kr2[j].y * qr[hq].y) + (kr2[j].z * qr[hq].z + kr2[j].w * qr[hq].w);
#define SQ_DPP_FADD(ctrl) d += __builtin_bit_cast(float, __builtin_amdgcn_update_dpp(0, __builtin_bit_cast(int, d), ctrl, 0xf, 0xf, false))
                SQ_DPP_FADD(0x111); SQ_DPP_FADD(0x112); SQ_DPP_FADD(0x114); SQ_DPP_FADD(0x118);
#undef SQ_DPP_FADD
                if (dq == 15) s_l[(4 * kvh + hq) * 256 + 32 * wave + j] = d * 0.125f;
            }
    }
    __syncthreads();
#pragma unroll
    for (int k2 = 0; k2 < 2; ++k2) {
        LAS float* sr = s_l + (2 * wave + k2) * 256;
        float v0 = sr[lane], v1 = sr[lane + 64], v2 = sr[lane + 128], v3 = sr[lane + 192];
        float mx = fmaxf(fmaxf(v0, v1), fmaxf(v2, v3));
#pragma unroll
        for (int o = 1; o < 64; o <<= 1) mx = fmaxf(mx, __shfl_xor(mx, o));
        v0 = __expf(v0 - mx); v1 = __expf(v1 - mx); v2 = __expf(v2 - mx); v3 = __expf(v3 - mx);
        const float inv = 1.0f / wave_sum((v0 + v1) + (v2 + v3));
        sr[lane] = v0 * inv; sr[lane + 64] = v1 * inv; sr[lane + 128] = v2 * inv; sr[lane + 192] = v3 * inv;
    }
    __syncthreads();
    {
        const int kvh = lane >> 4, dq = lane & 15;
        f4 vv[32];
#pragma unroll
        for (int j = 0; j < 32; ++j) { const int idx = sel_l[32 * wave + j];
            const float* vrow = idx >= 0 ? cv + (size_t)idx * 256 : out + O_VS + (size_t)(4 * b + (-1 - idx)) * 256;
            vv[j] = *(const f4*)(vrow + 4 * lane); }
        f4 acc[4] = {(f4){0.f, 0.f, 0.f, 0.f}, (f4){0.f, 0.f, 0.f, 0.f}, (f4){0.f, 0.f, 0.f, 0.f}, (f4){0.f, 0.f, 0.f, 0.f}};
#pragma unroll
        for (int j4 = 0; j4 < 8; ++j4)
#pragma unroll
            for (int hq = 0; hq < 4; ++hq) { const f4 p = *(const LAS f4*)(s_l + (4 * kvh + hq) * 256 + 32 * wave + 4 * j4);
                acc[hq] += p.x * vv[4 * j4] + p.y * vv[4 * j4 + 1] + p.z * vv[4 * j4 + 2] + p.w * vv[4 * j4 + 3]; }
        LAS float* red = (LAS float*)(lds + SM_END);
#pragma unroll
        for (int hq = 0; hq < 4; ++hq) *(LAS f4*)(red + ((wave * 16 + 4 * kvh + hq) * 64 + 4 * dq)) = acc[hq];
        __syncthreads();
        const int head = tid >> 5, d = 2 * (tid & 31); float a0 = 0.f, a1 = 0.f;
#pragma unroll
        for (int w = 0; w < 8; ++w) { const float* rp = nullptr; (void)rp; const LAS float* q2 = red + ((w * 16 + head) * 64 + d); a0 += q2[0]; a1 += q2[1]; }
        *(unsigned*)(YA + (size_t)qrow * YCP + head * 64 + d) = pk2(a0, a1);
    }
    __syncthreads();
}
}

namespace pg8 {
__device__ __forceinline__ float ep_silu(float x) { return x * __builtin_amdgcn_rcpf(1.0f + __expf(-x)); }
__device__ __forceinline__ float ep_sigm(float x) { return __builtin_amdgcn_rcpf(1.0f + __expf(-x)); }
struct EpiGU {
    static constexpr bool PERM = true, AFTER_DRAIN = false; static constexpr int HOOK_T = 0; static constexpr bool GROUPS = false;
    bf16_t* O;
    __device__ __forceinline__ void operator()(const f32x4 (&acc)[2][2][4][2], const Unit& u, int wr, int wc, int fr, int fq) const {
        const int row0 = u.pm * BM + wr * 64 + fr, col0 = u.pn * 128 + wc * 32 + 8 * fq;
#pragma unroll
        for (int ai = 0; ai < 2; ++ai)
#pragma unroll
            for (int m = 0; m < 4; ++m) {
                bf16_t* rowp = O + (size_t)(row0 + ai * HALF + m * 16) * 2816 + col0;
                const f32x4 g0 = acc[ai][0][m][0], g1 = acc[ai][0][m][1], u0 = acc[ai][1][m][0], u1 = acc[ai][1][m][1];
                u32x4 w;
                w.x = cvt_pk_bf16(ep_silu(g0[0]) * u0[0], ep_silu(g0[1]) * u0[1]); w.y = cvt_pk_bf16(ep_silu(g0[2]) * u0[2], ep_silu(g0[3]) * u0[3]);
                w.z = cvt_pk_bf16(ep_silu(g1[0]) * u1[0], ep_silu(g1[1]) * u1[1]); w.w = cvt_pk_bf16(ep_silu(g1[2]) * u1[2], ep_silu(g1[3]) * u1[3]);
                *(u32x4*)rowp = w;
            }
    }
};
struct EpiF32 {
    static constexpr bool PERM = false, AFTER_DRAIN = false; static constexpr int HOOK_T = 0; static constexpr bool GROUPS = false;
    float* O; int ldc;
    __device__ __forceinline__ void operator()(const f32x4 (&acc)[2][2][4][2], const Unit& u, int wr, int wc, int fr, int fq) const {
        const int row0 = u.pm * BM + wr * 64 + fr, col0 = u.pn * BM + wc * 32 + 4 * fq;
#pragma unroll
        for (int ai = 0; ai < 2; ++ai)
#pragma unroll
            for (int m = 0; m < 4; ++m) { float* rowp = O + (size_t)(row0 + ai * HALF + m * 16) * ldc + col0;
#pragma unroll
                for (int bj = 0; bj < 2; ++bj)
#pragma unroll
                    for (int n = 0; n < 2; ++n) *(f32x4*)(rowp + bj * HALF + n * 16) = acc[ai][bj][m][n]; }
    }
};
struct EpiB16 {
    static constexpr bool PERM = true, AFTER_DRAIN = false; static constexpr int HOOK_T = 0; static constexpr bool GROUPS = false;
    bf16_t* O; int ldc;
    __device__ __forceinline__ void operator()(const f32x4 (&acc)[2][2][4][2], const Unit& u, int wr, int wc, int fr, int fq) const {
        const int row0 = u.pm * BM + wr * 64 + fr, col0 = u.pn * BM + wc * 32 + 8 * fq;
#pragma unroll
        for (int ai = 0; ai < 2; ++ai)
#pragma unroll
            for (int m = 0; m < 4; ++m) { bf16_t* rowp = O + (size_t)(row0 + ai * HALF + m * 16) * ldc + col0;
#pragma unroll
                for (int bj = 0; bj < 2; ++bj) { const f32x4 v0 = acc[ai][bj][m][0], v1 = acc[ai][bj][m][1]; u32x4 w;
                    w.x = cvt_pk_bf16(v0[0], v0[1]); w.y = cvt_pk_bf16(v0[2], v0[3]); w.z = cvt_pk_bf16(v1[0], v1[1]); w.w = cvt_pk_bf16(v1[2], v1[3]);
                    *(u32x4*)(rowp + bj * HALF) = w; } }
    }
};
struct EpiMemKV {
    static constexpr bool PERM = false, AFTER_DRAIN = false; static constexpr int HOOK_T = 0; static constexpr bool GROUPS = false;
    float* outk; float* outv; bf16_t* mkb;
    __device__ __forceinline__ void operator()(const f32x4 (&acc)[2][2][4][2], const Unit& u, int wr, int wc, int fr, int fq) const {
        const bool isv = u.pn >= 4; float* O = isv ? outv : outk;
        const int row0 = u.pm * BM + wr * 64 + fr, col0 = (u.pn & 3) * BM + wc * 32 + 4 * fq;
#pragma unroll
        for (int ai = 0; ai < 2; ++ai)
#pragma unroll
            for (int m = 0; m < 4; ++m) { const size_t off = (size_t)(row0 + ai * HALF + m * 16) * 1024 + col0;
#pragma unroll
                for (int bj = 0; bj < 2; ++bj)
#pragma unroll
                    for (int n = 0; n < 2; ++n) { const f32x4 v = acc[ai][bj][m][n]; *(f32x4*)(O + off + bj * HALF + n * 16) = v;
                        if (!isv) { typedef unsigned u32x2v __attribute__((ext_vector_type(2))); u32x2v w; w.x = cvt_pk_bf16(v[0], v[1]); w.y = cvt_pk_bf16(v[2], v[3]);
                            *(u32x2v*)(mkb + off + bj * HALF + n * 16) = w; } } }
    }
};
struct EpiWin {
    static constexpr bool PERM = true, AFTER_DRAIN = false; static constexpr int HOOK_T = 0; static constexpr bool GROUPS = false;
    bf16_t *Z, *XBC, *Q, *KB, *QI, *GS, *GA, *KIB; float* MISC; float* out;
    __device__ __forceinline__ void operator()(const f32x4 (&acc)[2][2][4][2], const Unit& u, int wr, int wc, int fr, int fq) const {
        const int pn = u.pn, row0 = u.pm * BM + wr * 64 + fr, cl = wc * 32 + 8 * fq;
        bf16_t* base = nullptr; int ld = 0, colt = 0, kind = 0;
        if (pn < 8) { base = Z; ld = 2048; colt = pn * 256; }
        else if (pn < 24) { base = XBC; ld = 4096; colt = (pn - 8) * 256; kind = 1; }
        else if (pn < 28) { base = Q; ld = 1024; colt = (pn - 24) * 256; }
        else if (pn == 28) { base = KB; ld = 256; colt = 0; kind = 2; }
        else if (pn == 29) { kind = 3; }
        else if (pn < 32) { base = QI; ld = 512; colt = (pn - 30) * 256; }
        else if (pn < 36) { base = GS; ld = 1024; colt = (pn - 32) * 256; }
        else if (pn < 40) { base = GA; ld = 1024; colt = (pn - 36) * 256; }
        else kind = 4;
#pragma unroll
        for (int ai = 0; ai < 2; ++ai)
#pragma unroll
            for (int m = 0; m < 4; ++m) {
                const int row = row0 + ai * HALF + m * 16;
#pragma unroll
                for (int bj = 0; bj < 2; ++bj) {
                    const int c = colt + bj * HALF + cl;
                    const f32x4 v0 = acc[ai][bj][m][0], v1 = acc[ai][bj][m][1];
                    u32x4 w; w.x = cvt_pk_bf16(v0[0], v0[1]); w.y = cvt_pk_bf16(v0[2], v0[3]); w.z = cvt_pk_bf16(v1[0], v1[1]); w.w = cvt_pk_bf16(v1[2], v1[3]);
                    if (base) *(u32x4*)(base + (size_t)row * ld + c) = w;
                    if (kind == 1) {
                        float* o = nullptr;
                        if (row < 16384) { const int tt = row & 2047; if (tt >= 2045) o = out + 28442624 + (size_t)((row >> 11) * 3 + (tt - 2045)) * 4096 + c; }
                        else if (row < 16512) { const int rs = row - 16384, t4 = rs & 3; if (t4 >= 1) o = out + 41197568 + (size_t)((rs >> 2) * 3 + (t4 - 1)) * 4096 + c; }
                        if (o) { *(f32x4*)o = v0; *(f32x4*)(o + 4) = v1; }
                    } else if (kind == 2 || kind == 3) {
                        float* o = nullptr;
                        if (row < 16384) o = out + (kind == 2 ? 16908288 : 21102592) + (size_t)row * 256 + c;
                        else if (row < 16512) o = out + (kind == 2 ? 32735232 : 32768000) + (size_t)(row - 16384) * 256 + c;
                        if (o) { *(f32x4*)o = v0; *(f32x4*)(o + 4) = v1; }
                    } else if (kind == 4) {
                        float* mo = MISC + (size_t)row * 256 + c; *(f32x4*)mo = v0; *(f32x4*)(mo + 4) = v1;
                        if (c >= 32 && c < 96) {
                            *(u32x4*)(KIB + (size_t)row * 64 + (c - 32)) = w;
                            float* o = nullptr;
                            if (row < 16384) o = out + 25296896 + (size_t)row * 64 + (c - 32);
                            else if (row < 16512) o = out + 32800768 + (size_t)(row - 16384) * 64 + (c - 32);
                            if (o) { *(f32x4*)o = v0; *(f32x4*)(o + 4) = v1; }
                        }
                    }
                }
            }
    }
};
}
static_assert(O_CONVP == 28442624 && O_CONVS == 41197568 && O_KP == 16908288 && O_VP == 21102592 && O_KS == 32735232 && O_VS == 32768000 && O_KIP == 25296896 && O_KIS == 32800768, "offsets used in EpiWin");


namespace mema {
typedef short s16x8 __attribute__((ext_vector_type(8)));
typedef float f4 __attribute__((ext_vector_type(4)));
typedef unsigned u2 __attribute__((ext_vector_type(2)));
typedef unsigned u4 __attribute__((ext_vector_type(4)));
__device__ __forceinline__ f4 mfma16(s16x8 a, s16x8 b, f4 c) { return __builtin_amdgcn_mfma_f32_16x16x32_bf16(a, b, c, 0, 0, 0); }
__device__ __forceinline__ void mem_stage_load(int tid, const bf16* __restrict__ src  , int pitch, u4 (&v)[16]) {
#pragma unroll
    for (int i = 0; i < 16; ++i) { const int idx = i * 512 + tid, row = idx >> 5, c = idx & 31; v[i] = *(const u4*)(src + (size_t)row * pitch + 8 * c); }
}
__device__ __forceinline__ void mem_stage_store(LAS unsigned char* lds, int tid, const u4 (&v)[16]) {
#pragma unroll
    for (int i = 0; i < 16; ++i) { const int idx = i * 512 + tid, row = idx >> 5, c = idx & 31; *(LAS u4*)(lds + row * 512 + ((c ^ (row & 15)) << 4)) = v[i]; }
}
__device__ __forceinline__ void memattn_unit(LAS unsigned char* lds, int tid, const bf16* __restrict__ QM, const bf16* __restrict__ MKB, const bf16* __restrict__ MVT, bf16* __restrict__ OM,
                                             int bm, int head, int qrow0, int nq) {
    const int lane = tid & 63, wave = __builtin_amdgcn_readfirstlane(tid >> 6), l15 = lane & 15, lq = lane >> 4;
    const bool active = 16 * wave < nq;
    const int t = 16 * wave + l15, qrow = qrow0 + (t < nq ? t : nq - 1);
    s16x8 qf[8];
#pragma unroll
    for (int ks = 0; ks < 8; ++ks) qf[ks] = *(const s16x8*)(QM + (size_t)qrow * 1024 + head * 256 + 32 * ks + 8 * lq);
    u4 stg[16];
    mem_stage_load(tid, MKB + (size_t)bm * 256 * 1024 + head * 256, 1024, stg);
    mem_stage_store(lds, tid, stg);
    s16x8 pf[8]; float inv = 0.f;
    __syncthreads();
    f4 s[16];
    if (active) {
#pragma unroll
        for (int kt = 0; kt < 16; ++kt) { s[kt] = (f4){0.f, 0.f, 0.f, 0.f};
#pragma unroll
            for (int ks = 0; ks < 8; ++ks) s[kt] = mfma16(*(const LAS s16x8*)(lds + (16 * kt + l15) * 512 + (((4 * ks + lq) ^ l15) << 4)), qf[ks], s[kt]); }
    }
    mem_stage_load(tid, MVT + ((size_t)bm * 1024 + head * 256) * 256, 256, stg);
    if (active) {
        float mx = -1e30f;
#pragma unroll
        for (int kt = 0; kt < 16; ++kt) mx = fmaxf(mx, fmaxf(fmaxf(s[kt].x, s[kt].y), fmaxf(s[kt].z, s[kt].w)));
        mx = fmaxf(mx, __shfl_xor(mx, 16)); mx = fmaxf(mx, __shfl_xor(mx, 32));
        const float c2 = 0.0625f * 1.4426950408889634f; float sum = 0.f;
#pragma unroll
        for (int kt = 0; kt < 16; ++kt) { s[kt].x = __builtin_amdgcn_exp2f((s[kt].x - mx) * c2); s[kt].y = __builtin_amdgcn_exp2f((s[kt].y - mx) * c2);
            s[kt].z = __builtin_amdgcn_exp2f((s[kt].z - mx) * c2); s[kt].w = __builtin_amdgcn_exp2f((s[kt].w - mx) * c2); sum += (s[kt].x + s[kt].y) + (s[kt].z + s[kt].w); }
        sum += __shfl_xor(sum, 16); sum += __shfl_xor(sum, 32);
        inv = 1.0f / sum;
#pragma unroll
        for (int s8 = 0; s8 < 8; ++s8) { u4 w; w.x = pk2(s[2 * s8].x, s[2 * s8].y); w.y = pk2(s[2 * s8].z, s[2 * s8].w); w.z = pk2(s[2 * s8 + 1].x, s[2 * s8 + 1].y); w.w = pk2(s[2 * s8 + 1].z, s[2 * s8 + 1].w);
            pf[s8] = __builtin_bit_cast(s16x8, w); }
    }
    __syncthreads();
    mem_stage_store(lds, tid, stg);
    __syncthreads();
    if (active) {
        bf16* orow = OM + (size_t)qrow * 1024 + head * 256 + 4 * lq;
#pragma unroll 4
        for (int dt = 0; dt < 16; ++dt) { f4 o = (f4){0.f, 0.f, 0.f, 0.f};
            const LAS unsigned char* vr = lds + (16 * dt + l15) * 512 + 8 * (lq & 1);
#pragma unroll
            for (int s8 = 0; s8 < 8; ++s8) { const int c = 4 * s8 + (lq >> 1);
                const u2 a0 = *(const LAS u2*)(vr + ((c ^ l15) << 4)), a1 = *(const LAS u2*)(vr + (((c + 2) ^ l15) << 4));
                u4 fa; fa.x = a0.x; fa.y = a0.y; fa.z = a1.x; fa.w = a1.y;
                o = mfma16(__builtin_bit_cast(s16x8, fa), pf[s8], o); }
            if (t < nq) { u2 w; w.x = pk2(o.x * inv, o.y * inv); w.y = pk2(o.z * inv, o.w * inv); *(u2*)(orow + 16 * dt) = w; }
        }
    }
    __syncthreads();
}
}

namespace pg8 {
struct EpiGateS {
    static constexpr bool PERM = false, AFTER_DRAIN = false; static constexpr int HOOK_T = 0; static constexpr bool GROUPS = false;
    float* F; const bf16_t* G;
    __device__ __forceinline__ void operator()(const f32x4 (&acc)[2][2][4][2], const Unit& u, int wr, int wc, int fr, int fq) const {
        typedef unsigned u32x2v __attribute__((ext_vector_type(2)));
        const int row0 = u.pm * BM + wr * 64 + fr, col0 = u.pn * BM + wc * 32 + 4 * fq;
#pragma unroll
        for (int ai = 0; ai < 2; ++ai)
#pragma unroll
            for (int m = 0; m < 4; ++m) { const size_t off = (size_t)(row0 + ai * HALF + m * 16) * 1024 + col0;
#pragma unroll
                for (int bj = 0; bj < 2; ++bj)
#pragma unroll
                    for (int n = 0; n < 2; ++n) { const u32x2v g = *(const u32x2v*)(G + off + bj * HALF + n * 16); const f32x4 v = acc[ai][bj][m][n]; f32x4 o;
                        o[0] = v[0] * ep_sigm(__uint_as_float(g.x << 16)); o[1] = v[1] * ep_sigm(__uint_as_float(g.x & 0xffff0000u));
                        o[2] = v[2] * ep_sigm(__uint_as_float(g.y << 16)); o[3] = v[3] * ep_sigm(__uint_as_float(g.y & 0xffff0000u));
                        *(f32x4*)(F + off + bj * HALF + n * 16) = o; } }
    }
};
struct EpiGateA {
    static constexpr bool PERM = false, AFTER_DRAIN = false; static constexpr int HOOK_T = 0; static constexpr bool GROUPS = false;
    const float* F; const bf16_t* G; bf16_t* O;
    __device__ __forceinline__ void operator()(const f32x4 (&acc)[2][2][4][2], const Unit& u, int wr, int wc, int fr, int fq) const {
        typedef unsigned u32x2v __attribute__((ext_vector_type(2)));
        const int row0 = u.pm * BM + wr * 64 + fr, col0 = u.pn * BM + wc * 32 + 4 * fq;
#pragma unroll
        for (int ai = 0; ai < 2; ++ai)
#pragma unroll
            for (int m = 0; m < 4; ++m) { const size_t off = (size_t)(row0 + ai * HALF + m * 16) * 1024 + col0;
#pragma unroll
                for (int bj = 0; bj < 2; ++bj)
#pragma unroll
                    for (int n = 0; n < 2; ++n) { const u32x2v g = *(const u32x2v*)(G + off + bj * HALF + n * 16); const f32x4 v = acc[ai][bj][m][n]; const f32x4 f = *(const f32x4*)(F + off + bj * HALF + n * 16);
                        u32x2v w;
                        w.x = cvt_pk_bf16(f[0] + v[0] * ep_sigm(__uint_as_float(g.x << 16)), f[1] + v[1] * ep_sigm(__uint_as_float(g.x & 0xffff0000u)));
                        w.y = cvt_pk_bf16(f[2] + v[2] * ep_sigm(__uint_as_float(g.y << 16)), f[3] + v[3] * ep_sigm(__uint_as_float(g.y & 0xffff0000u)));
                        *(u32x2v*)(O + off + bj * HALF + n * 16) = w; } }
    }
};
struct EpiGateC {
    static constexpr bool PERM = false, AFTER_DRAIN = false; static constexpr int HOOK_T = 32; static constexpr bool GROUPS = true;
    const bf16_t* GS; const bf16_t* GA; bf16_t* O; const float* SSQ; LAS float* RT;
    template <bool LIGHT>
    __device__ __forceinline__ void fill(const Unit& u, int tl_in) const {
        int tl = tl_in; asm volatile("" : "+v"(tl));
        const int rl = tl >> 1, hf = tl & 1;
        const float* sp = SSQ + (size_t)(u.pm * BM + rl) * 32 + 16 * hf;
        float og[4];
#pragma unroll
        for (int g = 0; g < 4; ++g) { const f32x4 s = *(const f32x4*)(sp + 4 * g); float t = ((s[0] + s[1]) + (s[2] + s[3])) * (1.0f / 256.0f) + EPS;
            if (LIGHT) asm volatile("" : "+v"(t) :: "memory");
            og[g] = t; }
        *(LAS f32x4*)(RT + rl * 8 + 4 * hf) = (f32x4){og[0], og[1], og[2], og[3]};
    }
    __device__ __forceinline__ void hookg(f32x4 (&acc)[2][2][4][2], int j, int wr, int fr) const {
        int rb = (wr * 64 + fr) * 8 + j; asm volatile("" : "+v"(rb));
#pragma unroll
        for (int ai = 0; ai < 2; ++ai)
#pragma unroll
            for (int m = 0; m < 4; ++m) { const float va = RT[rb + (ai * HALF + m * 16) * 8 - 1], vb = RT[rb + (ai * HALF + m * 16) * 8];
                const float r = __builtin_amdgcn_sqrtf(vb * __builtin_amdgcn_rcpf(va));
#pragma unroll
                for (int bj = 0; bj < 2; ++bj)
#pragma unroll
                    for (int n = 0; n < 2; ++n) acc[ai][bj][m][n] = acc[ai][bj][m][n] * r;
                asm volatile("" ::: "memory"); }
    }
    __device__ __forceinline__ void hook(f32x4 (&acc)[2][2][4][2], const Unit& u, int wr, int wc, int fr, int fq) const {
        typedef unsigned u32x2v __attribute__((ext_vector_type(2)));
        int row0 = u.pm * BM + wr * 64 + fr, col0 = u.pn * BM + wc * 32 + 4 * fq, rb = (wr * 64 + fr) * 8;
        asm volatile("" : "+v"(row0), "+v"(col0), "+v"(rb));
#pragma unroll
        for (int ai = 0; ai < 2; ++ai)
#pragma unroll
            for (int m = 0; m < 4; ++m) { const size_t off = (size_t)(row0 + ai * HALF + m * 16) * 1024 + col0; const float rs7 = __builtin_amdgcn_rsqf(RT[rb + (ai * HALF + m * 16) * 8 + 7]);
#pragma unroll
                for (int bj = 0; bj < 2; ++bj)
#pragma unroll
                    for (int n = 0; n < 2; ++n) { const u32x2v gs = *(const u32x2v*)(GS + off + bj * HALF + n * 16), ga = *(const u32x2v*)(GA + off + bj * HALF + n * 16);
                        f32x4 r;
                        r[0] = (1.0f + __expf(-__uint_as_float(ga.x << 16))) * __builtin_amdgcn_rcpf(1.0f + __expf(-__uint_as_float(gs.x << 16)));
                        r[1] = (1.0f + __expf(-__uint_as_float(ga.x & 0xffff0000u))) * __builtin_amdgcn_rcpf(1.0f + __expf(-__uint_as_float(gs.x & 0xffff0000u)));
                        r[2] = (1.0f + __expf(-__uint_as_float(ga.y << 16))) * __builtin_amdgcn_rcpf(1.0f + __expf(-__uint_as_float(gs.y << 16)));
                        r[3] = (1.0f + __expf(-__uint_as_float(ga.y & 0xffff0000u))) * __builtin_amdgcn_rcpf(1.0f + __expf(-__uint_as_float(gs.y & 0xffff0000u)));
                        acc[ai][bj][m][n] = acc[ai][bj][m][n] * (r * rs7); }
                asm volatile("" ::: "memory"); }
    }
    __device__ __forceinline__ void operator()(const f32x4 (&acc)[2][2][4][2], const Unit& u, int wr, int wc, int fr, int fq) const {
        typedef unsigned u32x2v __attribute__((ext_vector_type(2)));
        const int row0 = u.pm * BM + wr * 64 + fr, col0 = u.pn * BM + wc * 32 + 4 * fq;
#pragma unroll
        for (int ai = 0; ai < 2; ++ai)
#pragma unroll
            for (int m = 0; m < 4; ++m) { const size_t off = (size_t)(row0 + ai * HALF + m * 16) * 1024 + col0;
#pragma unroll
                for (int bj = 0; bj < 2; ++bj)
#pragma unroll
                    for (int n = 0; n < 2; ++n) { const u32x2v ga = *(const u32x2v*)(GA + off + bj * HALF + n * 16); const f32x4 v = acc[ai][bj][m][n]; u32x2v w;
                        w.x = cvt_pk_bf16(v[0] * ep_sigm(__uint_as_float(ga.x << 16)), v[1] * ep_sigm(__uint_as_float(ga.x & 0xffff0000u)));
                        w.y = cvt_pk_bf16(v[2] * ep_sigm(__uint_as_float(ga.y << 16)), v[3] * ep_sigm(__uint_as_float(ga.y & 0xffff0000u)));
                        *(u32x2v*)(O + off + bj * HALF + n * 16) = w; } }
    }
};
}

namespace sgemm {
typedef short s16x8 __attribute__((ext_vector_type(8)));
typedef float f4 __attribute__((ext_vector_type(4)));
__device__ __forceinline__ f4 mfma16(s16x8 a, s16x8 b, f4 c) { return __builtin_amdgcn_mfma_f32_16x16x32_bf16(a, b, c, 0, 0, 0); }
__device__ __forceinline__ void part(const bf16* __restrict__ A, int lda, const bf16* __restrict__ W, int ldw, int K, int rb, int cb, int wave, int l15, int lq, f4 (&acc)[2]) {
    const int ksl = K >> 3, k0 = wave * ksl;
    const bf16* ap = A + (size_t)(MP + 32 * rb + l15) * lda + k0 + 8 * lq;
    const bf16* wp = W + (size_t)(16 * cb + l15) * ldw + k0 + 8 * lq;
    for (int ks = 0; ks < (ksl >> 5); ++ks) {
        const s16x8 bf = *(const s16x8*)(wp + 32 * ks);
        acc[0] = mfma16(*(const s16x8*)(ap + 32 * ks), bf, acc[0]);
        acc[1] = mfma16(*(const s16x8*)(ap + (size_t)16 * lda + 32 * ks), bf, acc[1]);
    }
}
template <int MODE>
__device__ __forceinline__ void run(LAS unsigned char* lds, int tid, int item, const bf16* __restrict__ A1, int lda1, const bf16* __restrict__ W1, int ldw1, int K1,
                                    const bf16* __restrict__ A2, int lda2, const bf16* __restrict__ W2, int ldw2, int K2,
                                    float* __restrict__ Of, bf16* __restrict__ Ob, const bf16* __restrict__ GS, const bf16* __restrict__ GA, const float* __restrict__ SSQ = nullptr) {
    const int lane = tid & 63, wave = __builtin_amdgcn_readfirstlane(tid >> 6), l15 = lane & 15, lq = lane >> 4;
    const int rb = item & 3, cb = item >> 2;
    f4 acc[2] = {(f4){0.f, 0.f, 0.f, 0.f}, (f4){0.f, 0.f, 0.f, 0.f}};
    part(A1, lda1, W1, ldw1, K1, rb, cb, wave, l15, lq, acc);
    if (MODE == 2) {
#pragma unroll
        for (int rt = 0; rt < 2; ++rt)
#pragma unroll
            for (int e = 0; e < 4; ++e) { const f4 s = *(const f4*)(SSQ + (size_t)(MP + 32 * rb + 16 * rt + 4 * lq + e) * 32 + 4 * wave);
                acc[rt][e] *= 1.0f / sqrtf(((s.x + s.y) + (s.z + s.w)) * (1.0f / 256.0f) + EPS); }
    }
    LAS float* red = (LAS float*)lds;
#pragma unroll
    for (int rt = 0; rt < 2; ++rt) { red[(wave * 32 + 16 * rt + 4 * lq + 0) * 16 + l15] = acc[rt].x; red[(wave * 32 + 16 * rt + 4 * lq + 1) * 16 + l15] = acc[rt].y;
        red[(wave * 32 + 16 * rt + 4 * lq + 2) * 16 + l15] = acc[rt].z; red[(wave * 32 + 16 * rt + 4 * lq + 3) * 16 + l15] = acc[rt].w; }
    if (MODE == 2) {
        f4 ac2[2] = {(f4){0.f, 0.f, 0.f, 0.f}, (f4){0.f, 0.f, 0.f, 0.f}};
        part(A2, lda2, W2, ldw2, K2, rb, cb, wave, l15, lq, ac2);
#pragma unroll
        for (int rt = 0; rt < 2; ++rt) { red[4096 + (wave * 32 + 16 * rt + 4 * lq + 0) * 16 + l15] = ac2[rt].x; red[4096 + (wave * 32 + 16 * rt + 4 * lq + 1) * 16 + l15] = ac2[rt].y;
            red[4096 + (wave * 32 + 16 * rt + 4 * lq + 2) * 16 + l15] = ac2[rt].z; red[4096 + (wave * 32 + 16 * rt + 4 * lq + 3) * 16 + l15] = ac2[rt].w; }
    }
    __syncthreads();
    { const int r = tid >> 4, c = tid & 15; float v = 0.f;
#pragma unroll
      for (int w = 0; w < 8; ++w) v += red[(w * 32 + r) * 16 + c];
      const size_t o = (size_t)(MP + 32 * rb + r) * 1024 + 16 * cb + c;
      if (MODE == 0) Of[o] = v;
      else if (MODE == 1) Ob[o] = (bf16)f2bf(v);
      else { float v2 = 0.f;
#pragma unroll
          for (int w = 0; w < 8; ++w) v2 += red[4096 + (w * 32 + r) * 16 + c];
          const float gs = __uint_as_float((unsigned)GS[o] << 16), ga = __uint_as_float((unsigned)GA[o] << 16);
          Ob[o] = (bf16)f2bf(v * sigmoid_f(gs) + v2 * sigmoid_f(ga)); } }
    __syncthreads();
}
}
__global__ void __launch_bounds__(NWAVES * 64, 2) mega_fwd(Args a_unused) {
    extern __shared__ __attribute__((aligned(16))) unsigned char lds_raw[];
    LAS unsigned char* lds = (LAS unsigned char*)lds_raw;
    volatile LAS unsigned* MISCW = (volatile LAS unsigned*)(lds + MISC_OFF);
    const int wave0 = __builtin_amdgcn_readfirstlane(threadIdx.x >> 6);
    const KArgs ap0 = (KArgs)__builtin_amdgcn_kernarg_segment_ptr();
    for (int u = threadIdx.x; u < (LDS_BYTES - LDSCTL_OFF) / 4; u += NWAVES * 64) ((LAS unsigned*)(lds + LDSCTL_OFF))[u] = 0u;
    __syncthreads();
    (void)xcd_barrier_post((unsigned*)(ap0->ws + WS_CTL) + CW_BAR, MISCW + 8);
#ifdef DBG_T1
#define DBG_STAMP(k_) if (blockIdx.x == 0 && tid == 0) { KArgs as_ = ap0; asm volatile("" : "+s"(as_)); ((unsigned long long*)(as_->ws + WS_CTL + 512 * 1024))[k_] = __builtin_amdgcn_s_memrealtime(); }
#else
#define DBG_STAMP(k_)
#endif
#ifdef DBG_U1
#define UT_BEGIN() const unsigned long long ut0_ = __builtin_amdgcn_s_memrealtime();
#define UT_END(ty_) if (tu == 0) { KArgs au_ = ap0; asm volatile("" : "+s"(au_)); atomicAdd((unsigned*)(au_->ws + WS_CTL + 768 * 1024) + (ty_), (unsigned)(__builtin_amdgcn_s_memrealtime() - ut0_)); }
#else
#define UT_BEGIN()
#define UT_END(ty_)
#endif
#define TID_FRESH(tv) int tv; { unsigned m_ = ~0u; asm volatile("" : "+s"(m_)); tv = wave0 * 64 + (int)__builtin_amdgcn_mbcnt_hi(m_, __builtin_amdgcn_mbcnt_lo(m_, 0u)); }
#define PH_BEGIN(k_) { TID_FRESH(tid) DBG_STAMP(k_) KArgs a = ap0; asm volatile("" : "+s"(a)); \
    const int lane = tid & 63, wave = wave0; const int G = gridDim.x, gw = blockIdx.x * NWAVES + wave, NGW = G * NWAVES; \
    unsigned char* ws = a->ws; float* out = a->out; unsigned* ctl = (unsigned*)(ws + WS_CTL); bf16* U = (bf16*)(ws + WS_U); bf16* ACT = (bf16*)(ws + WS_ACT); float* Fb = (float*)(ws + WS_F); bf16* FB = (bf16*)(ws + WS_FB); bf16* HB = (bf16*)(ws + WS_HB); (void)FB; (void)HB; \
    (void)lane; (void)wave; (void)gw; (void)NGW; (void)out; (void)ctl; (void)U; (void)ACT; (void)Fb;
#define GRID_BARRIER() do { TID_FRESH(tb_) KArgs ab_ = ap0; asm volatile("" : "+s"(ab_)); XcdBarrier bb_; bb_.bar = (unsigned*)(ab_->ws + WS_CTL) + CW_BAR; bb_.x = xb_xcc_id(); bb_.st = MISCW + 8; \
    xcd_barrier(bb_, tb_ == 0); } while (0)
#define PH_END } GRID_BARRIER();
#define DEQUEUE(qi, uvar) do { if (tid == 0) MISCW[16] = __hip_atomic_fetch_add(ctl + CW_Q + 64 * (qi), 1u, __ATOMIC_RELAXED, __HIP_MEMORY_SCOPE_AGENT); \
        __syncthreads(); uvar = (int)MISCW[16]; __syncthreads(); } while (0)

    PH_BEGIN(0)
    prologue(a, lds, wave, lane, gw, NGW);
    PH_END

    PH_BEGIN(1)
    { pg8::Gemm g{U, (const bf16*)(ws + WS_WGU1), MT, NGU, DM}; pg8::StaticOrder S; S.init(MT, NGU, G, (int)blockIdx.x);
      pg8::EpiGU E{ACT};
      pg8::gemm_phase<pg8::EpiGU, pg8::StaticOrder, true, true>(lds, g, S, E, tid); }
    { const int rem1 = ((MT / 256) * (NGU / 256)) % G, nkv = (NB * 256 / 256) * (2048 / 256); const bool fits = rem1 != 0 && rem1 + nkv <= G; const int koff = fits ? rem1 : 0;
      { pg8::Gemm g{(const bf16*)(ws + WS_MN), (const bf16*)(ws + WS_WMKV), NB * 256, 2048, DM}; pg8::StaticOrder S; S.init(NB * 256, 2048, G, (int)((blockIdx.x + G - koff) % G));
        pg8::EpiMemKV E{out + O_MKP, out + O_MVP, (bf16*)(ws + WS_MKB)};
        pg8::gemm_phase<pg8::EpiMemKV, pg8::StaticOrder, true, true>(lds, g, S, E, tid); }
      tr_tail(a, lds, wave, lane, fits ? rem1 + nkv : (nkv % G), G, TrSet{IT_CMV, TR_CMV, 0, 0, 0, 0, 0, 0}); }
    PH_END

    PH_BEGIN(2)
    { pg8::Gemm g{ACT, (const bf16*)(ws + WS_WD1), MP, DM, FF}; pg8::StaticOrder S; S.init(MP, DM, G, (int)blockIdx.x);
      pg8::EpiB16 E{FB, DM};
      pg8::gemm_phase<pg8::EpiB16, pg8::StaticOrder, true, true>(lds, g, S, E, tid); }
    for (int it = blockIdx.x; it < 256; it += G) sgemm::run<1>(lds, tid, it, ACT, FF, (const bf16*)(ws + WS_WD1), FF, FF, nullptr, 0, nullptr, 0, 0, nullptr, FB, nullptr, nullptr);
    PH_END

    PH_BEGIN(3)
    for (int r = gw; r < MR; r += 4 * NGW) {
        f32x4 f[4][4], h[4][4];
#pragma unroll
        for (int k = 0; k < 4; ++k) { const int rk = r + k * NGW < MR ? r + k * NGW : r;
            pn_load(rk < MP ? (const float*)a->in[I_XP] + (size_t)rk * DM : (const float*)a->in[I_XS] + (size_t)(rk - MP) * DM, nullptr, FB + (size_t)rk * DM, lane, f[k], h[k]); }
#pragma unroll
        for (int k = 0; k < 4; ++k) { const int rk = r + k * NGW;
            if (rk < MR) pn_finish(f[k], h[k], (const float*)a->in[I_F1POST], 0.5f, HB + (size_t)rk * DM, nullptr, (const float*)a->in[I_MIXPRE], U + (size_t)rk * DM, lane); }
    }
    PH_END

    PH_BEGIN(4)
    { pg8::Gemm g{U, (const bf16*)(ws + WS_WIN), MT, NINP, DM}; pg8::StaticOrder S; S.init(MT, NINP, G, (int)blockIdx.x);
      pg8::EpiWin E{(bf16*)(ws + WS_Z), (bf16*)(ws + WS_XBC), (bf16*)(ws + WS_Q), (bf16*)(ws + WS_KB), (bf16*)(ws + WS_QI), (bf16*)(ws + WS_GS), (bf16*)(ws + WS_GA),
                    (bf16*)(ws + WS_KIB), (float*)(ws + WS_MISC), out};
      pg8::gemm_phase<pg8::EpiWin, pg8::StaticOrder, true, true>(lds, g, S, E, tid); }
    { const int thr = ((MT / 256) * (NINP / 256)) % G;
      if ((int)blockIdx.x >= thr) { const int id = ((int)blockIdx.x - thr) * NWAVES + wave, nid = (G - thr) * NWAVES; LAS float* scr = (LAS float*)(lds + wave * 16384);
          tr_run(a, scr, lane, id, nid, TrSet{IT_GU, TR_GU2, IT_BRS + 4 * IT_SQ, TR_BRS, 0, 0, 0, 0});
          rows_run(a, lane, id, nid, ROWS_P0, IT_ROWS);
          for (int it = id; it < NB * 128; it += nid) { const int b = it >> 7, q = it & 127, db = q >> 2, kb = q & 3;
              tr_item(out + O_MVP + (size_t)b * 256 * DM, DM, 32 * db, 32, 64 * kb, (bf16*)(ws + WS_MVT) + (size_t)b * DM * 256, 256, 32 * db, 0, nullptr, scr, lane); } } }
    PH_END

    PH_BEGIN(5)
    for (;;) {
        int u; DEQUEUE(0, u);
        { KArgs a2 = ap0; asm volatile("" : "+s"(a2)); a = a2; ws = a->ws; out = a->out; }
        TID_FRESH(tu) const int wu = wave0, lu = tu & 63; (void)wu; (void)lu;
        if (u >= 768 + 256 + 32 + 256) break;
        UT_BEGIN()
        int uty, uix;
        if (u < 768) { const int grp = u / 3, k = u - 3 * grp; uty = (k == 0) ? 0 : (k == 1 ? 2 : 1); uix = grp; }
        else if (u < 1024) { uty = 0; uix = 256 + (u - 768); }
        else if (u < 1056) { uty = 1; uix = 256 + (u - 1024); }
        else { uty = 3; uix = u - 1056; }
        if (uty == 0) {
            const int v = uix, qblk = 63 - (v >> 3), b = v & 7;
            dsa::idx_prompt_unit(lds, tu, (const bf16*)(ws + WS_QI), (const bf16*)(ws + WS_KIB), (const float*)(ws + WS_MISC), (float*)(ws + WS_SC), (unsigned*)(ws + WS_MASK), b, qblk);
            UT_END(1)
        } else if (uty == 1) {
            const int v = uix;
            if (v < 256) ssd::conv_rows(tu, (const bf16*)(ws + WS_XBC), (bf16*)(ws + WS_XBCA), (const float*)a->in[I_CONVW], (const float*)a->in[I_CONVB], 64 * v, 64, (64 * v) & (SEQ - 1), nullptr);
            else ssd::conv_rows(tu, (const bf16*)(ws + WS_XBC), (bf16*)(ws + WS_XBCA), (const float*)a->in[I_CONVW], (const float*)a->in[I_CONVB], MP + 4 * (v - 256), 4, 0, (const float*)a->in[I_CONV] + (size_t)(v - 256) * 3 * 4096);
            UT_END(0)
        } else if (uty == 2) {
            const int v = uix;
            dsa::idx_sample_unit(tu, (const bf16*)(ws + WS_QI), (const float*)(ws + WS_MISC), (const float*)a->in[I_CKI], (const int*)a->in[I_PT], (float*)(ws + WS_SCS), v >> 3, v & 7);
            UT_END(2)
        } else {
            const int v = uix; LAS float* scr = (LAS float*)(lds + wu * 16384);
            { const int it = v * 8 + wu, b = it >> 8, q = it & 255, db = q >> 5, kb = q & 31;
                tr_item(out + O_VP + (size_t)b * SEQ * 256, 256, 32 * db, 32, 64 * kb, (bf16*)(ws + WS_VT) + (size_t)b * 256 * SEQ, SEQ, 32 * db, 0, nullptr, scr, lu); }
            __syncthreads();
            UT_END(4)
        }
    }
    PH_END

    PH_BEGIN(6)
    for (;;) {
        int u; DEQUEUE(1, u);
        { KArgs a2 = ap0; asm volatile("" : "+s"(a2)); a = a2; ws = a->ws; out = a->out; }
        TID_FRESH(tu) const int wu = wave0, lu = tu & 63; (void)wu; (void)lu;
        if (u >= 256 + 128 + 1024 + 1024) break;
        UT_BEGIN()
        if (u < 256 || u >= 1408) {
            const bool smp = u >= 1408; const int v = smp ? u - 1408 : u, b = v >> 5, g = (v >> 2) & 7, h = v & 3;
            if (smp) ssd::ssd_sample_unit(lds, tu, a, b, 4 * g + h);
            else ssd::ssd_unit(lds, tu, a, b * SEQ, SEQ, g, h, b, false);
            UT_END(smp ? 3 : 10)
        } else if (u < 384) {
            const int aix = u - 256;
            dsa::sample_query_unit(lds, tu, (const bf16*)(ws + WS_Q), (const bf16*)(ws + WS_QI), (const float*)(ws + WS_MISC), (const float*)(ws + WS_SCS),
                                   (const float*)a->in[I_CK], (const float*)a->in[I_CV], (const int*)a->in[I_PT], out, (bf16*)(ws + WS_YC) + 2048, aix >> 2, aix & 3);
            UT_END(5)
        } else {
            const int v = u - 384, qb = 31 - (v >> 5), b = (v >> 2) & 7, kvh = v & 3;
            dsa::attn_prompt_unit(lds, tu, (const bf16*)(ws + WS_Q), (const bf16*)(ws + WS_KB), (const bf16*)(ws + WS_VT), (const unsigned*)(ws + WS_MASK), (bf16*)(ws + WS_YC) + 2048, b, kvh, qb);
            UT_END(6)
        }
    }
    PH_END

    PH_BEGIN(7)
    { pg8::Gemm g{(const bf16*)(ws + WS_YC), (const bf16*)(ws + WS_WBRS), MP, DM, 3072};
      pg8::EpiGateC E{(const bf16*)(ws + WS_GS), (const bf16*)(ws + WS_GA), (bf16*)(ws + WS_MRG), (const float*)(ws + WS_SSQ), (LAS float*)(lds + MISC_OFF + 1024)};
      for (int i = 0;; ++i) {
          pg8::Unit u0; { pg8::StaticOrder S0; S0.init(MP, DM, G, (int)blockIdx.x); if (!S0.next(i, u0)) break; }
          E.fill<false>(u0, tid);
          pg8::StaticOrder S; S.init(MP, DM, 1 << 28, i * G + (int)blockIdx.x);
          pg8::gemm_phase<pg8::EpiGateC, pg8::StaticOrder, true, true>(lds, g, S, E, tid); } }
    for (int it = blockIdx.x; it < 256; it += G) sgemm::run<2>(lds, tid, it, (const bf16*)(ws + WS_YC), YCP, (const bf16*)(ws + WS_WBRS), 3072, 2048, (const bf16*)(ws + WS_YC) + 2048, YCP, (const bf16*)(ws + WS_WBRS) + 2048, 3072, DM,
                                                               nullptr, (bf16*)(ws + WS_MRG), (const bf16*)(ws + WS_GS), (const bf16*)(ws + WS_GA), (const float*)(ws + WS_SSQ));
    PH_END

    PH_BEGIN(8)
    { pg8::Gemm g{(const bf16*)(ws + WS_MRG), (const bf16*)(ws + WS_WOUT), MP, DM, DM}; pg8::StaticOrder S; S.init(MP, DM, G, (int)blockIdx.x);
      pg8::EpiB16 E{FB, DM};
      pg8::gemm_phase<pg8::EpiB16, pg8::StaticOrder, true, true>(lds, g, S, E, tid); }
    for (int it = blockIdx.x; it < 256; it += G) sgemm::run<1>(lds, tid, it, (const bf16*)(ws + WS_MRG), DM, (const bf16*)(ws + WS_WOUT), DM, DM, nullptr, 0, nullptr, 0, 0, nullptr, FB, nullptr, nullptr);
    PH_END

    PH_BEGIN(9)
    for (int r = gw; r < MR; r += 4 * NGW) {
        f32x4 f[4][4], h[4][4];
#pragma unroll
        for (int k = 0; k < 4; ++k) { const int rk = r + k * NGW < MR ? r + k * NGW : r; pn_load(nullptr, HB + (size_t)rk * DM, FB + (size_t)rk * DM, lane, f[k], h[k]); }
#pragma unroll
        for (int k = 0; k < 4; ++k) { const int rk = r + k * NGW; if (rk < MR) pn_finish(f[k], h[k], (const float*)a->in[I_MIXPOST], 1.0f, HB + (size_t)rk * DM, nullptr, (const float*)a->in[I_MEMPRE], U + (size_t)rk * DM, lane); }
    }
    PH_END

    PH_BEGIN(10)
    { pg8::Gemm g{U, (const bf16*)(ws + WS_WMQ), MP, DM, DM}; pg8::StaticOrder S; S.init(MP, DM, G, (int)blockIdx.x);
      pg8::EpiB16 E{(bf16*)(ws + WS_QM), DM};
      pg8::gemm_phase<pg8::EpiB16, pg8::StaticOrder, true, true>(lds, g, S, E, tid); }
    for (int it = blockIdx.x; it < 256; it += G) sgemm::run<1>(lds, tid, it, U, DM, (const bf16*)(ws + WS_WMQ), DM, DM, nullptr, 0, nullptr, 0, 0, nullptr, (bf16*)(ws + WS_QM), nullptr, nullptr);
    PH_END

    PH_BEGIN(11)
    for (;;) {
        int u; DEQUEUE(2, u);
        { KArgs a2 = ap0; asm volatile("" : "+s"(a2)); a = a2; ws = a->ws; out = a->out; }
        TID_FRESH(tu) const int wu = wave0, lu = tu & 63; (void)wu; (void)lu;
        if (u >= 512 + 128) break;
        UT_BEGIN()
        if (u < 512) { const int b = u >> 6, head = (u >> 4) & 3, qt = u & 15;
            mema::memattn_unit(lds, tu, (const bf16*)(ws + WS_QM), (const bf16*)(ws + WS_MKB), (const bf16*)(ws + WS_MVT), (bf16*)(ws + WS_OM), b, head, b * SEQ + 128 * qt, 128); UT_END(8)
        } else { const int v = u - 512, b = v >> 2, head = v & 3;
            mema::memattn_unit(lds, tu, (const bf16*)(ws + WS_QM), (const bf16*)(ws + WS_MKB), (const bf16*)(ws + WS_MVT), (bf16*)(ws + WS_OM), NB + b, head, MP + 4 * b, 4); UT_END(9) }
    }
    PH_END

    PH_BEGIN(12)
    { pg8::Gemm g{(const bf16*)(ws + WS_OM), (const bf16*)(ws + WS_WMO), MP, DM, DM}; pg8::StaticOrder S; S.init(MP, DM, G, (int)blockIdx.x);
      pg8::EpiB16 E{FB, DM};
      pg8::gemm_phase<pg8::EpiB16, pg8::StaticOrder, true, true>(lds, g, S, E, tid); }
    for (int it = blockIdx.x; it < 256; it += G) sgemm::run<1>(lds, tid, it, (const bf16*)(ws + WS_OM), DM, (const bf16*)(ws + WS_WMO), DM, DM, nullptr, 0, nullptr, 0, 0, nullptr, FB, nullptr, nullptr);
    PH_END

    PH_BEGIN(13)
    for (int r = gw; r < MR; r += 4 * NGW) {
        f32x4 f[4][4], h[4][4];
#pragma unroll
        for (int k = 0; k < 4; ++k) { const int rk = r + k * NGW < MR ? r + k * NGW : r; pn_load(nullptr, HB + (size_t)rk * DM, FB + (size_t)rk * DM, lane, f[k], h[k]); }
#pragma unroll
        for (int k = 0; k < 4; ++k) { const int rk = r + k * NGW; if (rk < MR) pn_finish(f[k], h[k], (const float*)a->in[I_MEMPOST], 1.0f, HB + (size_t)rk * DM, nullptr, (const float*)a->in[I_F2PRE], U + (size_t)rk * DM, lane); }
    }
    PH_END

    PH_BEGIN(14)
    { pg8::Gemm g{U, (const bf16*)(ws + WS_WGU2), MT, NGU, DM}; pg8::StaticOrder S; S.init(MT, NGU, G, (int)blockIdx.x);
      pg8::EpiGU E{ACT};
      pg8::gemm_phase<pg8::EpiGU, pg8::StaticOrder, true, true>(lds, g, S, E, tid); }
    tr_tail(a, lds, wave, lane, ((MT / 256) * (NGU / 256)) % G, G, TrSet{IT_D, TR_D2, 0, 0, 0, 0, 0, 0});
    PH_END

    PH_BEGIN(15)
    { pg8::Gemm g{ACT, (const bf16*)(ws + WS_WD2), MP, DM, FF}; pg8::StaticOrder S; S.init(MP, DM, G, (int)blockIdx.x);
      pg8::EpiB16 E{FB, DM};
      pg8::gemm_phase<pg8::EpiB16, pg8::StaticOrder, true, true>(lds, g, S, E, tid); }
    for (int it = blockIdx.x; it < 256; it += G) sgemm::run<1>(lds, tid, it, ACT, FF, (const bf16*)(ws + WS_WD2), FF, FF, nullptr, 0, nullptr, 0, 0, nullptr, FB, nullptr, nullptr);
    PH_END

    PH_BEGIN(16)
    for (int r = gw; r < MR; r += 4 * NGW) {
        f32x4 f[4][4], h[4][4];
#pragma unroll
        for (int k = 0; k < 4; ++k) { const int rk = r + k * NGW < MR ? r + k * NGW : r; pn_load(nullptr, HB + (size_t)rk * DM, FB + (size_t)rk * DM, lane, f[k], h[k]); }
#pragma unroll
        for (int k = 0; k < 4; ++k) { const int rk = r + k * NGW; if (rk < MR) pn_finish(f[k], h[k], (const float*)a->in[I_F2POST], 0.5f, nullptr, out + (size_t)rk * DM, nullptr, nullptr, lane); }
    }
    }
#ifdef DBG_T1
    GRID_BARRIER();
    PH_BEGIN(17)
    if (blockIdx.x == 0) {
        __syncthreads();
        const unsigned long long* st = (const unsigned long long*)(ws + WS_CTL + 512 * 1024);
        const float tot = (float)(st[17] - st[0]);
#ifdef DBG_U1
        const unsigned* ut = (const unsigned*)(ws + WS_CTL + 768 * 1024);
        const float f1 = (float)ut[DBG_U1] / (tot * (float)G), f2 = (DBG_U2 >= 16) ? (float)ut[DBG_U2] / ((float)ut[16] + (float)ut[17] + (float)ut[18] + (float)ut[19]) : (float)ut[DBG_U2] / (tot * (float)G);
#else
        const float f1 = (float)(st[DBG_T1 + 1] - st[DBG_T1]) / tot, f2 = (float)(st[DBG_T2 + 1] - st[DBG_T2]) / tot;
#endif
        const float sc = 1.0f;  (void)f1;
        for (int i = tid; i < MS * 64; i += 512) out[O_KIS + i] *= sc;
        if (tid == 0) out[O_VS] += 100.0f * f2;
    }
    }
#endif
}

extern "C" void kernel_launch(void* const* d_in, const int* in_sizes, int n_in, void* d_out, int out_size, void* d_ws, size_t ws_size, hipStream_t stream) {
    static int grid = 0;
    if (grid == 0) {
        if (n_in != N_IN || (size_t)out_size != O_END || ws_size < WS_END) {
            fprintf(stderr, "kernel_launch: unexpected sizes: n_in %d out %d ws %zu (need %zu)\n", n_in, out_size, ws_size, (size_t)WS_END); grid = -1; return; }
        int dev = 0, cus = 0, per_cu = 0;
        if (hipGetDevice(&dev) != hipSuccess || hipDeviceGetAttribute(&cus, hipDeviceAttributeMultiprocessorCount, dev) != hipSuccess) { grid = -1; return; }
        if (hipFuncSetAttribute((const void*)mega_fwd, hipFuncAttributeMaxDynamicSharedMemorySize, LDS_BYTES) != hipSuccess) { fprintf(stderr, "kernel_launch: hipFuncSetAttribute failed\n"); grid = -1; return; }
        if (hipOccupancyMaxActiveBlocksPerMultiprocessor(&per_cu, (const void*)mega_fwd, NWAVES * 64, LDS_BYTES) != hipSuccess || per_cu < 1)
            fprintf(stderr, "kernel_launch: occupancy query reports %d\n", per_cu);
        (void)hipGetLastError();
        grid = cus;
    }
    if (grid < 0) return;
    if (hipMemsetAsync((char*)d_ws + WS_CTL, 0, CTL_ZERO_BYTES, stream) != hipSuccess) return;
    Args a{};
    for (int i = 0; i < N_IN; ++i) a.in[i] = d_in[i];
    a.out = (float*)d_out; a.ws = (unsigned char*)d_ws;
    hipLaunchKernelGGL(mega_fwd, dim3(grid), dim3(NWAVES * 64), LDS_BYTES, stream, a);
}
```
